# Optimizing an MI355X kernel written in HIP

```python
import math
import jax, jax.numpy as jnp
from jax import lax
import numpy as np

D_MODEL = 1024
BATCH = 8
SEQ = 2048
DEPTH = 1
DEC_BATCH = 128
DEC_SEQ = 8
PAST_LEN = 16384
PAGE_SIZE = 128

S5_WIDTH = D_MODEL // 2
S5_GROUP = 16
S5_GROUPS = S5_WIDTH // S5_GROUP
S5_STATE = 64
CM_WIDTH = D_MODEL - S5_WIDTH
CM_HEADS = 8
CM_HEAD_DIM = CM_WIDTH // CM_HEADS
CHUNK = 128
IN_WIDTH = S5_WIDTH + 2 * CM_WIDTH
MIX_WIDTH = S5_WIDTH + CM_WIDTH
D_FF = -(-8 * D_MODEL // (3 * 256)) * 256
EPS = 1e-6
DT_MIN = 1e-3
DT_MAX = 1e-1

kernel_name = "hymba_s5_chunkgmlp_decoder_step"


def rmsnorm(x, g):
    xf = x.astype(jnp.float32)
    r = lax.rsqrt(jnp.mean(xf * xf, axis=-1, keepdims=True) + EPS)
    return (xf * r * g.astype(jnp.float32)).astype(x.dtype)


def layernorm(x, g, b):
    xf = x.astype(jnp.float32)
    mu = jnp.mean(xf, axis=-1, keepdims=True)
    xc = xf - mu
    r = lax.rsqrt(jnp.mean(xc * xc, axis=-1, keepdims=True) + EPS)
    return (xc * r * g.astype(jnp.float32) + b.astype(jnp.float32)).astype(x.dtype)


def _complex_affine_combine(e1, e2):
    a1r, a1i, b1r, b1i = e1
    a2r, a2i, b2r, b2i = e2
    ar = a2r * a1r - a2i * a1i
    ai = a2r * a1i + a2i * a1r
    br = a2r * b1r - a2i * b1i + b2r
    bi = a2r * b1i + a2i * b1r + b2i
    return (ar, ai, br, bi)


def s5_mixer(xs, h0_re, h0_im, lam_re, lam_im, log_dt, b_re, b_im, c_re, c_im,
             d_skip, w_glu, b_glu):
    f32 = jnp.float32
    Bn, T, _ = xs.shape
    xf = xs.astype(f32)
    u = xf.reshape(Bn, T, S5_GROUPS, S5_GROUP)
    dt = jnp.exp(log_dt.astype(f32))[:, None]
    lr = lam_re.astype(f32)
    li = lam_im.astype(f32)
    mag = jnp.exp(lr * dt)
    ar = mag * jnp.cos(li * dt)
    ai = mag * jnp.sin(li * dt)
    den = lr * lr + li * li
    qr = ((ar - 1.0) * lr + ai * li) / den
    qi = (ai * lr - (ar - 1.0) * li) / den
    br_, bi_ = b_re.astype(f32), b_im.astype(f32)
    bbr = qr[..., None] * br_ - qi[..., None] * bi_
    bbi = qr[..., None] * bi_ + qi[..., None] * br_
    bu_r = jnp.einsum('btgi,gni->btgn', u, bbr)
    bu_i = jnp.einsum('btgi,gni->btgn', u, bbi)
    h0r = h0_re.astype(f32)
    h0i = h0_im.astype(f32)
    bu_r = bu_r.at[:, 0].add(ar * h0r - ai * h0i)
    bu_i = bu_i.at[:, 0].add(ar * h0i + ai * h0r)
    a_r = jnp.broadcast_to(ar, bu_r.shape)
    a_i = jnp.broadcast_to(ai, bu_i.shape)
    _, _, hr, hi = lax.associative_scan(_complex_affine_combine, (a_r, a_i, bu_r, bu_i), axis=1)
    y = (jnp.einsum('btgn,gon->btgo', hr, c_re.astype(f32))
         - jnp.einsum('btgn,gon->btgo', hi, c_im.astype(f32)))
    y = y.reshape(Bn, T, S5_WIDTH) + d_skip.astype(f32) * xf
    g = jax.nn.gelu(y)
    out = g * jax.nn.sigmoid(g @ w_glu.astype(f32) + b_glu.astype(f32))
    return out.astype(xs.dtype), hr[:, -1], hi[:, -1]


def chunk_mixer(uv, ln_g, ln_b, w_s, b_s):
    Bn, T, _ = uv.shape
    uv = jax.nn.gelu(uv)
    u = uv[..., :CM_WIDTH]
    v = layernorm(uv[..., CM_WIDTH:], ln_g, ln_b)
    Lc = T if T < CHUNK else CHUNK
    n_chunks = -(-T // Lc)
    Tp = n_chunks * Lc
    vp = jnp.pad(v, ((0, 0), (0, Tp - T), (0, 0)))
    vc = vp.reshape(Bn, n_chunks, Lc, CM_HEADS, CM_HEAD_DIM)
    mask = jnp.tril(jnp.ones((Lc, Lc), dtype=bool))
    w = jnp.where(mask[None], w_s[:, :Lc, :Lc], jnp.zeros((), w_s.dtype))
    mixed = jnp.einsum('hts,bcshd->bcthd', w, vc)
    mixed = mixed + jnp.transpose(b_s[:, :Lc])[None, None, :, :, None]
    mixed = mixed.reshape(Bn, Tp, CM_WIDTH)[:, :T]
    out = u * mixed
    start = ((T - 1) // CHUNK) * CHUNK
    return out, v[:, start:]


def swiglu(x, w_gate, w_up, w_down):
    return (jax.nn.silu(x @ w_gate) * (x @ w_up)) @ w_down


def setup_inputs(seed: int = 0) -> dict:
    key = jax.random.key(seed)
    ks = jax.random.split(key, 32)
    f32 = jnp.float32
    nrm = lambda k, shape, s: jax.random.normal(k, shape, f32) * s
    x_prompt = nrm(ks[0], (BATCH, SEQ, D_MODEL), 1.0)
    x_sample = nrm(ks[1], (DEC_BATCH, DEC_SEQ, D_MODEL), 1.0)
    state_s5_re = nrm(ks[2], (DEPTH, DEC_BATCH, S5_GROUPS, S5_STATE), 0.1)
    state_s5_im = nrm(ks[3], (DEPTH, DEC_BATCH, S5_GROUPS, S5_STATE), 0.1)
    norm1 = 1.0 + nrm(ks[4], (DEPTH, D_MODEL), 0.02)
    w_in = nrm(ks[5], (DEPTH, D_MODEL, IN_WIDTH), D_MODEL ** -0.5)
    lam_re = -0.5 * jnp.exp(nrm(ks[6], (DEPTH, S5_GROUPS, S5_STATE), 0.05))
    lam_im = jnp.broadcast_to(math.pi * jnp.arange(S5_STATE, dtype=f32),
                              (DEPTH, S5_GROUPS, S5_STATE)) + nrm(ks[7], (DEPTH, S5_GROUPS, S5_STATE), 0.01)
    log_dt = jax.random.uniform(ks[8], (DEPTH, S5_GROUPS), f32,
                                math.log(DT_MIN), math.log(DT_MAX))
    b_re = nrm(ks[9], (DEPTH, S5_GROUPS, S5_STATE, S5_GROUP), (2 * S5_GROUP) ** -0.5)
    b_im = nrm(ks[10], (DEPTH, S5_GROUPS, S5_STATE, S5_GROUP), (2 * S5_GROUP) ** -0.5)
    c_re = nrm(ks[11], (DEPTH, S5_GROUPS, S5_GROUP, S5_STATE), (2 * S5_STATE) ** -0.5)
    c_im = nrm(ks[12], (DEPTH, S5_GROUPS, S5_GROUP, S5_STATE), (2 * S5_STATE) ** -0.5)
    d_skip = nrm(ks[13], (DEPTH, S5_WIDTH), 1.0)
    w_glu = nrm(ks[14], (DEPTH, S5_WIDTH, S5_WIDTH), S5_WIDTH ** -0.5)
    b_glu = nrm(ks[15], (DEPTH, S5_WIDTH), 0.01)
    cm_ln_g = 1.0 + nrm(ks[16], (DEPTH, CM_WIDTH), 0.02)
    cm_ln_b = nrm(ks[17], (DEPTH, CM_WIDTH), 0.01)
    w_s = nrm(ks[18], (DEPTH, CM_HEADS, CHUNK, CHUNK), CHUNK ** -0.5)
    b_s = 1.0 + nrm(ks[19], (DEPTH, CM_HEADS, CHUNK), 0.01)
    g_s5 = 1.0 + nrm(ks[20], (DEPTH, S5_WIDTH), 0.02)
    g_cm = 1.0 + nrm(ks[21], (DEPTH, CM_WIDTH), 0.02)
    w_out = nrm(ks[22], (DEPTH, MIX_WIDTH, D_MODEL), MIX_WIDTH ** -0.5)
    norm2 = 1.0 + nrm(ks[23], (DEPTH, D_MODEL), 0.02)
    w_gate = nrm(ks[24], (DEPTH, D_MODEL, D_FF), D_MODEL ** -0.5)
    w_up = nrm(ks[25], (DEPTH, D_MODEL, D_FF), D_MODEL ** -0.5)
    w_down = nrm(ks[26], (DEPTH, D_FF, D_MODEL), D_FF ** -0.5)
    norm_f = 1.0 + nrm(ks[27], (D_MODEL,), 0.02)
    return {"x_prompt": x_prompt, "x_sample": x_sample,
            "state_s5_re": state_s5_re, "state_s5_im": state_s5_im,
            "norm1": norm1, "w_in": w_in, "lam_re": lam_re, "lam_im": lam_im,
            "log_dt": log_dt, "b_re": b_re, "b_im": b_im, "c_re": c_re, "c_im": c_im,
            "d_skip": d_skip, "w_glu": w_glu, "b_glu": b_glu,
            "cm_ln_g": cm_ln_g, "cm_ln_b": cm_ln_b, "w_s": w_s, "b_s": b_s,
            "g_s5": g_s5, "g_cm": g_cm, "w_out": w_out, "norm2": norm2,
            "w_gate": w_gate, "w_up": w_up, "w_down": w_down, "norm_f": norm_f}


def reference(x_prompt, x_sample, state_s5_re, state_s5_im, norm1, w_in, lam_re, lam_im,
              log_dt, b_re, b_im, c_re, c_im, d_skip, w_glu, b_glu, cm_ln_g, cm_ln_b,
              w_s, b_s, g_s5, g_cm, w_out, norm2, w_gate, w_up, w_down, norm_f):
    def layer(x, h0r, h0i, l):
        h = rmsnorm(x, norm1[l])
        p = h @ w_in[l]
        o_s5, hr, hi = s5_mixer(p[..., :S5_WIDTH], h0r, h0i, lam_re[l], lam_im[l], log_dt[l],
                                b_re[l], b_im[l], c_re[l], c_im[l], d_skip[l], w_glu[l], b_glu[l])
        o_cm, v_rows = chunk_mixer(p[..., S5_WIDTH:], cm_ln_g[l], cm_ln_b[l], w_s[l], b_s[l])
        mix = jnp.concatenate([rmsnorm(o_s5, g_s5[l]), rmsnorm(o_cm, g_cm[l])], axis=-1)
        x = x + mix @ w_out[l]
        x = x + swiglu(rmsnorm(x, norm2[l]), w_gate[l], w_up[l], w_down[l])
        return x, hr, hi, v_rows

    xp, xs = x_prompt, x_sample
    zeros_state = jnp.zeros((BATCH, S5_GROUPS, S5_STATE), jnp.float32)
    pr, pi_, pv, sr, si, sv = [], [], [], [], [], []
    for l in range(DEPTH):
        xp, hr, hi, vr = layer(xp, zeros_state, zeros_state, l)
        pr.append(hr); pi_.append(hi); pv.append(vr)
        xs, hr, hi, vr = layer(xs, state_s5_re[l], state_s5_im[l], l)
        sr.append(hr); si.append(hi); sv.append(vr)
    y_prompt = rmsnorm(xp, norm_f)
    y_sample = rmsnorm(xs, norm_f)
    return (y_prompt, y_sample, jnp.stack(pr), jnp.stack(pi_), jnp.stack(pv),
            jnp.stack(sr), jnp.stack(si), jnp.stack(sv))
```

```cpp
#include <hip/hip_runtime.h>
#include <hip/hip_cooperative_groups.h>
#include <cstdio>
#include <cstdint>
namespace cg = cooperative_groups;
#ifndef PHMASK
#define PHMASK 255
#endif
#ifndef MK_MULTI_LAUNCH
#define MK_MULTI_LAUNCH 1
#endif
namespace pg8 {
#define PG8_LAS __attribute__((address_space(3)))
typedef unsigned short bf16_t;
typedef short bf16x8 __attribute__((ext_vector_type(8)));
typedef float f32x4 __attribute__((ext_vector_type(4)));
typedef unsigned u32x4 __attribute__((ext_vector_type(4)));
constexpr int BM = 256, BK = 64, HALF = 128, HTB = HALF * BK * 2  , STAGE_BYTES = 8 * HTB, NXCD = 8, WGM = 8;

__host__ __device__ __forceinline__ int lds_byte(int r, int c) { const int st = (r >> 4) * 2 + (c >> 5), rr = r & 15, cc = c & 31, ob = rr * 64 + cc * 2; return st * 1024 + (ob ^ (((ob >> 9) & 1) << 5)); }
__host__ __device__ __forceinline__ void stage_rc(int b, int& R, int& C) { const int st = b / 1024, sb = b % 1024, swz = sb ^ (((sb >> 9) & 1) << 5); R = (st >> 1) * 16 + swz / 64; C = (st & 1) * 32 + (swz % 64) / 2; }
__host__ __device__ __forceinline__ int perm32(int rho) { const int n = rho >> 4, i = rho & 15; return 8 * (i >> 2) + 4 * n + (i & 3); }

struct Unit { int pm, pn; };
struct Gemm { const bf16_t* A; const bf16_t* Bt; int M, N, K; };

struct StaticOrder {
    int nM, nN, nwg, G, c;
    __host__ __device__ void init(int M, int N, int G_, int c_) { nM = M / BM; nN = N / BM; nwg = nM * nN; G = G_; c = c_; }
    __host__ __device__ bool next(int i, Unit& u) const {
        const long L = (long)i * G + c; if (L >= nwg) return false;
        int wgid = (int)L; { const int q = nwg / NXCD, r = nwg % NXCD, xcd = wgid % NXCD, off = wgid / NXCD; wgid = (xcd < r ? xcd * (q + 1) : r * (q + 1) + (xcd - r) * q) + off; }
        const int nig = WGM * nN, gid = wgid / nig, fm = gid * WGM, gsz = (nM - fm) < WGM ? (nM - fm) : WGM;
        u.pm = fm + ((wgid % nig) % gsz); u.pn = (wgid % nig) / gsz; return true;
    }
    __device__ __forceinline__ void a_ready(const Unit&) const {}
    __device__ __forceinline__ void done(const Unit&) const {}
};
template <class Epi, class Sched, bool STAMP = false>
__device__ __forceinline__ void gemm_phase(PG8_LAS unsigned char* lds, const Gemm g, const Sched& S, const Epi& E, unsigned long long* stamps) {
    const int tid = threadIdx.x, wid = __builtin_amdgcn_readfirstlane(tid >> 6), lane = tid & 63, wr = wid >> 2, wc = wid & 3, fr = lane & 15, fq = lane >> 4;
    const int K = g.K, nt = K / BK;
    int ts_lo = 0, ts_hi = 0, nts = 0; const unsigned long long rt_entry = STAMP ? (unsigned long long)wall_clock64() : 0ull;
#define PG8_STAMP() do { if (STAMP && wid == 0 && nts < 64) { const unsigned long long _c = (unsigned long long)clock64(); \
        ts_lo = (lane == nts) ? (int)(unsigned)_c : ts_lo; ts_hi = (lane == nts) ? (int)(unsigned)(_c >> 32) : ts_hi; ++nts; } } while (0)
    PG8_STAMP();
    unsigned voffA[2], voffB[2];
#pragma unroll
    for (int i = 0; i < 2; ++i) { int R, C; stage_rc(tid * 16 + i * 8192, R, C); const int Rb = Epi::PERM ? ((R & ~31) + perm32(R & 31)) : R;
        voffA[i] = (unsigned)(R * K + C) * 2u; voffB[i] = (unsigned)(Rb * K + C) * 2u; }
    const size_t kstep = (size_t)(BK * 2);
    const size_t hstep = (size_t)HALF * K * 2;
    const size_t tstep = 2 * hstep;
    const unsigned ldsw = (unsigned)wid * 1024u;
    const int aoff = lds_byte(wr * 64 + fr, fq * 8), boff = lds_byte(wc * 32 + fr, fq * 8);
#define PG8_SA(b, h) (((b) * 2 + (h)) * HTB)
#define PG8_SB(b, h) ((4 + (b) * 2 + (h)) * HTB)
#define PG8_STAGE(bufoff, gbase, voff) do { _Pragma("unroll") for (int _i = 0; _i < 2; ++_i) \
        __builtin_amdgcn_global_load_lds((const unsigned*)((const char*)(gbase) + (voff)[_i]), (PG8_LAS unsigned*)(lds + (bufoff) + ldsw + _i * 8192), 16, 0, 0); } while (0)
#define PG8_LDA(dst, b, h) do { _Pragma("unroll") for (int m = 0; m < 4; ++m) _Pragma("unroll") for (int k = 0; k < 2; ++k) dst[m][k] = *(const PG8_LAS bf16x8*)(lds + PG8_SA(b, h) + aoff + m * 2048 + k * 1024); } while (0)
#define PG8_LDB(dst, b, h) do { _Pragma("unroll") for (int n = 0; n < 2; ++n) _Pragma("unroll") for (int k = 0; k < 2; ++k) dst[n][k] = *(const PG8_LAS bf16x8*)(lds + PG8_SB(b, h) + boff + n * 2048 + k * 1024); } while (0)
#define PG8_MMA(ai, bj, At, Bt) do { __builtin_amdgcn_s_setprio(1); _Pragma("unroll") for (int m = 0; m < 4; ++m) _Pragma("unroll") for (int n = 0; n < 2; ++n) _Pragma("unroll") for (int k = 0; k < 2; ++k) \
        acc[ai][bj][m][n] = __builtin_amdgcn_mfma_f32_16x16x32_bf16(Bt[n][k], At[m][k], acc[ai][bj][m][n], 0, 0, 0); __builtin_amdgcn_s_setprio(0); } while (0)
#define PG8_WAIT_V(n) asm volatile("s_waitcnt vmcnt(" #n ")" ::: "memory")
#define PG8_WAIT_L(n) asm volatile("s_waitcnt lgkmcnt(" #n ")" ::: "memory")
#define PG8_BAR __builtin_amdgcn_s_barrier()
#define PG8_SCHED __builtin_amdgcn_sched_barrier(0)
    Unit cur, nxt; int ui = 0;
    if (!S.next(0, cur)) return;
    f32x4 acc[2][2][4][2];
#pragma unroll
    for (int a = 0; a < 2; ++a)
#pragma unroll
        for (int b = 0; b < 2; ++b)
#pragma unroll
            for (int m = 0; m < 4; ++m)
#pragma unroll
                for (int n = 0; n < 2; ++n) acc[a][b][m][n] = (f32x4){0.f, 0.f, 0.f, 0.f};
    bf16x8 At[4][2], B0[2][2], B1[2][2];
    const char* cA = (const char*)g.A + (size_t)cur.pm * tstep; const char* cB = (const char*)g.Bt + (size_t)cur.pn * tstep;
    S.a_ready(cur);
    PG8_STAGE(PG8_SB(0, 0), cB, voffB); PG8_STAGE(PG8_SA(0, 0), cA, voffA); PG8_STAGE(PG8_SB(0, 1), cB + hstep, voffB); PG8_STAGE(PG8_SA(0, 1), cA + hstep, voffA);
    if (wr == 1) PG8_BAR;
    PG8_WAIT_V(4); PG8_BAR;
    PG8_STAGE(PG8_SB(1, 0), cB + kstep, voffB); PG8_STAGE(PG8_SA(1, 0), cA + kstep, voffA); PG8_STAGE(PG8_SB(1, 1), cB + hstep + kstep, voffB);
    PG8_WAIT_V(6); PG8_BAR;
    PG8_STAMP();
    for (;;) {
        const bool has_next = S.next(ui + 1, nxt);
        const char* nA = has_next ? (const char*)g.A + (size_t)nxt.pm * tstep : cA; const char* nB = has_next ? (const char*)g.Bt + (size_t)nxt.pn * tstep : cB;
        for (int t = 0; t < nt; t += 2) {
            const bool last = (t == nt - 2);
            const char* a1 = cA + (size_t)(t + 1) * kstep;
            const char* a2 = last ? nA : cA + (size_t)(t + 2) * kstep; const char* b2 = last ? nB : cB + (size_t)(t + 2) * kstep;
            const char* a3 = a2 + kstep; const char* b3 = b2 + kstep;
            if (last && has_next) S.a_ready(nxt);
            if constexpr (Epi::HAS_MID) { if (t == Epi::MID_T) E.mid(acc, cur, wr, wc, fr, fq); }
            PG8_LDB(B0, 0, 0); PG8_SCHED; PG8_LDA(At, 0, 0); PG8_STAGE(PG8_SA(1, 1), a1 + hstep, voffA);
            PG8_WAIT_L(8); PG8_BAR; PG8_WAIT_L(0); PG8_MMA(0, 0, At, B0); PG8_BAR; PG8_SCHED;
            PG8_LDB(B1, 0, 1); PG8_STAGE(PG8_SB(0, 0), b2, voffB);
            PG8_BAR; PG8_WAIT_L(0); PG8_MMA(0, 1, At, B1); PG8_BAR;
            PG8_LDA(At, 0, 1); PG8_STAGE(PG8_SA(0, 0), a2, voffA);
            PG8_BAR; PG8_WAIT_L(0); PG8_MMA(1, 0, At, B0); PG8_BAR; PG8_SCHED;
            PG8_STAGE(PG8_SB(0, 1), b2 + hstep, voffB);
            PG8_WAIT_V(6); PG8_BAR; PG8_MMA(1, 1, At, B1); PG8_BAR;
            PG8_LDB(B0, 1, 0); PG8_SCHED; PG8_LDA(At, 1, 0); PG8_STAGE(PG8_SA(0, 1), a2 + hstep, voffA);
            PG8_WAIT_L(8); PG8_BAR; PG8_WAIT_L(0); PG8_MMA(0, 0, At, B0); PG8_BAR; PG8_SCHED;
            PG8_LDB(B1, 1, 1); PG8_STAGE(PG8_SB(1, 0), b3, voffB);
            PG8_BAR; PG8_WAIT_L(0); PG8_MMA(0, 1, At, B1); PG8_BAR;
            PG8_LDA(At, 1, 1); PG8_STAGE(PG8_SA(1, 0), a3, voffA);
            PG8_BAR; PG8_WAIT_L(0); PG8_MMA(1, 0, At, B0); PG8_BAR; PG8_SCHED;
            PG8_STAGE(PG8_SB(1, 1), b3 + hstep, voffB);
            PG8_WAIT_V(6); PG8_BAR; PG8_MMA(1, 1, At, B1); PG8_BAR;
        }
        PG8_STAMP();
        if constexpr (!Epi::AFTER_DRAIN) { E(acc, cur, wr, wc, fr, fq); S.done(cur); }
        PG8_STAMP();
        if (!has_next) break;
#pragma unroll
        for (int a = 0; a < 2; ++a)
#pragma unroll
            for (int b = 0; b < 2; ++b)
#pragma unroll
                for (int m = 0; m < 4; ++m)
#pragma unroll
                    for (int n = 0; n < 2; ++n) acc[a][b][m][n] = (f32x4){0.f, 0.f, 0.f, 0.f};
        cur = nxt; cA = nA; cB = nB; ++ui;
    }
    PG8_WAIT_V(0);
    if (wr == 0) PG8_BAR;
    PG8_BAR;
    if constexpr (Epi::AFTER_DRAIN) { E.fused(acc, cur, wr, wc, fr, fq, lds, wid, lane); S.done(cur); }
    PG8_STAMP();
    if (STAMP && wid == 0) { stamps[lane] = lane < nts ? (((unsigned long long)(unsigned)ts_hi << 32) | (unsigned)ts_lo) : 0ull;
        if (lane == 62) stamps[62] = rt_entry; if (lane == 63) stamps[63] = (unsigned long long)wall_clock64(); }
#undef PG8_STAMP
#undef PG8_SA
#undef PG8_SB
#undef PG8_STAGE
#undef PG8_LDA
#undef PG8_LDB
#undef PG8_MMA
#undef PG8_WAIT_V
#undef PG8_WAIT_L
#undef PG8_BAR
#undef PG8_SCHED
}
}

using pg8::bf16_t; using pg8::bf16x8; using pg8::f32x4; using pg8::Unit;
#define LAS __attribute__((address_space(3)))
typedef unsigned u32x2 __attribute__((ext_vector_type(2)));
typedef unsigned u32x4 __attribute__((ext_vector_type(4)));
typedef float f32x16 __attribute__((ext_vector_type(16)));

constexpr int DM = 1024, NTP = 16384, MTOK = 17408, INW = 1536, DFF = 2816;
constexpr float EPSV = 1e-6f;
constexpr size_t O_Y = 0, O_PRE = 17825792, O_PIM = 17842176, O_PV = 17858560, O_SRE = 18382848, O_SIM = 18644992, O_SV = 18907136;
constexpr size_t W_ACT = 0, W_XH = 0, W_GBUF = 0, W_MIX = 35651584, W_PBUF = 71303168, W_X2B = 98041856;
constexpr size_t W_BTIN = 133693440, W_BTGLU = W_BTIN + 3145728, W_BTOUT = W_BTGLU + 524288, W_BTGU = W_BTOUT + 2097152, W_BTDN = W_BTGU + 11534336;
constexpr size_t W_ATAB = W_BTDN + 5767168, W_BBT = W_ATAB + 16384, W_CMT = W_BBT + 131072, W_WTP = W_CMT + 131072, W_WTS = W_WTP + 262144, W_RSS = W_WTS + 262144;
constexpr size_t W_END = W_RSS + 4 * 17408 * 4;
constexpr int LDS_BYTES = 131072 + 4096;

struct Params { const float* in[28]; float* out; unsigned char* ws; int ph_lo, ph_hi; };

__device__ __forceinline__ unsigned pk2(float lo, float hi) { unsigned r; asm volatile("v_cvt_pk_bf16_f32 %0, %1, %2" : "=v"(r) : "v"(lo), "v"(hi)); return r; }
__device__ __forceinline__ float bflo(unsigned w) { return __uint_as_float(w << 16); }
__device__ __forceinline__ float bfhi(unsigned w) { return __uint_as_float(w & 0xffff0000u); }
__device__ __forceinline__ float sigmoidf_(float z) { return __builtin_amdgcn_rcpf(1.0f + __builtin_amdgcn_exp2f(-1.4426950408889634f * z)); }
__device__ __forceinline__ float gelu_t(float x) { const float z = 1.5957691216057308f * (x + 0.044715f * x * x * x); return x * sigmoidf_(z); }
__device__ __forceinline__ float wave_sum(float v) {
#pragma unroll
    for (int o = 1; o < 64; o <<= 1) v += __shfl_xor(v, o);
    return v;
}
#define LDS_WAIT() asm volatile("s_waitcnt lgkmcnt(0)" ::: "memory")
__device__ __forceinline__ const float* xrow_ptr(const Params& p, int tok) { return tok < NTP ? p.in[0] + (size_t)tok * DM : p.in[1] + (size_t)(tok - NTP) * DM; }

struct EpiBase { static constexpr bool PERM = false, AFTER_DRAIN = false, HAS_MID = false; static constexpr int MID_T = -1;
    __device__ __forceinline__ void mid(f32x4 (&)[2][2][4][2], const Unit&, int, int, int, int) const {} };

__device__ __forceinline__ void row_ss_add(float* rss, int row, float ss, int fq) {
    ss += __shfl_xor(ss, 16); ss += __shfl_xor(ss, 32);
    if (fq == 0) unsafeAtomicAdd(rss + row, ss);
}

struct EpiInProj : EpiBase {
    bf16_t* P;
    __device__ __forceinline__ void operator()(const f32x4 (&acc)[2][2][4][2], const Unit& u, int wr, int wc, int fr, int fq) const {
        const int row0 = u.pm * 256 + wr * 64 + fr, col0 = u.pn * 256 + wc * 32 + 4 * fq; const bool act = u.pn >= 2;
#pragma unroll
        for (int ai = 0; ai < 2; ++ai)
#pragma unroll
            for (int m = 0; m < 4; ++m) { bf16_t* rowp = P + (size_t)(row0 + ai * 128 + m * 16) * INW + col0;
#pragma unroll
                for (int bj = 0; bj < 2; ++bj)
#pragma unroll
                    for (int n = 0; n < 2; ++n) { f32x4 v = acc[ai][bj][m][n];
                        if (act) { v[0] = gelu_t(v[0]); v[1] = gelu_t(v[1]); v[2] = gelu_t(v[2]); v[3] = gelu_t(v[3]); }
                        u32x2 w; w.x = pk2(v[0], v[1]); w.y = pk2(v[2], v[3]); *(u32x2*)(rowp + bj * 128 + n * 16) = w; } }
    }
};
struct EpiGlu : EpiBase {
    const bf16_t* G; bf16_t* MIX; const float* bglu; float* rss;
    __device__ __forceinline__ void operator()(const f32x4 (&acc)[2][2][4][2], const Unit& u, int wr, int wc, int fr, int fq) const {
        const int row0 = u.pm * 256 + wr * 64 + fr, col0 = u.pn * 256 + wc * 32 + 4 * fq;
        f32x4 bv[2][2];
#pragma unroll
        for (int bj = 0; bj < 2; ++bj)
#pragma unroll
            for (int n = 0; n < 2; ++n) bv[bj][n] = *(const f32x4*)(bglu + col0 + bj * 128 + n * 16);
#pragma unroll
        for (int ai = 0; ai < 2; ++ai)
#pragma unroll
            for (int m = 0; m < 4; ++m) { const int row = row0 + ai * 128 + m * 16; float ss = 0.f;
#pragma unroll
                for (int bj = 0; bj < 2; ++bj)
#pragma unroll
                    for (int n = 0; n < 2; ++n) { const int c = col0 + bj * 128 + n * 16; const f32x4 z = acc[ai][bj][m][n] + bv[bj][n];
                        const u32x2 gw = *(const u32x2*)(G + (size_t)row * 512 + c);
                        const float o0 = bflo(gw.x) * sigmoidf_(z[0]), o1 = bfhi(gw.x) * sigmoidf_(z[1]), o2 = bflo(gw.y) * sigmoidf_(z[2]), o3 = bfhi(gw.y) * sigmoidf_(z[3]);
                        ss += o0 * o0 + o1 * o1 + o2 * o2 + o3 * o3;
                        u32x2 w; w.x = pk2(o0, o1); w.y = pk2(o2, o3); *(u32x2*)(MIX + (size_t)row * DM + c) = w; }
                row_ss_add(rss, row, ss, fq); }
    }
};
struct EpiOutProj : EpiBase {
    static constexpr bool HAS_MID = true; static constexpr int MID_T = 8;
    const float* xp; const float* xs; float* X2; bf16_t* X2B; float* rss2; const LAS float* fl; int pm0, pn0;
    __device__ __forceinline__ void mid(f32x4 (&acc)[2][2][4][2], const Unit& u, int wr, int wc, int fr, int fq) const {
        const LAS float* f0 = fl + ((u.pm == pm0 && u.pn == pn0) ? 0 : 256) + wr * 64 + fr;
#pragma unroll
        for (int ai = 0; ai < 2; ++ai)
#pragma unroll
            for (int m = 0; m < 4; ++m) { const float f = f0[ai * 128 + m * 16];
#pragma unroll
                for (int bj = 0; bj < 2; ++bj)
#pragma unroll
                    for (int n = 0; n < 2; ++n) acc[ai][bj][m][n] = acc[ai][bj][m][n] * f; }
    }
    __device__ __forceinline__ void operator()(const f32x4 (&acc)[2][2][4][2], const Unit& u, int wr, int wc, int fr, int fq) const {
        const int row0 = u.pm * 256 + wr * 64 + fr, col0 = u.pn * 256 + wc * 32 + 4 * fq;
        const LAS float* r0 = fl + 512 + ((u.pm == pm0 && u.pn == pn0) ? 0 : 256) + wr * 64 + fr;
#pragma unroll
        for (int ai = 0; ai < 2; ++ai)
#pragma unroll
            for (int m = 0; m < 4; ++m) { const int row = row0 + ai * 128 + m * 16; float ss = 0.f;
                const float rc = r0[ai * 128 + m * 16];
                const float* xr = row < NTP ? xp + (size_t)row * DM : xs + (size_t)(row - NTP) * DM;
#pragma unroll
                for (int bj = 0; bj < 2; ++bj)
#pragma unroll
                    for (int n = 0; n < 2; ++n) { const int c = col0 + bj * 128 + n * 16; const f32x4 xv = *(const f32x4*)(xr + c);
                        const f32x4 v = xv + acc[ai][bj][m][n] * rc; ss += v[0] * v[0] + v[1] * v[1] + v[2] * v[2] + v[3] * v[3];
                        *(f32x4*)(X2 + (size_t)row * DM + c) = v; u32x2 w; w.x = pk2(v[0], v[1]); w.y = pk2(v[2], v[3]); *(u32x2*)(X2B + (size_t)row * DM + c) = w; }
                row_ss_add(rss2, row, ss, fq); }
    }
};
struct EpiGateUp : EpiBase {
    bf16_t* ACT; const float* rss2;
    __device__ __forceinline__ void operator()(const f32x4 (&acc)[2][2][4][2], const Unit& u, int wr, int wc, int fr, int fq) const {
        const int row0 = u.pm * 256 + wr * 64 + fr, f0 = u.pn * 128 + wc * 32 + 4 * fq;
#pragma unroll
        for (int ai = 0; ai < 2; ++ai)
#pragma unroll
            for (int m = 0; m < 4; ++m) { const int row = row0 + ai * 128 + m * 16; const float r2 = rsqrtf(rss2[row] * (1.f / 1024.f) + EPSV);
#pragma unroll
                for (int n = 0; n < 2; ++n) { const f32x4 g = acc[ai][0][m][n] * r2, up = acc[ai][1][m][n] * r2; float o[4];
#pragma unroll
                    for (int j = 0; j < 4; ++j) o[j] = g[j] * sigmoidf_(g[j]) * up[j];
                    u32x2 w; w.x = pk2(o[0], o[1]); w.y = pk2(o[2], o[3]); *(u32x2*)(ACT + (size_t)row * DFF + f0 + n * 16) = w; } }
    }
};
struct EpiDown : EpiBase {
    float* X; float* rss3;
    __device__ __forceinline__ void operator()(const f32x4 (&acc)[2][2][4][2], const Unit& u, int wr, int wc, int fr, int fq) const {
        const int row0 = u.pm * 256 + wr * 64 + fr, col0 = u.pn * 256 + wc * 32 + 4 * fq;
#pragma unroll
        for (int ai = 0; ai < 2; ++ai)
#pragma unroll
            for (int m = 0; m < 4; ++m) { const int row = row0 + ai * 128 + m * 16; float ss = 0.f;
#pragma unroll
                for (int bj = 0; bj < 2; ++bj)
#pragma unroll
                    for (int n = 0; n < 2; ++n) { float* px = X + (size_t)row * DM + col0 + bj * 128 + n * 16; const f32x4 v = *(const f32x4*)px + acc[ai][bj][m][n];
                        ss += v[0] * v[0] + v[1] * v[1] + v[2] * v[2] + v[3] * v[3]; *(f32x4*)px = v; }
                row_ss_add(rss3, row, ss, fq); }
    }
};

__device__ __forceinline__ void p0_transpose_item(const float* W, int K, int N, bf16_t* WT, int mode, int bjoff, const float* ks1, const float* ks2, int ksplit, LAS float* scr, int item, int lane) {
    const int nblk = N / 32, kb = item / nblk, nb = item % nblk, k0 = 64 * kb, n0 = 32 * nb;
#pragma unroll 8
    for (int i = 0; i < 32; ++i) { const int kk = 2 * i + (lane >> 5), k = k0 + kk; float sc = 1.f; if (ks1) sc = k < ksplit ? ks1[k] : ks2[k - ksplit];
        scr[kk * 33 + (lane & 31)] = W[(size_t)k * N + n0 + (lane & 31)] * sc; }
    LDS_WAIT();
    const int c = lane & 7;
#pragma unroll
    for (int j = 0; j < 4; ++j) { const int n = (lane >> 3) + 8 * j; const LAS float* s = scr + (8 * c) * 33 + n; const int nn = n0 + n;
        const int row = mode ? (((nn >> 7) << 8) + bjoff + (nn & 127)) : nn;
        u32x4 o; o.x = pk2(s[0 * 33], s[1 * 33]); o.y = pk2(s[2 * 33], s[3 * 33]); o.z = pk2(s[4 * 33], s[5 * 33]); o.w = pk2(s[6 * 33], s[7 * 33]);
        *(u32x4*)(WT + (size_t)row * K + k0 + 8 * c) = o; }
    LDS_WAIT();
}

__device__ __forceinline__ void phase0(const Params& p, LAS unsigned char* lds) {
    const int tid = threadIdx.x, lane = tid & 63, wave = tid >> 6;
    const int gw = blockIdx.x * 8 + wave, NGW = gridDim.x * 8;
    unsigned char* ws = p.ws;
    {   bf16_t* XH = (bf16_t*)(ws + W_XH); const f32x4* g4 = (const f32x4*)p.in[4] + lane;
        for (int tok = gw; tok < MTOK; tok += NGW) { const f32x4* xr = (const f32x4*)xrow_ptr(p, tok) + lane; f32x4 v[4]; float s = 0.f;
#pragma unroll
            for (int j = 0; j < 4; ++j) { v[j] = xr[64 * j]; s += (v[j][0] * v[j][0] + v[j][1] * v[j][1]) + (v[j][2] * v[j][2] + v[j][3] * v[j][3]); }
            const float r = rsqrtf(wave_sum(s) * (1.f / 1024.f) + EPSV);
            u32x2* o8 = (u32x2*)(XH + (size_t)tok * DM) + lane;
#pragma unroll
            for (int j = 0; j < 4; ++j) { const f32x4 g = g4[64 * j]; u32x2 w; w.x = pk2(v[j][0] * r * g[0], v[j][1] * r * g[1]); w.y = pk2(v[j][2] * r * g[2], v[j][3] * r * g[3]); o8[64 * j] = w; } }
    }
    {   LAS float* scr = (LAS float*)(lds + wave * 8448);
        constexpr int I_IN = 16 * 48, I_GLU = 8 * 16, I_OUT = 16 * 32, I_G = 16 * 88, I_DN = 44 * 32, NIT = I_IN + I_GLU + I_OUT + 2 * I_G + I_DN;
        for (int it = gw; it < NIT; it += NGW) { int r = it;
            if (r < I_IN) { p0_transpose_item(p.in[5], 1024, 1536, (bf16_t*)(ws + W_BTIN), 0, 0, nullptr, nullptr, 0, scr, r, lane); continue; } r -= I_IN;
            if (r < I_GLU) { p0_transpose_item(p.in[14], 512, 512, (bf16_t*)(ws + W_BTGLU), 0, 0, nullptr, nullptr, 0, scr, r, lane); continue; } r -= I_GLU;
            if (r < I_OUT) { p0_transpose_item(p.in[22], 1024, 1024, (bf16_t*)(ws + W_BTOUT), 0, 0, p.in[20], p.in[21], 512, scr, r, lane); continue; } r -= I_OUT;
            if (r < I_G) { p0_transpose_item(p.in[24], 1024, 2816, (bf16_t*)(ws + W_BTGU), 1, 0, p.in[23], p.in[23], 1024, scr, r, lane); continue; } r -= I_G;
            if (r < I_G) { p0_transpose_item(p.in[25], 1024, 2816, (bf16_t*)(ws + W_BTGU), 1, 128, p.in[23], p.in[23], 1024, scr, r, lane); continue; } r -= I_G;
            p0_transpose_item(p.in[26], 2816, 1024, (bf16_t*)(ws + W_BTDN), 0, 0, nullptr, nullptr, 0, scr, r, lane); }
    }
    const int gt = blockIdx.x * 512 + tid, NGT = gridDim.x * 512;
    for (int idx = gt; idx < 2048; idx += NGT) { const int g = idx >> 6;
        const float dt = expf(p.in[8][g]), lr = p.in[6][idx], li = p.in[7][idx];
        const float mag = expf(lr * dt), ar = mag * cosf(li * dt), ai = mag * sinf(li * dt), den = lr * lr + li * li;
        const float qr = ((ar - 1.0f) * lr + ai * li) / den, qi = (ai * lr - (ar - 1.0f) * li) / den;
        float* AT = (float*)(ws + W_ATAB); AT[idx * 2] = ar; AT[idx * 2 + 1] = ai;
        bf16_t* BB = (bf16_t*)(ws + W_BBT); const int n = idx & 63;
#pragma unroll
        for (int i = 0; i < 16; i += 2) { const float br0 = p.in[9][idx * 16 + i], bi0 = p.in[10][idx * 16 + i], br1 = p.in[9][idx * 16 + i + 1], bi1 = p.in[10][idx * 16 + i + 1];
            *(unsigned*)(BB + ((size_t)(g * 2 + 0) * 64 + n) * 16 + i) = pk2(qr * br0 - qi * bi0, qr * br1 - qi * bi1);
            *(unsigned*)(BB + ((size_t)(g * 2 + 1) * 64 + n) * 16 + i) = pk2(qr * bi0 + qi * br0, qr * bi1 + qi * br1); } }
    for (int idx = gt; idx < 32768; idx += NGT) { const int g = idx >> 10, o = (idx >> 6) & 15, kp = (idx & 63) * 2;
        const int c5 = kp >> 2, e = kp & 3; const size_t base = ((size_t)(g * 16 + o)) * 64;
        float v0, v1; if (e == 0) { v0 = p.in[11][base + c5]; v1 = p.in[11][base + c5 + 32]; } else { v0 = -p.in[12][base + c5]; v1 = -p.in[12][base + c5 + 32]; }
        *(unsigned*)((bf16_t*)(ws + W_CMT) + ((size_t)(g * 16 + o)) * 128 + kp) = pk2(v0, v1); }
    for (int idx = gt; idx < 131072; idx += NGT) { const int which = idx >> 16, h = (idx >> 13) & 7, t = (idx >> 6) & 127, s = (idx & 63) * 2; const float* wsr = p.in[18] + (size_t)h * 16384;
        float v0, v1;
        if (which == 0) { v0 = s <= t ? wsr[t * 128 + s] : 0.f; v1 = (s + 1) <= t ? wsr[t * 128 + s + 1] : 0.f; }
        else { const bool same = (t >> 3) == (s >> 3); const int tt = t & 7, s0 = s & 7; v0 = (same && s0 <= tt) ? wsr[tt * 128 + s0] : 0.f; v1 = (same && (s0 + 1) <= tt) ? wsr[tt * 128 + s0 + 1] : 0.f; }
        *(unsigned*)((bf16_t*)(ws + (which ? W_WTS : W_WTP)) + (size_t)h * 16384 + t * 128 + s) = pk2(v0, v1); }
    for (int idx = gt; idx < 4 * MTOK; idx += NGT) ((float*)(ws + W_RSS))[idx] = 0.f;
}

constexpr int HT_STRIDE = 272, HT_WAVE = 32 * HT_STRIDE, SSEG_OFF = 8 * HT_WAVE;
struct S5Ctx { bf16x8 Bf[4]; bf16x8 Cf[4]; float ar0, ai0, ar1, ai1; float dsk[4]; };

__device__ __forceinline__ void s5_bu(const bf16_t* P, const S5Ctx& c, int g, int tokA, int tokB, int lane, f32x16 (&acc)[4]) {
    const int rho = lane & 31, half = (rho >> 2) & 1, r = 4 * (rho >> 3) + (rho & 3);
    const int tok = (half ? tokB : tokA) + r;
    const bf16x8 a = *(const bf16x8*)(P + (size_t)tok * INW + g * 16 + 8 * (lane >> 5));
#pragma unroll
    for (int j = 0; j < 4; ++j) { f32x16 z;
#pragma unroll
        for (int i = 0; i < 16; ++i) z[i] = 0.f;
        acc[j] = __builtin_amdgcn_mfma_f32_32x32x16_bf16(a, c.Bf[j], z, 0, 0, 0); }
}
#define S5_STEP(r) do { const float nr0 = c.ar0 * hr0 - c.ai0 * hi0 + acc[0][r], ni0 = c.ar0 * hi0 + c.ai0 * hr0 + acc[2][r]; \
        const float nr1 = c.ar1 * hr1 - c.ai1 * hi1 + acc[1][r], ni1 = c.ar1 * hi1 + c.ai1 * hr1 + acc[3][r]; hr0 = nr0; hi0 = ni0; hr1 = nr1; hi1 = ni1; } while (0)

__device__ __forceinline__ void s5_y(const bf16_t* P, bf16_t* GB, const S5Ctx& c, int g, int tokA, int tokB, int lane, LAS unsigned char* ht) {
    const int cc = lane & 15, q = lane >> 4;
#pragma unroll
    for (int t16 = 0; t16 < 2; ++t16) { f32x4 y = {0.f, 0.f, 0.f, 0.f};
#pragma unroll
        for (int ks = 0; ks < 4; ++ks) { const bf16x8 b = *(const LAS bf16x8*)(ht + (16 * t16 + cc) * HT_STRIDE + 64 * ks + 16 * q);
            y = __builtin_amdgcn_mfma_f32_16x16x32_bf16(c.Cf[ks], b, y, 0, 0, 0); }
        const int tok = (t16 ? tokB : tokA) + cc;
        const u32x2 xw = *(const u32x2*)(P + (size_t)tok * INW + g * 16 + 4 * q);
        const float o0 = gelu_t(y[0] + c.dsk[0] * bflo(xw.x)), o1 = gelu_t(y[1] + c.dsk[1] * bfhi(xw.x)), o2 = gelu_t(y[2] + c.dsk[2] * bflo(xw.y)), o3 = gelu_t(y[3] + c.dsk[3] * bfhi(xw.y));
        u32x2 w; w.x = pk2(o0, o1); w.y = pk2(o2, o3); *(u32x2*)(GB + (size_t)tok * 512 + g * 16 + 4 * q) = w; }
}
__device__ __forceinline__ void s5_load_ctx(const Params& p, S5Ctx& c, int g, int lane) {
    const unsigned char* ws = p.ws; const int c5 = lane & 31, hh = lane >> 5;
    const float* AT = (const float*)(ws + W_ATAB) + (size_t)g * 128; c.ar0 = AT[c5 * 2]; c.ai0 = AT[c5 * 2 + 1]; c.ar1 = AT[(c5 + 32) * 2]; c.ai1 = AT[(c5 + 32) * 2 + 1];
    const bf16_t* BB = (const bf16_t*)(ws + W_BBT);
#pragma unroll
    for (int j = 0; j < 4; ++j) c.Bf[j] = *(const bf16x8*)(BB + ((size_t)(g * 2 + (j >> 1)) * 64 + 32 * (j & 1) + c5) * 16 + 8 * hh);
    const bf16_t* CM = (const bf16_t*)(ws + W_CMT) + ((size_t)(g * 16 + (lane & 15))) * 128;
#pragma unroll
    for (int ks = 0; ks < 4; ++ks) c.Cf[ks] = *(const bf16x8*)(CM + 32 * ks + 8 * (lane >> 4));
#pragma unroll
    for (int j = 0; j < 4; ++j) c.dsk[j] = p.in[13][g * 16 + 4 * (lane >> 4) + j];
}
#define S5_WRITE(r) do { u32x2 w; w.x = pk2(hr0, hr1); w.y = pk2(hi0, hi1); *(LAS u32x2*)(ht + (16 * hh + (r)) * HT_STRIDE + 8 * c5) = w; } while (0)

__device__ __forceinline__ void s5_prompt_item(const Params& p, int item, LAS unsigned char* lds) {
    const int tid = threadIdx.x, lane = tid & 63, wave = tid >> 6, c5 = lane & 31, hh = lane >> 5;
    const int b = item >> 5, g = item & 31, seqbase = b * 2048;
    const bf16_t* P = (const bf16_t*)(p.ws + W_PBUF); bf16_t* GB = (bf16_t*)(p.ws + W_GBUF);
    S5Ctx c; s5_load_ctx(p, c, g, lane);
    LAS unsigned char* ht = lds + wave * HT_WAVE; LAS float* sseg = (LAS float*)(lds + SSEG_OFF);
    float hr0 = 0.f, hi0 = 0.f, hr1 = 0.f, hi1 = 0.f; f32x16 acc[4];
    const int tbase = seqbase + 256 * wave;
    for (int tile = 0; tile < 8; ++tile) { const int tokA = tbase + 16 * tile, tokB = tokA + 128;
        s5_bu(P, c, g, tokA, tokB, lane, acc);
#pragma unroll
        for (int r = 0; r < 16; ++r) S5_STEP(r); }
    const int seg = 2 * wave + hh;
    sseg[(seg * 64 + c5) * 2] = hr0; sseg[(seg * 64 + c5) * 2 + 1] = hi0; sseg[(seg * 64 + c5 + 32) * 2] = hr1; sseg[(seg * 64 + c5 + 32) * 2 + 1] = hi1;
    float pr0 = c.ar0, pi0 = c.ai0, pr1 = c.ar1, pi1 = c.ai1;
#pragma unroll
    for (int i = 0; i < 7; ++i) { const float t0 = pr0 * pr0 - pi0 * pi0, u0 = 2.f * pr0 * pi0, t1 = pr1 * pr1 - pi1 * pi1, u1 = 2.f * pr1 * pi1; pr0 = t0; pi0 = u0; pr1 = t1; pi1 = u1; }
    __syncthreads();
    hr0 = hi0 = hr1 = hi1 = 0.f;
    for (int j = 0; j < seg; ++j) { const float s0r = sseg[(j * 64 + c5) * 2], s0i = sseg[(j * 64 + c5) * 2 + 1], s1r = sseg[(j * 64 + c5 + 32) * 2], s1i = sseg[(j * 64 + c5 + 32) * 2 + 1];
        const float nr0 = pr0 * hr0 - pi0 * hi0 + s0r, ni0 = pr0 * hi0 + pi0 * hr0 + s0i, nr1 = pr1 * hr1 - pi1 * hi1 + s1r, ni1 = pr1 * hi1 + pi1 * hr1 + s1i; hr0 = nr0; hi0 = ni0; hr1 = nr1; hi1 = ni1; }
    for (int tile = 0; tile < 8; ++tile) { const int tokA = tbase + 16 * tile, tokB = tokA + 128;
        s5_bu(P, c, g, tokA, tokB, lane, acc);
#pragma unroll
        for (int r = 0; r < 16; ++r) { S5_STEP(r); S5_WRITE(r); }
        LDS_WAIT();
        s5_y(P, GB, c, g, tokA, tokB, lane, ht);
        LDS_WAIT(); }
    if (seg == 15) { float* ore = p.out + O_PRE + (size_t)(b * 32 + g) * 64; float* oim = p.out + O_PIM + (size_t)(b * 32 + g) * 64;
        ore[c5] = hr0; ore[c5 + 32] = hr1; oim[c5] = hi0; oim[c5 + 32] = hi1; }
    __syncthreads();
}
__device__ __forceinline__ void s5_sample_item(const Params& p, int item, LAS unsigned char* lds) {
    const int tid = threadIdx.x, lane = tid & 63, wave = tid >> 6, c5 = lane & 31, hh = lane >> 5;
    const int g = item >> 2, qq = item & 3;
    const bf16_t* P = (const bf16_t*)(p.ws + W_PBUF); bf16_t* GB = (bf16_t*)(p.ws + W_GBUF);
    S5Ctx c; s5_load_ctx(p, c, g, lane);
    LAS unsigned char* ht = lds + wave * HT_WAVE;
    const int b0 = 32 * qq + 4 * wave, tokA = NTP + 8 * b0, tokB = tokA + 16, bA = b0 + 2 * hh;
    float hr0, hi0, hr1, hi1; f32x16 acc[4];
    s5_bu(P, c, g, tokA, tokB, lane, acc);
#pragma unroll
    for (int half = 0; half < 2; ++half) { const size_t so = ((size_t)(bA + half) * 32 + g) * 64;
        hr0 = p.in[2][so + c5]; hr1 = p.in[2][so + c5 + 32]; hi0 = p.in[3][so + c5]; hi1 = p.in[3][so + c5 + 32];
#pragma unroll
        for (int r8 = 0; r8 < 8; ++r8) { S5_STEP(half * 8 + r8); S5_WRITE(half * 8 + r8); }
        p.out[O_SRE + so + c5] = hr0; p.out[O_SRE + so + c5 + 32] = hr1; p.out[O_SIM + so + c5] = hi0; p.out[O_SIM + so + c5 + 32] = hi1; }
    LDS_WAIT();
    s5_y(P, GB, c, g, tokA, tokB, lane, ht);
    LDS_WAIT();
    __syncthreads();
}

__device__ __forceinline__ void cm_item(const Params& p, int item, LAS unsigned char* lds) {
    const int tid = threadIdx.x, lane = tid & 63, wave = tid >> 6;
    const bool sample = item >= 128; int tok0; float* vout = nullptr; const bf16_t* WT; int tmask;
    if (!sample) { const int b = item >> 4, cidx = item & 15; tok0 = b * 2048 + 128 * cidx; if (cidx == 15) vout = p.out + O_PV + (size_t)b * 128 * 512; WT = (const bf16_t*)(p.ws + W_WTP); tmask = 127; }
    else { const int j = item - 128; tok0 = NTP + 128 * j; vout = p.out + O_SV + (size_t)j * 128 * 512; WT = (const bf16_t*)(p.ws + W_WTS); tmask = 7; }
    const bf16_t* P = (const bf16_t*)(p.ws + W_PBUF); bf16_t* MIX = (bf16_t*)(p.ws + W_MIX); float* rss_cm = (float*)(p.ws + W_RSS) + MTOK;
    {   float lg[8], lb[8];
#pragma unroll
        for (int j = 0; j < 8; ++j) { lg[j] = p.in[16][8 * lane + j]; lb[j] = p.in[17][8 * lane + j]; }
        for (int i = 0; i < 8; ++i) { const int s = 16 * wave + 2 * i; float v[2][8];
#pragma unroll
            for (int e = 0; e < 2; ++e) { const u32x4 raw = *(const u32x4*)(P + (size_t)(tok0 + s + e) * INW + 1024 + 8 * lane);
                v[e][0] = bflo(raw.x); v[e][1] = bfhi(raw.x); v[e][2] = bflo(raw.y); v[e][3] = bfhi(raw.y); v[e][4] = bflo(raw.z); v[e][5] = bfhi(raw.z); v[e][6] = bflo(raw.w); v[e][7] = bfhi(raw.w);
                float sm = 0.f;
#pragma unroll
                for (int j = 0; j < 8; ++j) sm += v[e][j];
                const float mu = wave_sum(sm) * (1.f / 512.f); float s2 = 0.f;
#pragma unroll
                for (int j = 0; j < 8; ++j) { v[e][j] -= mu; s2 += v[e][j] * v[e][j]; }
                const float rs = rsqrtf(wave_sum(s2) * (1.f / 512.f) + EPSV);
#pragma unroll
                for (int j = 0; j < 8; ++j) v[e][j] = v[e][j] * rs * lg[j] + lb[j];
                if (vout) { float* vo = vout + (size_t)(s + e) * 512 + 8 * lane; *(f32x4*)vo = (f32x4){v[e][0], v[e][1], v[e][2], v[e][3]}; *(f32x4*)(vo + 4) = (f32x4){v[e][4], v[e][5], v[e][6], v[e][7]}; } }
            const int chunk = (s >> 3) ^ (lane & 15);
#pragma unroll
            for (int j = 0; j < 8; ++j) *(LAS unsigned*)(lds + (8 * lane + j) * 256 + chunk * 16 + (s & 7) * 2) = pk2(v[0][j], v[1][j]); }
    }
    __syncthreads();
    {   const int h = wave, cc = lane & 15, q = lane >> 4;
        bf16x8 Af[4][4];
#pragma unroll
        for (int dt = 0; dt < 4; ++dt)
#pragma unroll
            for (int ks = 0; ks < 4; ++ks) { const int d = 64 * h + 16 * dt + cc; Af[dt][ks] = *(const LAS bf16x8*)(lds + d * 256 + (((4 * ks + q) ^ ((d >> 3) & 15)) * 16)); }
        const bf16_t* Wh = WT + (size_t)h * 16384; const float* bs = p.in[19] + h * 128;
#pragma unroll
        for (int tt = 0; tt < 8; ++tt) { const int t = 16 * tt + cc; f32x4 acc[4];
#pragma unroll
            for (int dt = 0; dt < 4; ++dt) acc[dt] = (f32x4){0.f, 0.f, 0.f, 0.f};
#pragma unroll
            for (int ks = 0; ks < 4; ++ks) if (ks <= (tt >> 1)) { const bf16x8 bw = *(const bf16x8*)(Wh + t * 128 + 32 * ks + 8 * q);
#pragma unroll
                for (int dt = 0; dt < 4; ++dt) acc[dt] = __builtin_amdgcn_mfma_f32_16x16x32_bf16(Af[dt][ks], bw, acc[dt], 0, 0, 0); }
            const float bias = bs[t & tmask]; float ss = 0.f; const size_t tok = (size_t)(tok0 + t);
#pragma unroll
            for (int dt = 0; dt < 4; ++dt) { const int d = 64 * h + 16 * dt + 4 * q; const u32x2 uw = *(const u32x2*)(P + tok * INW + 512 + d);
                const float o0 = bflo(uw.x) * (acc[dt][0] + bias), o1 = bfhi(uw.x) * (acc[dt][1] + bias), o2 = bflo(uw.y) * (acc[dt][2] + bias), o3 = bfhi(uw.y) * (acc[dt][3] + bias);
                ss += o0 * o0 + o1 * o1 + o2 * o2 + o3 * o3; u32x2 w; w.x = pk2(o0, o1); w.y = pk2(o2, o3); *(u32x2*)(MIX + tok * DM + 512 + d) = w; }
            ss += __shfl_xor(ss, 16); ss += __shfl_xor(ss, 32);
            if (q == 0) unsafeAtomicAdd(rss_cm + tok0 + t, ss); }
    }
    __syncthreads();
}

__device__ __forceinline__ void phase2(const Params& p, LAS unsigned char* lds) {
    for (int it = blockIdx.x; it < 256 + 128 + 136; it += gridDim.x) {
        if (it < 256) s5_prompt_item(p, it, lds);
        else if (it < 384) s5_sample_item(p, it - 256, lds);
        else cm_item(p, it - 384, lds);
    }
}
__device__ __forceinline__ void phase7(const Params& p) {
    const int tid = threadIdx.x, lane = tid & 63, wave = tid >> 6, gw = blockIdx.x * 8 + wave, NGW = gridDim.x * 8;
    const float* rss3 = (const float*)(p.ws + W_RSS) + 3 * MTOK; const f32x4* nf = (const f32x4*)p.in[27] + lane;
    f32x4 g[4];
#pragma unroll
    for (int j = 0; j < 4; ++j) g[j] = nf[64 * j];
    for (int tok = gw; tok < MTOK; tok += NGW) { f32x4* xr = (f32x4*)(p.out + (size_t)tok * DM) + lane; const float r = rsqrtf(rss3[tok] * (1.f / 1024.f) + EPSV);
#pragma unroll
        for (int j = 0; j < 4; ++j) { f32x4 v = xr[64 * j]; xr[64 * j] = v * r * g[j]; } }
}

__global__ __launch_bounds__(512, 2) void mega_fwd(Params p) {
    extern __shared__ __attribute__((aligned(16))) unsigned char shm_raw[];
    LAS unsigned char* lds = (LAS unsigned char*)shm_raw;
    cg::grid_group grid = cg::this_grid();
    unsigned char* ws = p.ws; float* rss = (float*)(ws + W_RSS);
    pg8::StaticOrder S;
#define PH_BEGIN(n) if ((PHMASK & (1 << n)) && p.ph_lo <= n && n < p.ph_hi) { if (n > p.ph_lo) grid.sync();
#define PH_END }
    PH_BEGIN(0) phase0(p, lds); PH_END
    PH_BEGIN(1) pg8::Gemm g{(const bf16_t*)(ws + W_XH), (const bf16_t*)(ws + W_BTIN), MTOK, INW, 1024}; S.init(g.M, g.N, gridDim.x, blockIdx.x);
        EpiInProj E; E.P = (bf16_t*)(ws + W_PBUF); pg8::gemm_phase<EpiInProj, pg8::StaticOrder, false>(lds, g, S, E, nullptr); PH_END
    PH_BEGIN(2) phase2(p, lds); PH_END
    PH_BEGIN(3) pg8::Gemm g{(const bf16_t*)(ws + W_GBUF), (const bf16_t*)(ws + W_BTGLU), MTOK, 512, 512}; S.init(g.M, g.N, gridDim.x, blockIdx.x);
        EpiGlu E; E.G = (const bf16_t*)(ws + W_GBUF); E.MIX = (bf16_t*)(ws + W_MIX); E.bglu = p.in[15]; E.rss = rss;
        pg8::gemm_phase<EpiGlu, pg8::StaticOrder, false>(lds, g, S, E, nullptr); PH_END
    PH_BEGIN(4) pg8::Gemm g{(const bf16_t*)(ws + W_MIX), (const bf16_t*)(ws + W_BTOUT), MTOK, 1024, 1024}; S.init(g.M, g.N, gridDim.x, blockIdx.x);
        EpiOutProj E; E.xp = p.in[0]; E.xs = p.in[1]; E.X2 = p.out; E.X2B = (bf16_t*)(ws + W_X2B); E.rss2 = rss + 2 * MTOK;
        LAS float* fl = (LAS float*)(lds + 131072); E.fl = fl; E.pm0 = -1; E.pn0 = -1;
        for (int i = 0; i < 2; ++i) { Unit u; if (S.next(i, u)) { if (i == 0) { E.pm0 = u.pm; E.pn0 = u.pn; }
            if (threadIdx.x < 256) { const int row = u.pm * 256 + threadIdx.x; const float a = rss[row] * (1.f / 512.f) + EPSV, b = rss[MTOK + row] * (1.f / 512.f) + EPSV;
                fl[i * 256 + threadIdx.x] = sqrtf(b / a); fl[512 + i * 256 + threadIdx.x] = rsqrtf(b); } } }
        __syncthreads();
        pg8::gemm_phase<EpiOutProj, pg8::StaticOrder, false>(lds, g, S, E, nullptr); PH_END
    PH_BEGIN(5) pg8::Gemm g{(const bf16_t*)(ws + W_X2B), (const bf16_t*)(ws + W_BTGU), MTOK, 2 * DFF, 1024}; S.init(g.M, g.N, gridDim.x, blockIdx.x);
        EpiGateUp E; E.ACT = (bf16_t*)(ws + W_ACT); E.rss2 = rss + 2 * MTOK;
        pg8::gemm_phase<EpiGateUp, pg8::StaticOrder, false>(lds, g, S, E, nullptr); PH_END
    PH_BEGIN(6) pg8::Gemm g{(const bf16_t*)(ws + W_ACT), (const bf16_t*)(ws + W_BTDN), MTOK, 1024, DFF}; S.init(g.M, g.N, gridDim.x, blockIdx.x);
        EpiDown E; E.X = p.out; E.rss3 = rss + 3 * MTOK;
        pg8::gemm_phase<EpiDown, pg8::StaticOrder, false>(lds, g, S, E, nullptr); PH_END
    PH_BEGIN(7) phase7(p); PH_END
}

extern "C" void kernel_launch(void* const* d_in, const int* in_sizes, int n_in, void* d_out, int out_size, void* d_ws, size_t ws_size, hipStream_t stream) {
    static int grid = 0;
    if (grid == 0) {
        if (n_in != 28 || ws_size < W_END) { fprintf(stderr, "kernel_launch: unexpected n_in %d / ws %zu (need %zu)\n", n_in, ws_size, (size_t)W_END); grid = -1; return; }
        int dev = 0, cus = 0, per_cu = 0;
        if (hipGetDevice(&dev) != hipSuccess || hipDeviceGetAttribute(&cus, hipDeviceAttributeMultiprocessorCount, dev) != hipSuccess) { grid = -1; return; }
        if (hipFuncSetAttribute((const void*)mega_fwd, hipFuncAttributeMaxDynamicSharedMemorySize, LDS_BYTES) != hipSuccess) { fprintf(stderr, "kernel_launch: hipFuncSetAttribute failed\n"); grid = -1; return; }
        if (hipOccupancyMaxActiveBlocksPerMultiprocessor(&per_cu, (const void*)mega_fwd, 512, LDS_BYTES) != hipSuccess || per_cu < 1) { fprintf(stderr, "kernel_launch: occupancy query says %d\n", per_cu); per_cu = 1; }
        (void)hipGetLastError();
        grid = cus * 1;
    }
    if (grid < 0) return;
    Params p{};
    for (int i = 0; i < 28; ++i) p.in[i] = (const float*)d_in[i];
    p.out = (float*)d_out; p.ws = (unsigned char*)d_ws;
#if MK_MULTI_LAUNCH
    for (int ph = 0; ph < 8; ++ph) { p.ph_lo = ph; p.ph_hi = ph + 1; hipLaunchKernelGGL(mega_fwd, dim3(grid), dim3(512), LDS_BYTES, stream, p); }
#else
    p.ph_lo = 0; p.ph_hi = 8;
    void* args[] = {&p};
    hipError_t e = hipLaunchCooperativeKernel((const void*)mega_fwd, dim3(grid), dim3(512), args, LDS_BYTES, stream);
    if (e != hipSuccess) fprintf(stderr, "kernel_launch: cooperative launch failed: %s (grid %d)\n", hipGetErrorString(e), grid);
#endif
}
```

```cpp
#include <hip/hip_runtime.h>
#include <hip/hip_cooperative_groups.h>
#include <cstdio>
#include <cstdint>
namespace cg = cooperative_groups;
#ifndef PHMASK
#define PHMASK 255
#endif
#ifndef PROBE_PH
#define PROBE_PH -1
#endif
#ifndef PROBE_P2MASK
#define PROBE_P2MASK 7
#endif
#ifndef PROBE_VAR
#define PROBE_VAR 0
#endif
#ifndef PROBE_N
#define PROBE_N 2
#endif
#ifndef GP_ALIGN
#define GP_ALIGN true
#endif
#ifndef GP_SP2
#define GP_SP2 true
#endif
#ifndef MK_MULTI_LAUNCH
#define MK_MULTI_LAUNCH 0
#endif
namespace pg8 {
#define PG8_LAS __attribute__((address_space(3)))
typedef unsigned short bf16_t;
typedef short bf16x8 __attribute__((ext_vector_type(8)));
typedef float f32x4 __attribute__((ext_vector_type(4)));
typedef unsigned u32x4 __attribute__((ext_vector_type(4)));
constexpr int BM = 256, BK = 64, HALF = 128, HTB = HALF * BK * 2  , STAGE_BYTES = 8 * HTB, NXCD = 8, WGM = 8;

__host__ __device__ __forceinline__ int lds_byte(int r, int c) { const int st = (r >> 4) * 2 + (c >> 5), rr = r & 15, cc = c & 31, ob = rr * 64 + cc * 2; return st * 1024 + (ob ^ (((ob >> 9) & 1) << 5)); }
__host__ __device__ __forceinline__ void stage_rc(int b, int& R, int& C) { const int st = b / 1024, sb = b % 1024, swz = sb ^ (((sb >> 9) & 1) << 5); R = (st >> 1) * 16 + swz / 64; C = (st & 1) * 32 + (swz % 64) / 2; }
__host__ __device__ __forceinline__ int perm32(int rho) { const int n = rho >> 4, i = rho & 15; return 8 * (i >> 2) + 4 * n + (i & 3); }

struct Unit { int pm, pn, ko; };
struct Gemm { const bf16_t* A; const bf16_t* Bt; int M, N, K, ld; };

struct StaticOrder {
    int nM, nN, nwg, G, c;
    __host__ __device__ void init(int M, int N, int G_, int c_) { nM = M / BM; nN = N / BM; nwg = nM * nN; G = G_; c = c_; }
    __host__ __device__ bool next(int i, Unit& u) const {
        const long L = (long)i * G + c; if (L >= nwg) return false;
        int wgid = (int)L; { const int q = nwg / NXCD, r = nwg % NXCD, xcd = wgid % NXCD, off = wgid / NXCD; wgid = (xcd < r ? xcd * (q + 1) : r * (q + 1) + (xcd - r) * q) + off; }
        const int nig = WGM * nN, gid = wgid / nig, fm = gid * WGM, gsz = (nM - fm) < WGM ? (nM - fm) : WGM;
        u.pm = fm + ((wgid % nig) % gsz); u.pn = (wgid % nig) / gsz; u.ko = 0; return true;
    }
    __device__ __forceinline__ void a_ready(const Unit&) const {}
    __device__ __forceinline__ void done(const Unit&) const {}
};
struct SplitKOrder {
    int G, c;
    __host__ __device__ void init(int G_, int c_) { G = G_; c = c_; }
    __host__ __device__ bool next(int i, Unit& u) const { const long L = (long)i * G + c; if (L >= 176) return false; const int ks = (int)L % 11, rem = (int)L / 11; u.pm = 64 + (rem >> 2); u.pn = rem & 3; u.ko = ks * 256; return true; }
    __device__ __forceinline__ void a_ready(const Unit&) const {}
    __device__ __forceinline__ void done(const Unit&) const {}
};
struct GluOrder : StaticOrder {
    unsigned* cnt;
    __device__ __forceinline__ void done(const Unit& u) const {
        asm volatile("s_waitcnt vmcnt(0)" ::: "memory");
        __builtin_amdgcn_fence(__ATOMIC_RELEASE, "agent");
        asm volatile("s_waitcnt vmcnt(0)" ::: "memory");
        if ((threadIdx.x & 63) == 0) __hip_atomic_fetch_add(cnt + 16 * (1 + u.pm), 1u, __ATOMIC_RELAXED, __HIP_MEMORY_SCOPE_AGENT);
    }
};
struct SampleOutOrder {
    int c, base; unsigned* cnt;
    __host__ __device__ bool next(int i, Unit& u) const { if (i != 0 || c < base) return false; const int k = c - base; u.pm = 64 + (k >> 2); u.pn = k & 3; u.ko = 0; return true; }
    __device__ __forceinline__ void a_ready(const Unit&) const {}
    __device__ __forceinline__ void done(const Unit&) const {}
};
struct CountedGU : StaticOrder {
    const unsigned* cnt;
    __device__ __forceinline__ void a_ready(const Unit& u) const {
        if (u.pm >= 64) {
            if (threadIdx.x < 64) {
                for (unsigned sp = 0; sp < (1u << 16); ++sp) { if ((unsigned)__builtin_amdgcn_readfirstlane((int)__hip_atomic_load(cnt, __ATOMIC_RELAXED, __HIP_MEMORY_SCOPE_AGENT)) >= 16u) break; __builtin_amdgcn_s_sleep(2); }
                __builtin_amdgcn_fence(__ATOMIC_ACQUIRE, "agent");
                asm volatile("s_waitcnt vmcnt(0)" ::: "memory");
            }
            asm volatile("" ::: "memory"); __builtin_amdgcn_s_barrier(); asm volatile("" ::: "memory");
        }
    }
};
template <class Epi, class Sched, bool ALIGN_EPI = false, bool SP2 = false>
__device__ __forceinline__ void gemm_phase(PG8_LAS unsigned char* lds, const Gemm g, const Sched& S, const Epi& E) {
    const int tid = threadIdx.x, wid = __builtin_amdgcn_readfirstlane(tid >> 6), lane = tid & 63, wr = wid >> 2, wc = wid & 3, fr = lane & 15, fq = lane >> 4;
    const int K = g.K, nt = K / BK, LD = g.ld;
    unsigned voffA[2], voffB[2];
#pragma unroll
    for (int i = 0; i < 2; ++i) { int R, C; stage_rc(tid * 16 + i * 8192, R, C); const int Rb = Epi::PERM ? ((R & ~31) + perm32(R & 31)) : R;
        voffA[i] = (unsigned)(R * LD + C) * 2u; voffB[i] = (unsigned)(Rb * LD + C) * 2u; }
    const size_t kstep = (size_t)(BK * 2);
    const size_t hstep = (size_t)HALF * LD * 2;
    const size_t tstep = 2 * hstep;
    const unsigned ldsw = (unsigned)wid * 1024u;
    const int aoff = lds_byte(wr * 64 + fr, fq * 8), boff = lds_byte(wc * 32 + fr, fq * 8);
#define PG8_SA(b, h) (((b) * 2 + (h)) * HTB)
#define PG8_SB(b, h) ((4 + (b) * 2 + (h)) * HTB)
#define PG8_STAGE(bufoff, gbase, voff) do { _Pragma("unroll") for (int _i = 0; _i < 2; ++_i) \
        __builtin_amdgcn_global_load_lds((const unsigned*)((const char*)(gbase) + (voff)[_i]), (PG8_LAS unsigned*)(lds + (bufoff) + ldsw + _i * 8192), 16, 0, 0); } while (0)
#define PG8_LDA(dst, b, h) do { _Pragma("unroll") for (int m = 0; m < 4; ++m) _Pragma("unroll") for (int k = 0; k < 2; ++k) dst[m][k] = *(const PG8_LAS bf16x8*)(lds + PG8_SA(b, h) + aoff + m * 2048 + k * 1024); } while (0)
#define PG8_LDB(dst, b, h) do { _Pragma("unroll") for (int n = 0; n < 2; ++n) _Pragma("unroll") for (int k = 0; k < 2; ++k) dst[n][k] = *(const PG8_LAS bf16x8*)(lds + PG8_SB(b, h) + boff + n * 2048 + k * 1024); } while (0)
#define PG8_MMA(ai, bj, At, Bt) do { __builtin_amdgcn_s_setprio(1); _Pragma("unroll") for (int m = 0; m < 4; ++m) _Pragma("unroll") for (int n = 0; n < 2; ++n) _Pragma("unroll") for (int k = 0; k < 2; ++k) \
        acc[ai][bj][m][n] = __builtin_amdgcn_mfma_f32_16x16x32_bf16(Bt[n][k], At[m][k], acc[ai][bj][m][n], 0, 0, 0); __builtin_amdgcn_s_setprio(0); } while (0)
#define PG8_WAIT_V(n) asm volatile("s_waitcnt vmcnt(" #n ")" ::: "memory")
#define PG8_WAIT_L(n) asm volatile("s_waitcnt lgkmcnt(" #n ")" ::: "memory")
#define PG8_BAR __builtin_amdgcn_s_barrier()
#define PG8_SCHED __builtin_amdgcn_sched_barrier(0)
    Unit cur, nxt; int ui = 0;
    if (!S.next(0, cur)) return;
    f32x4 acc[2][2][4][2];
#pragma unroll
    for (int a = 0; a < 2; ++a)
#pragma unroll
        for (int b = 0; b < 2; ++b)
#pragma unroll
            for (int m = 0; m < 4; ++m)
#pragma unroll
                for (int n = 0; n < 2; ++n) acc[a][b][m][n] = (f32x4){0.f, 0.f, 0.f, 0.f};
    bf16x8 At[4][2], B0[2][2], B1[2][2];
    const char* cA = (const char*)g.A + (size_t)cur.pm * tstep + (size_t)cur.ko * 2; const char* cB = (const char*)g.Bt + (size_t)cur.pn * tstep + (size_t)cur.ko * 2;
    S.a_ready(cur);
    if constexpr (SP2) {
        PG8_STAGE(PG8_SB(0, 0), cB, voffB); PG8_STAGE(PG8_SB(0, 1), cB + hstep, voffB); PG8_STAGE(PG8_SA(0, 0), cA, voffA); PG8_STAGE(PG8_SA(0, 1), cA + hstep, voffA);
        if (wr == 1) PG8_BAR;
        PG8_WAIT_V(2); PG8_BAR;
        PG8_STAGE(PG8_SB(1, 0), cB + kstep, voffB); PG8_STAGE(PG8_SA(1, 0), cA + kstep, voffA); PG8_STAGE(PG8_SB(1, 1), cB + hstep + kstep, voffB);
        PG8_WAIT_V(6); PG8_BAR;
    } else {
        PG8_STAGE(PG8_SB(0, 0), cB, voffB); PG8_STAGE(PG8_SA(0, 0), cA, voffA); PG8_STAGE(PG8_SB(0, 1), cB + hstep, voffB); PG8_STAGE(PG8_SA(0, 1), cA + hstep, voffA);
        if (wr == 1) PG8_BAR;
        PG8_WAIT_V(4); PG8_BAR;
        PG8_STAGE(PG8_SB(1, 0), cB + kstep, voffB); PG8_STAGE(PG8_SA(1, 0), cA + kstep, voffA); PG8_STAGE(PG8_SB(1, 1), cB + hstep + kstep, voffB);
        PG8_WAIT_V(6); PG8_BAR;
    }
    for (;;) {
        const bool has_next = S.next(ui + 1, nxt);
        const char* nA = has_next ? (const char*)g.A + (size_t)nxt.pm * tstep + (size_t)nxt.ko * 2 : cA; const char* nB = has_next ? (const char*)g.Bt + (size_t)nxt.pn * tstep + (size_t)nxt.ko * 2 : cB;
        for (int t = 0; t < nt; t += 2) {
            const bool last = (t == nt - 2);
            const char* a1 = cA + (size_t)(t + 1) * kstep;
            const char* a2 = last ? nA : cA + (size_t)(t + 2) * kstep; const char* b2 = last ? nB : cB + (size_t)(t + 2) * kstep;
            const char* a3 = a2 + kstep; const char* b3 = b2 + kstep;
            if (last && has_next) S.a_ready(nxt);
            if constexpr (Epi::HAS_MID) { if (t == Epi::MID_T) E.mid(acc, cur, wr, wc, fr, fq); }
            if constexpr (SP2) {
            PG8_LDB(B0, 0, 0); PG8_LDB(B1, 0, 1); PG8_SCHED; PG8_LDA(At, 0, 0); PG8_STAGE(PG8_SA(1, 1), a1 + hstep, voffA);
            PG8_WAIT_V(8); PG8_WAIT_L(0); PG8_BAR; PG8_MMA(0, 0, At, B0); PG8_MMA(0, 1, At, B1); PG8_BAR; PG8_SCHED;
            PG8_LDA(At, 0, 1); PG8_STAGE(PG8_SB(0, 0), b2, voffB); PG8_STAGE(PG8_SB(0, 1), b2 + hstep, voffB); PG8_STAGE(PG8_SA(0, 0), a2, voffA);
            PG8_WAIT_V(8); PG8_WAIT_L(0); PG8_BAR; PG8_MMA(1, 0, At, B0); PG8_MMA(1, 1, At, B1); PG8_BAR; PG8_SCHED;
            PG8_LDB(B0, 1, 0); PG8_LDB(B1, 1, 1); PG8_SCHED; PG8_LDA(At, 1, 0); PG8_STAGE(PG8_SA(0, 1), a2 + hstep, voffA);
            PG8_WAIT_V(8); PG8_WAIT_L(0); PG8_BAR; PG8_MMA(0, 0, At, B0); PG8_MMA(0, 1, At, B1); PG8_BAR; PG8_SCHED;
            PG8_LDA(At, 1, 1); PG8_STAGE(PG8_SB(1, 0), b3, voffB); PG8_STAGE(PG8_SB(1, 1), b3 + hstep, voffB); PG8_STAGE(PG8_SA(1, 0), a3, voffA);
            PG8_WAIT_V(8); PG8_WAIT_L(0); PG8_BAR; PG8_MMA(1, 0, At, B0); PG8_MMA(1, 1, At, B1); PG8_BAR; PG8_SCHED;
            } else {
            PG8_LDB(B0, 0, 0); PG8_SCHED; PG8_LDA(At, 0, 0); PG8_STAGE(PG8_SA(1, 1), a1 + hstep, voffA);
            PG8_WAIT_L(8); PG8_BAR; PG8_WAIT_L(0); PG8_MMA(0, 0, At, B0); PG8_BAR; PG8_SCHED;
            PG8_LDB(B1, 0, 1); PG8_STAGE(PG8_SB(0, 0), b2, voffB);
            PG8_BAR; PG8_WAIT_L(0); PG8_MMA(0, 1, At, B1); PG8_BAR;
            PG8_LDA(At, 0, 1); PG8_STAGE(PG8_SA(0, 0), a2, voffA);
            PG8_BAR; PG8_WAIT_L(0); PG8_MMA(1, 0, At, B0); PG8_BAR; PG8_SCHED;
            PG8_STAGE(PG8_SB(0, 1), b2 + hstep, voffB);
            PG8_WAIT_V(6); PG8_BAR; PG8_MMA(1, 1, At, B1); PG8_BAR;
            PG8_LDB(B0, 1, 0); PG8_SCHED; PG8_LDA(At, 1, 0); PG8_STAGE(PG8_SA(0, 1), a2 + hstep, voffA);
            PG8_WAIT_L(8); PG8_BAR; PG8_WAIT_L(0); PG8_MMA(0, 0, At, B0); PG8_BAR; PG8_SCHED;
            PG8_LDB(B1, 1, 1); PG8_STAGE(PG8_SB(1, 0), b3, voffB);
            PG8_BAR; PG8_WAIT_L(0); PG8_MMA(0, 1, At, B1); PG8_BAR;
            PG8_LDA(At, 1, 1); PG8_STAGE(PG8_SA(1, 0), a3, voffA);
            PG8_BAR; PG8_WAIT_L(0); PG8_MMA(1, 0, At, B0); PG8_BAR; PG8_SCHED;
            PG8_STAGE(PG8_SB(1, 1), b3 + hstep, voffB);
            PG8_WAIT_V(6); PG8_BAR; PG8_MMA(1, 1, At, B1); PG8_BAR;
            }
        }
        if constexpr (ALIGN_EPI) { if (wr == 0) PG8_BAR; }
        if constexpr (!Epi::AFTER_DRAIN) { E(acc, cur, wr, wc, fr, fq); S.done(cur); }
        if (!has_next) break;
#pragma unroll
        for (int a = 0; a < 2; ++a)
#pragma unroll
            for (int b = 0; b < 2; ++b)
#pragma unroll
                for (int m = 0; m < 4; ++m)
#pragma unroll
                    for (int n = 0; n < 2; ++n) acc[a][b][m][n] = (f32x4){0.f, 0.f, 0.f, 0.f};
        cur = nxt; cA = nA; cB = nB; ++ui;
        if constexpr (ALIGN_EPI) { if (wr == 1) PG8_BAR; }
    }
    PG8_WAIT_V(0);
    if constexpr (!ALIGN_EPI) { if (wr == 0) PG8_BAR; }
    PG8_BAR;
    if constexpr (Epi::AFTER_DRAIN) { E.fused(acc, cur, wr, wc, fr, fq, lds, wid, lane); S.done(cur); }
#undef PG8_SA
#undef PG8_SB
#undef PG8_STAGE
#undef PG8_LDA
#undef PG8_LDB
#undef PG8_MMA
#undef PG8_WAIT_V
#undef PG8_WAIT_L
#undef PG8_BAR
#undef PG8_SCHED
}
}

using pg8::bf16_t; using pg8::bf16x8; using pg8::f32x4; using pg8::Unit;
#define LAS __attribute__((address_space(3)))
typedef unsigned u32x2 __attribute__((ext_vector_type(2)));
typedef unsigned u32x4 __attribute__((ext_vector_type(4)));
typedef float f32x16 __attribute__((ext_vector_type(16)));

constexpr int DM = 1024, NTP = 16384, MTOK = 17408, INW = 1536, DFF = 2816;
constexpr float EPSV = 1e-6f;
constexpr size_t O_Y = 0, O_PRE = 17825792, O_PIM = 17842176, O_PV = 17858560, O_SRE = 18382848, O_SIM = 18644992, O_SV = 18907136;
constexpr size_t W_ACT = 0, W_XH = 0, W_GBUF = 0, W_MIX = 35651584, W_PBUF = 71303168, W_X2B = 98041856;
constexpr size_t W_BTIN = 133693440, W_BTGLU = W_BTIN + 3145728, W_BTOUT = W_BTGLU + 524288, W_BTGU = W_BTOUT + 2097152, W_BTDN = W_BTGU + 11534336;
constexpr size_t W_ATAB = W_BTDN + 5767168, W_BBT = W_ATAB + 16384, W_CMT = W_BBT + 131072, W_WTP = W_CMT + 131072, W_WTS = W_WTP + 262144, W_RSS = W_WTS + 262144;
constexpr size_t W_BAR = W_RSS + 4 * 17408 * 4;
constexpr size_t W_X3B = W_BAR + 32768;
constexpr size_t W_PART = W_X3B + 33554432;
constexpr size_t W_END = W_PART + 11 * 4194304;
constexpr int LDS_BYTES = 131072 + 4096 + 256;

struct Params { const float* in[28]; float* out; unsigned char* ws; int ph_lo, ph_hi; };

__device__ __forceinline__ unsigned pk2(float lo, float hi) { unsigned r; asm volatile("v_cvt_pk_bf16_f32 %0, %1, %2" : "=v"(r) : "v"(lo), "v"(hi)); return r; }
__device__ __forceinline__ float bflo(unsigned w) { return __uint_as_float(w << 16); }
__device__ __forceinline__ float bfhi(unsigned w) { return __uint_as_float(w & 0xffff0000u); }
__device__ __forceinline__ float sigmoidf_(float z) { return __builtin_amdgcn_rcpf(1.0f + __builtin_amdgcn_exp2f(-1.4426950408889634f * z)); }
__device__ __forceinline__ float gelu_t(float x) { const float z = 1.5957691216057308f * (x + 0.044715f * x * x * x); return x * sigmoidf_(z); }
__device__ __forceinline__ float wave_sum(float v) {
#define WS_DPP(ctrl, rmask) v += __int_as_float(__builtin_amdgcn_update_dpp(0, __float_as_int(v), ctrl, rmask, 0xf, true))
    WS_DPP(0x111, 0xf); WS_DPP(0x112, 0xf); WS_DPP(0x114, 0xf); WS_DPP(0x118, 0xf); WS_DPP(0x142, 0xa); WS_DPP(0x143, 0xc);
#undef WS_DPP
    return __int_as_float(__builtin_amdgcn_readlane(__float_as_int(v), 63));
}
#define LDS_WAIT() asm volatile("s_waitcnt lgkmcnt(0)" ::: "memory")
__device__ __forceinline__ const float* xrow_ptr(const Params& p, int tok) { return tok < NTP ? p.in[0] + (size_t)tok * DM : p.in[1] + (size_t)(tok - NTP) * DM; }

struct EpiBase { bool dry = false; static constexpr bool PERM = false, AFTER_DRAIN = false, HAS_MID = false; static constexpr int MID_T = -1;
    __device__ __forceinline__ void mid(f32x4 (&)[2][2][4][2], const Unit&, int, int, int, int) const {} };

__device__ __forceinline__ void row_ss_add(float* rss, int row, float ss, int fq) {
    ss += __shfl_xor(ss, 16); ss += __shfl_xor(ss, 32);
    if (fq == 0) unsafeAtomicAdd(rss + row, ss);
}

struct EpiInProj : EpiBase {
    static constexpr bool PERM = true;
    bf16_t* P;
    __device__ __forceinline__ void operator()(const f32x4 (&acc)[2][2][4][2], const Unit& u, int wr, int wc, int fr, int fq) const {
        const int row0 = u.pm * 256 + wr * 64 + fr, col0 = u.pn * 256 + wc * 32 + 8 * fq; const bool act = u.pn >= 2;
#pragma unroll
        for (int ai = 0; ai < 2; ++ai)
#pragma unroll
            for (int m = 0; m < 4; ++m) { bf16_t* rowp = P + (size_t)(row0 + ai * 128 + m * 16) * INW + col0;
#pragma unroll
                for (int bj = 0; bj < 2; ++bj) { f32x4 v0 = acc[ai][bj][m][0], v1 = acc[ai][bj][m][1];
                    if (act) { v0[0] = gelu_t(v0[0]); v0[1] = gelu_t(v0[1]); v0[2] = gelu_t(v0[2]); v0[3] = gelu_t(v0[3]); v1[0] = gelu_t(v1[0]); v1[1] = gelu_t(v1[1]); v1[2] = gelu_t(v1[2]); v1[3] = gelu_t(v1[3]); }
                    u32x4 w; w.x = pk2(v0[0], v0[1]); w.y = pk2(v0[2], v0[3]); w.z = pk2(v1[0], v1[1]); w.w = pk2(v1[2], v1[3]); *(u32x4*)(rowp + bj * 128) = w; } }
    }
};
struct EpiGlu : EpiBase {
    static constexpr bool PERM = true;
    const bf16_t* G; bf16_t* MIX; const float* bglu; float* rss;
    __device__ __forceinline__ void operator()(const f32x4 (&acc)[2][2][4][2], const Unit& u, int wr, int wc, int fr, int fq) const {
        const int row0 = u.pm * 256 + wr * 64 + fr, col0 = u.pn * 256 + wc * 32 + 8 * fq;
        f32x4 bv[2][2];
#pragma unroll
        for (int bj = 0; bj < 2; ++bj)
#pragma unroll
            for (int n = 0; n < 2; ++n) bv[bj][n] = *(const f32x4*)(bglu + col0 + bj * 128 + n * 4);
#pragma unroll
        for (int ai = 0; ai < 2; ++ai) { u32x4 gw[4][2];
#pragma unroll
            for (int m = 0; m < 4; ++m)
#pragma unroll
                for (int bj = 0; bj < 2; ++bj) gw[m][bj] = *(const u32x4*)(G + (size_t)(row0 + ai * 128 + m * 16) * 512 + col0 + bj * 128);
#pragma unroll
            for (int m = 0; m < 4; ++m) { const int row = row0 + ai * 128 + m * 16; float ss = 0.f;
#pragma unroll
                for (int bj = 0; bj < 2; ++bj) { const f32x4 z0 = acc[ai][bj][m][0] + bv[bj][0], z1 = acc[ai][bj][m][1] + bv[bj][1]; const u32x4 g4 = gw[m][bj];
                    const float o0 = bflo(g4.x) * sigmoidf_(z0[0]), o1 = bfhi(g4.x) * sigmoidf_(z0[1]), o2 = bflo(g4.y) * sigmoidf_(z0[2]), o3 = bfhi(g4.y) * sigmoidf_(z0[3]);
                    const float o4 = bflo(g4.z) * sigmoidf_(z1[0]), o5 = bfhi(g4.z) * sigmoidf_(z1[1]), o6 = bflo(g4.w) * sigmoidf_(z1[2]), o7 = bfhi(g4.w) * sigmoidf_(z1[3]);
                    ss += (o0 * o0 + o1 * o1 + o2 * o2 + o3 * o3) + (o4 * o4 + o5 * o5 + o6 * o6 + o7 * o7);
                    u32x4 w; w.x = pk2(o0, o1); w.y = pk2(o2, o3); w.z = pk2(o4, o5); w.w = pk2(o6, o7); *(u32x4*)(MIX + (size_t)row * DM + col0 + bj * 128) = w; }
                if (!dry) row_ss_add(rss, row, ss, fq); } }
    }
};
struct EpiOutProj : EpiBase {
    static constexpr bool HAS_MID = true, PERM = true; static constexpr int MID_T = 8;
    const float* xp; const float* xs; bf16_t* X2B; float* rss2; const LAS float* fl; int pm0, pn0;
    __device__ __forceinline__ void mid(f32x4 (&acc)[2][2][4][2], const Unit& u, int wr, int wc, int fr, int fq) const {
        const LAS float* f0 = fl + ((u.pm == pm0 && u.pn == pn0) ? 0 : 256) + wr * 64 + fr;
#pragma unroll
        for (int ai = 0; ai < 2; ++ai)
#pragma unroll
            for (int m = 0; m < 4; ++m) { const float f = f0[ai * 128 + m * 16];
#pragma unroll
                for (int bj = 0; bj < 2; ++bj)
#pragma unroll
                    for (int n = 0; n < 2; ++n) acc[ai][bj][m][n] = acc[ai][bj][m][n] * f; }
    }
    __device__ __forceinline__ void operator()(const f32x4 (&acc)[2][2][4][2], const Unit& u, int wr, int wc, int fr, int fq) const {
        const int row0 = u.pm * 256 + wr * 64 + fr, col0 = u.pn * 256 + wc * 32 + 8 * fq;
        const LAS float* r0 = fl + 512 + ((u.pm == pm0 && u.pn == pn0) ? 0 : 256) + wr * 64 + fr;
        const float* xbase = row0 < NTP ? xp + (size_t)row0 * DM : xs + (size_t)(row0 - NTP) * DM;
#pragma unroll
        for (int ai = 0; ai < 2; ++ai) { f32x4 xv[4][2][2];
#pragma unroll
            for (int m = 0; m < 4; ++m)
#pragma unroll
                for (int bj = 0; bj < 2; ++bj)
#pragma unroll
                    for (int n = 0; n < 2; ++n) xv[m][bj][n] = *(const f32x4*)(xbase + (size_t)(ai * 128 + m * 16) * DM + col0 + bj * 128 + n * 4);
#pragma unroll
            for (int m = 0; m < 4; ++m) { const int row = row0 + ai * 128 + m * 16; float ss = 0.f; const float rc = r0[ai * 128 + m * 16];
#pragma unroll
                for (int bj = 0; bj < 2; ++bj) { const f32x4 v0 = xv[m][bj][0] + acc[ai][bj][m][0] * rc, v1 = xv[m][bj][1] + acc[ai][bj][m][1] * rc;
                    ss += (v0[0] * v0[0] + v0[1] * v0[1] + v0[2] * v0[2] + v0[3] * v0[3]) + (v1[0] * v1[0] + v1[1] * v1[1] + v1[2] * v1[2] + v1[3] * v1[3]);
                    u32x4 w; w.x = pk2(v0[0], v0[1]); w.y = pk2(v0[2], v0[3]); w.z = pk2(v1[0], v1[1]); w.w = pk2(v1[2], v1[3]); *(u32x4*)(X2B + (size_t)row * DM + col0 + bj * 128) = w; }
                if (!dry) row_ss_add(rss2, row, ss, fq); } }
    }
};
struct EpiGateUp : EpiBase {
    static constexpr bool PERM = true;
    bf16_t* ACT; const float* rss2;
    __device__ __forceinline__ void operator()(const f32x4 (&acc)[2][2][4][2], const Unit& u, int wr, int wc, int fr, int fq) const {
        const int row0 = u.pm * 256 + wr * 64 + fr, f0 = u.pn * 128 + wc * 32 + 8 * fq;
        float r2v[2][4];
#pragma unroll
        for (int ai = 0; ai < 2; ++ai)
#pragma unroll
            for (int m = 0; m < 4; ++m) r2v[ai][m] = rss2[row0 + ai * 128 + m * 16];
#pragma unroll
        for (int ai = 0; ai < 2; ++ai)
#pragma unroll
            for (int m = 0; m < 4; ++m) { const int row = row0 + ai * 128 + m * 16; const float r2 = rsqrtf(r2v[ai][m] * (1.f / 1024.f) + EPSV); float o[8];
#pragma unroll
                for (int n = 0; n < 2; ++n) { const f32x4 g = acc[ai][0][m][n] * r2, up = acc[ai][1][m][n] * r2;
#pragma unroll
                    for (int j = 0; j < 4; ++j) o[4 * n + j] = g[j] * sigmoidf_(g[j]) * up[j]; }
                u32x4 w; w.x = pk2(o[0], o[1]); w.y = pk2(o[2], o[3]); w.z = pk2(o[4], o[5]); w.w = pk2(o[6], o[7]); *(u32x4*)(ACT + (size_t)row * DFF + f0) = w; }
    }
};
struct EpiDown : EpiBase {
    static constexpr bool PERM = true;
    const bf16_t* X2B; bf16_t* X3B;
    __device__ __forceinline__ void operator()(const f32x4 (&acc)[2][2][4][2], const Unit& u, int wr, int wc, int fr, int fq) const {
        const int row0 = u.pm * 256 + wr * 64 + fr, col0 = u.pn * 256 + wc * 32 + 8 * fq;
#pragma unroll
        for (int ai = 0; ai < 2; ++ai) { u32x4 xv[4][2];
#pragma unroll
            for (int m = 0; m < 4; ++m)
#pragma unroll
                for (int bj = 0; bj < 2; ++bj) xv[m][bj] = *(const u32x4*)(X2B + (size_t)(row0 + ai * 128 + m * 16) * DM + col0 + bj * 128);
#pragma unroll
            for (int m = 0; m < 4; ++m) { const int row = row0 + ai * 128 + m * 16;
#pragma unroll
                for (int bj = 0; bj < 2; ++bj) { const f32x4 a0 = acc[ai][bj][m][0], a1 = acc[ai][bj][m][1]; const u32x4 x = xv[m][bj];
                    u32x4 w; w.x = pk2(bflo(x.x) + a0[0], bfhi(x.x) + a0[1]); w.y = pk2(bflo(x.y) + a0[2], bfhi(x.y) + a0[3]); w.z = pk2(bflo(x.z) + a1[0], bfhi(x.z) + a1[1]); w.w = pk2(bflo(x.w) + a1[2], bfhi(x.w) + a1[3]);
                    *(u32x4*)(X3B + (size_t)row * DM + col0 + bj * 128) = w; } } }
    }
};
struct EpiDownPart : EpiBase {
    static constexpr bool PERM = true;
    bf16_t* PART;
    __device__ __forceinline__ void operator()(const f32x4 (&acc)[2][2][4][2], const Unit& u, int wr, int wc, int fr, int fq) const {
        const int row0 = (u.pm - 64) * 256 + wr * 64 + fr, col0 = u.pn * 256 + wc * 32 + 8 * fq; bf16_t* base = PART + (size_t)(u.ko >> 8) * 1048576;
#pragma unroll
        for (int ai = 0; ai < 2; ++ai)
#pragma unroll
            for (int m = 0; m < 4; ++m)
#pragma unroll
                for (int bj = 0; bj < 2; ++bj) { const f32x4 a0 = acc[ai][bj][m][0], a1 = acc[ai][bj][m][1];
                    u32x4 w; w.x = pk2(a0[0], a0[1]); w.y = pk2(a0[2], a0[3]); w.z = pk2(a1[0], a1[1]); w.w = pk2(a1[2], a1[3]);
                    *(u32x4*)(base + (size_t)(row0 + ai * 128 + m * 16) * DM + col0 + bj * 128) = w; }
    }
};

__device__ __forceinline__ void p0_transpose_item(const float* W, int K, int N, bf16_t* WT, int mode, int bjoff, const float* ks1, const float* ks2, int ksplit, LAS float* scr, int item, int lane) {
    const int nblk = N / 32, kb = item / nblk, nb = item % nblk, k0 = 64 * kb, n0 = 32 * nb;
#pragma unroll 8
    for (int i = 0; i < 32; ++i) { const int kk = 2 * i + (lane >> 5), k = k0 + kk; float sc = 1.f; if (ks1) sc = k < ksplit ? ks1[k] : ks2[k - ksplit];
        scr[kk * 33 + (lane & 31)] = W[(size_t)k * N + n0 + (lane & 31)] * sc; }
    LDS_WAIT();
    const int c = lane & 7;
#pragma unroll
    for (int j = 0; j < 4; ++j) { const int n = (lane >> 3) + 8 * j; const LAS float* s = scr + (8 * c) * 33 + n; const int nn = n0 + n;
        const int row = mode ? (((nn >> 7) << 8) + bjoff + (nn & 127)) : nn;
        u32x4 o; o.x = pk2(s[0 * 33], s[1 * 33]); o.y = pk2(s[2 * 33], s[3 * 33]); o.z = pk2(s[4 * 33], s[5 * 33]); o.w = pk2(s[6 * 33], s[7 * 33]);
        *(u32x4*)(WT + (size_t)row * K + k0 + 8 * c) = o; }
    LDS_WAIT();
}

__device__ __forceinline__ void phase0(const Params& p, LAS unsigned char* lds) {
    const int tid = threadIdx.x, lane = tid & 63, wave = tid >> 6;
    const int gw = blockIdx.x * 8 + wave, NGW = gridDim.x * 8;
    unsigned char* ws = p.ws;
    {   bf16_t* XH = (bf16_t*)(ws + W_XH); const f32x4* g4 = (const f32x4*)p.in[4] + lane;
        for (int tok = gw; tok < MTOK; tok += 2 * NGW) { const int tok2 = tok + NGW < MTOK ? tok + NGW : tok;
            const f32x4* xr = (const f32x4*)xrow_ptr(p, tok) + lane; const f32x4* xr2 = (const f32x4*)xrow_ptr(p, tok2) + lane; f32x4 v[4], v2[4]; float s = 0.f, s2 = 0.f;
#pragma unroll
            for (int j = 0; j < 4; ++j) { v[j] = xr[64 * j]; v2[j] = xr2[64 * j]; }
#pragma unroll
            for (int j = 0; j < 4; ++j) { s += (v[j][0] * v[j][0] + v[j][1] * v[j][1]) + (v[j][2] * v[j][2] + v[j][3] * v[j][3]); s2 += (v2[j][0] * v2[j][0] + v2[j][1] * v2[j][1]) + (v2[j][2] * v2[j][2] + v2[j][3] * v2[j][3]); }
            const float r = rsqrtf(wave_sum(s) * (1.f / 1024.f) + EPSV), r2 = rsqrtf(wave_sum(s2) * (1.f / 1024.f) + EPSV);
            u32x2* o8 = (u32x2*)(XH + (size_t)tok * DM) + lane; u32x2* o82 = (u32x2*)(XH + (size_t)tok2 * DM) + lane;
#pragma unroll
            for (int j = 0; j < 4; ++j) { const f32x4 g = g4[64 * j]; u32x2 w; w.x = pk2(v[j][0] * r * g[0], v[j][1] * r * g[1]); w.y = pk2(v[j][2] * r * g[2], v[j][3] * r * g[3]); o8[64 * j] = w;
                u32x2 w2; w2.x = pk2(v2[j][0] * r2 * g[0], v2[j][1] * r2 * g[1]); w2.y = pk2(v2[j][2] * r2 * g[2], v2[j][3] * r2 * g[3]); o82[64 * j] = w2; } }
    }
    {   LAS float* scr = (LAS float*)(lds + wave * 8448);
        constexpr int I_IN = 16 * 48, I_GLU = 8 * 16, I_OUT = 16 * 32, NIT = I_IN + I_GLU + I_OUT;
        for (int it = gw; it < NIT; it += NGW) { int r = it;
            if (r < I_IN) { p0_transpose_item(p.in[5], 1024, 1536, (bf16_t*)(ws + W_BTIN), 0, 0, nullptr, nullptr, 0, scr, r, lane); continue; } r -= I_IN;
            if (r < I_GLU) { p0_transpose_item(p.in[14], 512, 512, (bf16_t*)(ws + W_BTGLU), 0, 0, nullptr, nullptr, 0, scr, r, lane); continue; } r -= I_GLU;
            p0_transpose_item(p.in[22], 1024, 1024, (bf16_t*)(ws + W_BTOUT), 0, 0, p.in[20], p.in[21], 512, scr, r, lane); }
    }
    const int gt = blockIdx.x * 512 + tid, NGT = gridDim.x * 512;
    for (int idx = gt; idx < 2048; idx += NGT) { const int g = idx >> 6;
        const float dt = expf(p.in[8][g]), lr = p.in[6][idx], li = p.in[7][idx];
        const float mag = expf(lr * dt), ar = mag * cosf(li * dt), ai = mag * sinf(li * dt), den = lr * lr + li * li;
        const float qr = ((ar - 1.0f) * lr + ai * li) / den, qi = (ai * lr - (ar - 1.0f) * li) / den;
        float* AT = (float*)(ws + W_ATAB); AT[idx * 2] = ar; AT[idx * 2 + 1] = ai;
        bf16_t* BB = (bf16_t*)(ws + W_BBT); const int n = idx & 63;
#pragma unroll
        for (int i = 0; i < 16; i += 2) { const float br0 = p.in[9][idx * 16 + i], bi0 = p.in[10][idx * 16 + i], br1 = p.in[9][idx * 16 + i + 1], bi1 = p.in[10][idx * 16 + i + 1];
            *(unsigned*)(BB + ((size_t)(g * 2 + 0) * 64 + n) * 16 + i) = pk2(qr * br0 - qi * bi0, qr * br1 - qi * bi1);
            *(unsigned*)(BB + ((size_t)(g * 2 + 1) * 64 + n) * 16 + i) = pk2(qr * bi0 + qi * br0, qr * bi1 + qi * br1); } }
    for (int idx = gt; idx < 32768; idx += NGT) { const int g = idx >> 10, o = (idx >> 6) & 15, kp = (idx & 63) * 2;
        const int c5 = kp >> 2, e = kp & 3; const size_t base = ((size_t)(g * 16 + o)) * 64;
        float v0, v1; if (e == 0) { v0 = p.in[11][base + c5]; v1 = p.in[11][base + c5 + 32]; } else { v0 = -p.in[12][base + c5]; v1 = -p.in[12][base + c5 + 32]; }
        *(unsigned*)((bf16_t*)(ws + W_CMT) + ((size_t)(g * 16 + o)) * 128 + kp) = pk2(v0, v1); }
    for (int idx = gt; idx < 131072; idx += NGT) { const int which = idx >> 16, h = (idx >> 13) & 7, t = (idx >> 6) & 127, s = (idx & 63) * 2; const float* wsr = p.in[18] + (size_t)h * 16384;
        float v0, v1;
        if (which == 0) { v0 = s <= t ? wsr[t * 128 + s] : 0.f; v1 = (s + 1) <= t ? wsr[t * 128 + s + 1] : 0.f; }
        else { const bool same = (t >> 3) == (s >> 3); const int tt = t & 7, s0 = s & 7; v0 = (same && s0 <= tt) ? wsr[tt * 128 + s0] : 0.f; v1 = (same && (s0 + 1) <= tt) ? wsr[tt * 128 + s0 + 1] : 0.f; }
        *(unsigned*)((bf16_t*)(ws + (which ? W_WTS : W_WTP)) + (size_t)h * 16384 + t * 128 + s) = pk2(v0, v1); }
    for (int idx = gt; idx < 4 * MTOK; idx += NGT) __hip_atomic_store((unsigned*)(ws + W_RSS) + idx, 0u, __ATOMIC_RELAXED, __HIP_MEMORY_SCOPE_AGENT);
}

__device__ __forceinline__ void p3_transposes(const Params& p, LAS unsigned char* lds, int first_idle) {
    const int tid = threadIdx.x, lane = tid & 63, wave = tid >> 6;
    if ((int)blockIdx.x < first_idle) return;
    const int gw = ((int)blockIdx.x - first_idle) * 8 + wave, NGW = ((int)gridDim.x - first_idle) * 8;
    unsigned char* ws = p.ws; LAS float* scr = (LAS float*)(lds + wave * 8448);
    constexpr int I_G = 16 * 88, I_DN = 44 * 32, NIT = 2 * I_G + I_DN;
    for (int it = gw; it < NIT; it += NGW) { int r = it;
        if (r < I_G) { p0_transpose_item(p.in[24], 1024, 2816, (bf16_t*)(ws + W_BTGU), 1, 0, p.in[23], p.in[23], 1024, scr, r, lane); continue; } r -= I_G;
        if (r < I_G) { p0_transpose_item(p.in[25], 1024, 2816, (bf16_t*)(ws + W_BTGU), 1, 128, p.in[23], p.in[23], 1024, scr, r, lane); continue; } r -= I_G;
        p0_transpose_item(p.in[26], 2816, 1024, (bf16_t*)(ws + W_BTDN), 0, 0, nullptr, nullptr, 0, scr, r, lane); }
}

constexpr int HT_STRIDE = 272, HT_WAVE = 32 * HT_STRIDE, SSEG_OFF = 8 * HT_WAVE;
struct S5Ctx { bf16x8 Bf[4]; bf16x8 Cf[4]; float ar0, ai0, ar1, ai1; float dsk[4]; };

__device__ __forceinline__ bf16x8 s5_load_a(const bf16_t* P, int g, int tokA, int tokB, int lane) {
    const int rho = lane & 31, half = (rho >> 2) & 1, r = 4 * (rho >> 3) + (rho & 3);
    const int tok = (half ? tokB : tokA) + r;
    return *(const bf16x8*)(P + (size_t)tok * INW + g * 16 + 8 * (lane >> 5));
}
__device__ __forceinline__ void s5_bu(const bf16x8 a, const S5Ctx& c, f32x16 (&acc)[4]) {
#pragma unroll
    for (int j = 0; j < 4; ++j) { f32x16 z;
#pragma unroll
        for (int i = 0; i < 16; ++i) z[i] = 0.f;
        acc[j] = __builtin_amdgcn_mfma_f32_32x32x16_bf16(a, c.Bf[j], z, 0, 0, 0); }
}
#define S5_STEP(r) do { const float nr0 = c.ar0 * hr0 - c.ai0 * hi0 + acc[0][r], ni0 = c.ar0 * hi0 + c.ai0 * hr0 + acc[2][r]; \
        const float nr1 = c.ar1 * hr1 - c.ai1 * hi1 + acc[1][r], ni1 = c.ar1 * hi1 + c.ai1 * hr1 + acc[3][r]; hr0 = nr0; hi0 = ni0; hr1 = nr1; hi1 = ni1; } while (0)

__device__ __forceinline__ u32x2 s5_load_x(const bf16_t* P, int g, int tok0, int lane) { return *(const u32x2*)(P + (size_t)(tok0 + (lane & 15)) * INW + g * 16 + 4 * (lane >> 4)); }
__device__ __forceinline__ void s5_y(bf16_t* GB, const S5Ctx& c, int g, int tokA, int tokB, int lane, LAS unsigned char* ht, const u32x2 xwA, const u32x2 xwB, bool nostore = false) {
    const int cc = lane & 15, q = lane >> 4;
#pragma unroll
    for (int t16 = 0; t16 < 2; ++t16) { f32x4 y = {0.f, 0.f, 0.f, 0.f};
#pragma unroll
        for (int ks = 0; ks < 4; ++ks) { const bf16x8 b = *(const LAS bf16x8*)(ht + (16 * t16 + cc) * HT_STRIDE + 64 * ks + 16 * q);
            y = __builtin_amdgcn_mfma_f32_16x16x32_bf16(c.Cf[ks], b, y, 0, 0, 0); }
        const int tok = (t16 ? tokB : tokA) + cc; const u32x2 xw = t16 ? xwB : xwA;
        const float o0 = gelu_t(y[0] + c.dsk[0] * bflo(xw.x)), o1 = gelu_t(y[1] + c.dsk[1] * bfhi(xw.x)), o2 = gelu_t(y[2] + c.dsk[2] * bflo(xw.y)), o3 = gelu_t(y[3] + c.dsk[3] * bfhi(xw.y));
        u32x2 w; w.x = pk2(o0, o1); w.y = pk2(o2, o3); if (!nostore) *(u32x2*)(GB + (size_t)tok * 512 + g * 16 + 4 * q) = w; }
}
__device__ __forceinline__ void s5_load_ctx(const Params& p, S5Ctx& c, int g, int lane) {
    const unsigned char* ws = p.ws; const int c5 = lane & 31, hh = lane >> 5;
    const float* AT = (const float*)(ws + W_ATAB) + (size_t)g * 128; c.ar0 = AT[c5 * 2]; c.ai0 = AT[c5 * 2 + 1]; c.ar1 = AT[(c5 + 32) * 2]; c.ai1 = AT[(c5 + 32) * 2 + 1];
    const bf16_t* BB = (const bf16_t*)(ws + W_BBT);
#pragma unroll
    for (int j = 0; j < 4; ++j) c.Bf[j] = *(const bf16x8*)(BB + ((size_t)(g * 2 + (j >> 1)) * 64 + 32 * (j & 1) + c5) * 16 + 8 * hh);
    const bf16_t* CM = (const bf16_t*)(ws + W_CMT) + ((size_t)(g * 16 + (lane & 15))) * 128;
#pragma unroll
    for (int ks = 0; ks < 4; ++ks) c.Cf[ks] = *(const bf16x8*)(CM + 32 * ks + 8 * (lane >> 4));
#pragma unroll
    for (int j = 0; j < 4; ++j) c.dsk[j] = p.in[13][g * 16 + 4 * (lane >> 4) + j];
}
#define S5_WRITE(r) do { u32x2 w; w.x = pk2(hr0, hr1); w.y = pk2(hi0, hi1); *(LAS u32x2*)(ht + (16 * hh + (r)) * HT_STRIDE + 8 * c5) = w; } while (0)

__device__ __forceinline__ void s5_prompt_item(const Params& p, int item, LAS unsigned char* lds, bool dryA = false, bool dryB = false) {
    const int tid = threadIdx.x, lane = tid & 63, wave = tid >> 6, c5 = lane & 31, hh = lane >> 5;
    const int slot = item >> 3, g = 4 * (item & 7) + (slot & 3), b = slot >> 2, seqbase = b * 2048;
    const bf16_t* P = (const bf16_t*)(p.ws + W_PBUF); bf16_t* GB = (bf16_t*)(p.ws + W_GBUF);
    S5Ctx c; s5_load_ctx(p, c, g, lane);
    LAS unsigned char* ht = lds + wave * HT_WAVE; LAS float* sseg = (LAS float*)(lds + SSEG_OFF);
    float hr0 = 0.f, hi0 = 0.f, hr1 = 0.f, hi1 = 0.f; f32x16 acc[4];
    const int tbase = seqbase + 256 * wave;
    bf16x8 acur = s5_load_a(P, g, tbase, tbase + 128, lane);
    for (int tile = 0; tile < 8; ++tile) { const int tn = tile < 7 ? tile + 1 : 7; const bf16x8 anext = s5_load_a(P, g, tbase + 16 * tn, tbase + 16 * tn + 128, lane);
        s5_bu(acur, c, acc); acur = anext;
#pragma unroll
        for (int r = 0; r < 16; ++r) S5_STEP(r); }
    const int seg = 2 * wave + hh;
    sseg[(seg * 64 + c5) * 2] = hr0; sseg[(seg * 64 + c5) * 2 + 1] = hi0; sseg[(seg * 64 + c5 + 32) * 2] = hr1; sseg[(seg * 64 + c5 + 32) * 2 + 1] = hi1;
    float pr0 = c.ar0, pi0 = c.ai0, pr1 = c.ar1, pi1 = c.ai1;
#pragma unroll
    for (int i = 0; i < 7; ++i) { const float t0 = pr0 * pr0 - pi0 * pi0, u0 = 2.f * pr0 * pi0, t1 = pr1 * pr1 - pi1 * pi1, u1 = 2.f * pr1 * pi1; pr0 = t0; pi0 = u0; pr1 = t1; pi1 = u1; }
    __syncthreads();
    hr0 = hi0 = hr1 = hi1 = 0.f;
    for (int j = 0; j < seg; ++j) { const float s0r = sseg[(j * 64 + c5) * 2], s0i = sseg[(j * 64 + c5) * 2 + 1], s1r = sseg[(j * 64 + c5 + 32) * 2], s1i = sseg[(j * 64 + c5 + 32) * 2 + 1];
        const float nr0 = pr0 * hr0 - pi0 * hi0 + s0r, ni0 = pr0 * hi0 + pi0 * hr0 + s0i, nr1 = pr1 * hr1 - pi1 * hi1 + s1r, ni1 = pr1 * hi1 + pi1 * hr1 + s1i; hr0 = nr0; hi0 = ni0; hr1 = nr1; hi1 = ni1; }
    acur = s5_load_a(P, g, tbase, tbase + 128, lane);
    for (int tile = 0; tile < 8; ++tile) { const int tokA = tbase + 16 * tile, tokB = tokA + 128; const int tn = tile < 7 ? tile + 1 : 7;
        const bf16x8 anext = s5_load_a(P, g, tbase + 16 * tn, tbase + 16 * tn + 128, lane);
        const u32x2 xwA = s5_load_x(P, g, tokA, lane), xwB = s5_load_x(P, g, tokB, lane);
        s5_bu(acur, c, acc); acur = anext;
#pragma unroll
        for (int r = 0; r < 16; ++r) { S5_STEP(r); S5_WRITE(r); }
        LDS_WAIT();
        s5_y(GB, c, g, tokA, tokB, lane, ht, xwA, xwB, dryA);
        LDS_WAIT(); }
    if (seg == 15 && !dryB) { float* ore = p.out + O_PRE + (size_t)(b * 32 + g) * 64; float* oim = p.out + O_PIM + (size_t)(b * 32 + g) * 64;
        ore[c5] = hr0; ore[c5 + 32] = hr1; oim[c5] = hi0; oim[c5 + 32] = hi1; }
    __syncthreads();
}
__device__ __forceinline__ void s5_sample_item(const Params& p, int item, LAS unsigned char* lds) {
    const int tid = threadIdx.x, lane = tid & 63, wave = tid >> 6, c5 = lane & 31, hh = lane >> 5;
    const int g = 4 * (item & 7) + ((item >> 3) & 3), qq = item >> 5;
    const bf16_t* P = (const bf16_t*)(p.ws + W_PBUF); bf16_t* GB = (bf16_t*)(p.ws + W_GBUF);
    S5Ctx c; s5_load_ctx(p, c, g, lane);
    LAS unsigned char* ht = lds + wave * HT_WAVE;
    const int b0 = 32 * qq + 4 * wave, tokA = NTP + 8 * b0, tokB = tokA + 16, bA = b0 + 2 * hh;
    float hr0, hi0, hr1, hi1; f32x16 acc[4];
    const u32x2 xwA = s5_load_x(P, g, tokA, lane), xwB = s5_load_x(P, g, tokB, lane);
    s5_bu(s5_load_a(P, g, tokA, tokB, lane), c, acc);
#pragma unroll
    for (int half = 0; half < 2; ++half) { const size_t so = ((size_t)(bA + half) * 32 + g) * 64;
        hr0 = p.in[2][so + c5]; hr1 = p.in[2][so + c5 + 32]; hi0 = p.in[3][so + c5]; hi1 = p.in[3][so + c5 + 32];
#pragma unroll
        for (int r8 = 0; r8 < 8; ++r8) { S5_STEP(half * 8 + r8); S5_WRITE(half * 8 + r8); }
        p.out[O_SRE + so + c5] = hr0; p.out[O_SRE + so + c5 + 32] = hr1; p.out[O_SIM + so + c5] = hi0; p.out[O_SIM + so + c5 + 32] = hi1; }
    LDS_WAIT();
    s5_y(GB, c, g, tokA, tokB, lane, ht, xwA, xwB);
    LDS_WAIT();
    __syncthreads();
}

__device__ __forceinline__ void cm_item(const Params& p, int item, LAS unsigned char* lds, bool dry) {
    const int tid = threadIdx.x, lane = tid & 63, wave = tid >> 6;
    const bool sample = item >= 128; int tok0; float* vout = nullptr; const bf16_t* WT; int tmask;
    if (!sample) { const int b = item >> 4, cidx = item & 15; tok0 = b * 2048 + 128 * cidx; if (cidx == 15) vout = p.out + O_PV + (size_t)b * 128 * 512; WT = (const bf16_t*)(p.ws + W_WTP); tmask = 127; }
    else { const int j = item - 128; tok0 = NTP + 128 * j; vout = p.out + O_SV + (size_t)j * 128 * 512; WT = (const bf16_t*)(p.ws + W_WTS); tmask = 7; }
    const bf16_t* P = (const bf16_t*)(p.ws + W_PBUF); bf16_t* MIX = (bf16_t*)(p.ws + W_MIX); float* rss_cm = (float*)(p.ws + W_RSS) + MTOK;
    {   float lg[8], lb[8];
#pragma unroll
        for (int j = 0; j < 8; ++j) { lg[j] = p.in[16][8 * lane + j]; lb[j] = p.in[17][8 * lane + j]; }
        u32x4 rawv[16];
#pragma unroll
        for (int i = 0; i < 16; ++i) rawv[i] = *(const u32x4*)(P + (size_t)(tok0 + 16 * wave + i) * INW + 1024 + 8 * lane);
#pragma unroll
        for (int i = 0; i < 8; ++i) { const int s = 16 * wave + 2 * i; float v[2][8];
#pragma unroll
            for (int e = 0; e < 2; ++e) { const u32x4 raw = rawv[2 * i + e];
                v[e][0] = bflo(raw.x); v[e][1] = bfhi(raw.x); v[e][2] = bflo(raw.y); v[e][3] = bfhi(raw.y); v[e][4] = bflo(raw.z); v[e][5] = bfhi(raw.z); v[e][6] = bflo(raw.w); v[e][7] = bfhi(raw.w);
                float sm = 0.f;
#pragma unroll
                for (int j = 0; j < 8; ++j) sm += v[e][j];
                const float mu = wave_sum(sm) * (1.f / 512.f); float s2 = 0.f;
#pragma unroll
                for (int j = 0; j < 8; ++j) { v[e][j] -= mu; s2 += v[e][j] * v[e][j]; }
                const float rs = rsqrtf(wave_sum(s2) * (1.f / 512.f) + EPSV);
#pragma unroll
                for (int j = 0; j < 8; ++j) v[e][j] = v[e][j] * rs * lg[j] + lb[j];
                if (vout) { float* vo = vout + (size_t)(s + e) * 512 + 8 * lane; *(f32x4*)vo = (f32x4){v[e][0], v[e][1], v[e][2], v[e][3]}; *(f32x4*)(vo + 4) = (f32x4){v[e][4], v[e][5], v[e][6], v[e][7]}; } }
            const int chunk = (s >> 3) ^ (lane & 15);
#pragma unroll
            for (int j = 0; j < 8; ++j) *(LAS unsigned*)(lds + (8 * lane + j) * 256 + chunk * 16 + (s & 7) * 2) = pk2(v[0][j], v[1][j]); }
    }
    __syncthreads();
    {   const int h = wave, cc = lane & 15, q = lane >> 4;
        bf16x8 Af[4][4];
#pragma unroll
        for (int dt = 0; dt < 4; ++dt)
#pragma unroll
            for (int ks = 0; ks < 4; ++ks) { const int d = 64 * h + 16 * dt + cc; Af[dt][ks] = *(const LAS bf16x8*)(lds + d * 256 + (((4 * ks + q) ^ ((d >> 3) & 15)) * 16)); }
        const bf16_t* Wh = WT + (size_t)h * 16384; const float* bs = p.in[19] + h * 128;
        bf16x8 bwN[4]; u32x2 uwN[4]; float biasN;
#define CM_LOAD(tt_) do { const int t_ = 16 * (tt_) + cc; \
            _Pragma("unroll") for (int ks = 0; ks < 4; ++ks) if (ks <= ((tt_) >> 1)) bwN[ks] = *(const bf16x8*)(Wh + t_ * 128 + 32 * ks + 8 * q); \
            _Pragma("unroll") for (int dt = 0; dt < 4; ++dt) uwN[dt] = *(const u32x2*)(P + (size_t)(tok0 + t_) * INW + 512 + 64 * h + 16 * dt + 4 * q); \
            biasN = bs[t_ & tmask]; } while (0)
        CM_LOAD(0);
#pragma unroll
        for (int tt = 0; tt < 8; ++tt) { const int t = 16 * tt + cc; f32x4 acc[4]; bf16x8 bw[4]; u32x2 uw[4];
#pragma unroll
            for (int ks = 0; ks < 4; ++ks) bw[ks] = bwN[ks];
#pragma unroll
            for (int dt = 0; dt < 4; ++dt) uw[dt] = uwN[dt];
            const float bias = biasN;
            if (tt < 7) CM_LOAD(tt + 1);
#pragma unroll
            for (int dt = 0; dt < 4; ++dt) acc[dt] = (f32x4){0.f, 0.f, 0.f, 0.f};
#pragma unroll
            for (int ks = 0; ks < 4; ++ks) if (ks <= (tt >> 1)) {
#pragma unroll
                for (int dt = 0; dt < 4; ++dt) acc[dt] = __builtin_amdgcn_mfma_f32_16x16x32_bf16(Af[dt][ks], bw[ks], acc[dt], 0, 0, 0); }
            float ss = 0.f; const size_t tok = (size_t)(tok0 + t);
#pragma unroll
            for (int dt = 0; dt < 4; ++dt) { const int d = 64 * h + 16 * dt + 4 * q;
                const float o0 = bflo(uw[dt].x) * (acc[dt][0] + bias), o1 = bfhi(uw[dt].x) * (acc[dt][1] + bias), o2 = bflo(uw[dt].y) * (acc[dt][2] + bias), o3 = bfhi(uw[dt].y) * (acc[dt][3] + bias);
                ss += o0 * o0 + o1 * o1 + o2 * o2 + o3 * o3; u32x2 w; w.x = pk2(o0, o1); w.y = pk2(o2, o3); *(u32x2*)(MIX + tok * DM + 512 + d) = w; }
            ss += __shfl_xor(ss, 16); ss += __shfl_xor(ss, 32);
            if (q == 0 && !dry) unsafeAtomicAdd(rss_cm + tok0 + t, ss);
            asm volatile("" ::: "memory"); }
#undef CM_LOAD
    }
    __syncthreads();
}

__device__ __forceinline__ void phase2(const Params& p, LAS unsigned char* lds, bool dry = false, int mask = 7) {
    for (int it = blockIdx.x; it < 256 + 128 + 136; it += gridDim.x) {
        if (it < 256) { if (mask & 1) s5_prompt_item(p, it, lds, dry && (PROBE_VAR & 1), dry && (PROBE_VAR & 2)); }
        else if (it < 392) { if (mask & 2) cm_item(p, it - 256, lds, dry); }
        else { if (mask & 4) s5_sample_item(p, it - 392, lds); }
    }
}
__device__ __forceinline__ void phase7(const Params& p, bool dry = false) {
    const int tid = threadIdx.x, lane = tid & 63, wave = tid >> 6, gw = blockIdx.x * 8 + wave, NGW = gridDim.x * 8;
    const f32x4* nf = (const f32x4*)p.in[27] + lane; const bf16_t* X3B = (const bf16_t*)(p.ws + W_X3B); const bf16_t* X2B = (const bf16_t*)(p.ws + W_X2B); const bf16_t* PART = (const bf16_t*)(p.ws + W_PART);
    f32x4 g[4];
#pragma unroll
    for (int j = 0; j < 4; ++j) g[j] = nf[64 * j];
    for (int q = gw; q < NTP + 2 * (MTOK - NTP); q += NGW) { if (q >= NTP && ((q - NTP) & 1)) continue;
        const int tok = q < NTP ? q : NTP + ((q - NTP) >> 1); f32x4 v[4];
        const u32x2* src = (const u32x2*)((tok < NTP ? X3B : X2B) + (size_t)tok * DM) + lane;
#pragma unroll
        for (int j = 0; j < 4; ++j) { const u32x2 w = src[64 * j]; v[j] = (f32x4){bflo(w.x), bfhi(w.x), bflo(w.y), bfhi(w.y)}; }
        if (tok >= NTP) { const u32x2* pp = (const u32x2*)(PART + (size_t)(tok - NTP) * DM) + lane;
#pragma unroll
            for (int ks = 0; ks < 11; ++ks) { u32x2 t[4];
#pragma unroll
                for (int j = 0; j < 4; ++j) t[j] = pp[(size_t)ks * 262144 + 64 * j];
#pragma unroll
                for (int j = 0; j < 4; ++j) v[j] = v[j] + (f32x4){bflo(t[j].x), bfhi(t[j].x), bflo(t[j].y), bfhi(t[j].y)}; } }
        float s2 = 0.f;
#pragma unroll
        for (int j = 0; j < 4; ++j) s2 += (v[j][0] * v[j][0] + v[j][1] * v[j][1]) + (v[j][2] * v[j][2] + v[j][3] * v[j][3]);
        const float r = rsqrtf(wave_sum(s2) * (1.f / 1024.f) + EPSV);
        f32x4* xr = (f32x4*)(p.out + (size_t)tok * DM) + lane;
        if (!dry) {
#pragma unroll
            for (int j = 0; j < 4; ++j) xr[64 * j] = v[j] * r * g[j]; } }
}

#define XB_TMO      128
#define XB_XCNT(j)  (256  + 64 * (j))
#define XB_XSUB(j)  (1280 + 64 * (j))
#define XB_XGEN(j)  (2304 + 64 * (j))
#define XB_TOP      3328
#define XB_TOPGEN   3392
#define XCD_BAR_WORDS 3456
#define XB_SPIN_CAP (1u << 18)

__device__ __forceinline__ unsigned xb_ld(unsigned* p)              { return __hip_atomic_load(p, __ATOMIC_RELAXED, __HIP_MEMORY_SCOPE_AGENT); }
__device__ __forceinline__ unsigned xb_add(unsigned* p, unsigned v) { return __hip_atomic_fetch_add(p, v, __ATOMIC_RELAXED, __HIP_MEMORY_SCOPE_AGENT); }
__device__ __forceinline__ unsigned xb_xcc_id() { return (unsigned)__builtin_amdgcn_s_getreg((3 << 11) | 20) & 0xFu; }
#define XB_SPIN(cond, bar) do { unsigned _sp = 0; while (cond) { __builtin_amdgcn_s_sleep(1); \
    if ((++_sp & 255u) == 0u) { if (xb_ld(&(bar)[XB_TMO])) break; if (_sp > XB_SPIN_CAP) { atomicAdd(&(bar)[XB_TMO], 1u); break; } } } } while (0)

struct XcdBarrier {
    unsigned* bar; unsigned x;
    volatile LAS unsigned* st;
};

__device__ __forceinline__ XcdBarrier xcd_barrier_post(unsigned* bar, volatile LAS unsigned* st) {
    XcdBarrier b; b.bar = bar; b.x = xb_xcc_id(); b.st = st;
    if (threadIdx.x == 0) (void)xb_add(&bar[XB_XCNT(b.x)], 1u);
    return b;
}
__device__ __forceinline__ void xcd_barrier_complete(unsigned* bar, unsigned x, unsigned& nloc, unsigned& nx) {
    const unsigned G = gridDim.x * gridDim.y * gridDim.z;
    unsigned sum, cnt, mine, sp = 0u;
    for (;;) {
        sum = 0u; cnt = 0u; mine = 0u;
#pragma unroll
        for (unsigned j = 0; j < 16; ++j) { const unsigned c = xb_ld(&bar[XB_XCNT(j)]); sum += c; cnt += (c > 0u) ? 1u : 0u; mine = (j == x) ? c : mine; }
        if (sum == G) break;
        __builtin_amdgcn_s_sleep(1);
        if ((++sp & 255u) == 0u) { if (xb_ld(&bar[XB_TMO])) break; if (sp > XB_SPIN_CAP) { atomicAdd(&bar[XB_TMO], 1u); break; } }
    }
    nloc = mine > 0u ? mine : 1u; nx = cnt > 0u ? cnt : 1u;
}

__device__ __forceinline__ void xcd_barrier(const XcdBarrier& b) {
    asm volatile("s_waitcnt vmcnt(0)" ::: "memory");
    __syncthreads();
    if (threadIdx.x == 0) {
        unsigned* bar = b.bar;
        __builtin_amdgcn_s_waitcnt(0);
        unsigned nloc = b.st[0], nx = b.st[1];
        if (nloc == 0u) { xcd_barrier_complete(bar, b.x, nloc, nx); b.st[0] = nloc; b.st[1] = nx; }
        __builtin_amdgcn_s_sleep(64);
        __builtin_amdgcn_fence(__ATOMIC_RELEASE, "agent"); asm volatile("s_waitcnt vmcnt(0)" ::: "memory");
        const unsigned old = xb_add(&bar[XB_XSUB(b.x)], 1u);
        const unsigned gen = old / nloc;
        if (old + 1u == (gen + 1u) * nloc) {
            __builtin_amdgcn_fence(__ATOMIC_RELEASE, "agent");
            asm volatile("s_waitcnt vmcnt(0)" ::: "memory");
            const unsigned og = xb_add(&bar[XB_TOP], 1u);
            const unsigned tg = og / nx;
            if (og + 1u == (tg + 1u) * nx) xb_add(&bar[XB_TOPGEN], 1u);
            else XB_SPIN(xb_ld(&bar[XB_TOPGEN]) == tg, bar);
            __builtin_amdgcn_fence(__ATOMIC_ACQUIRE, "agent");
            xb_add(&bar[XB_XGEN(b.x)], 1u);
            asm volatile("s_waitcnt vmcnt(0)" ::: "memory");
        } else {
            XB_SPIN(xb_ld(&bar[XB_XGEN(b.x)]) == gen, bar);
            __builtin_amdgcn_fence(__ATOMIC_ACQUIRE, "agent");
            asm volatile("s_waitcnt vmcnt(0)" ::: "memory");
        }
    }
    __syncthreads();
}


__global__ __launch_bounds__(512, 2) void mega_fwd(Params p) {
    extern __shared__ __attribute__((aligned(16))) unsigned char shm_raw[];
    LAS unsigned char* lds = (LAS unsigned char*)shm_raw;
    cg::grid_group grid = cg::this_grid();
    unsigned char* ws = p.ws; float* rss = (float*)(ws + W_RSS);
    pg8::StaticOrder S;
    volatile LAS unsigned* xst = (volatile LAS unsigned*)(lds + 131072 + 4096);
    if (threadIdx.x < 4) xst[threadIdx.x] = 0u;
    __syncthreads();
    const XcdBarrier xb = xcd_barrier_post((unsigned*)(ws + W_BAR), xst);
    if (p.ph_lo < 0) grid.sync();
#define PH_RUN(n, ...) if ((PHMASK & (1 << n)) && p.ph_lo <= n && n < p.ph_hi) { if (n > p.ph_lo) xcd_barrier(xb); \
        for (int rep = 0; rep < (PROBE_PH == n ? 1 + PROBE_N : 1); ++rep) { if (rep) xcd_barrier(xb); const bool dry = rep > 0; __VA_ARGS__ } }
    PH_RUN(0, phase0(p, lds); (void)dry;)
    PH_RUN(1, pg8::Gemm g{(const bf16_t*)(ws + W_XH), (const bf16_t*)(ws + W_BTIN), MTOK, INW, 1024, 1024}; S.init(g.M, g.N, gridDim.x, blockIdx.x);
        EpiInProj E; E.dry = dry; E.P = (bf16_t*)(ws + W_PBUF); pg8::gemm_phase<EpiInProj, pg8::StaticOrder, GP_ALIGN, GP_SP2>(lds, g, S, E);)
    PH_RUN(2, phase2(p, lds, dry, dry ? PROBE_P2MASK : 7);)
    PH_RUN(3, { pg8::Gemm g{(const bf16_t*)(ws + W_GBUF), (const bf16_t*)(ws + W_BTGLU), MTOK, 512, 512, 512}; pg8::StaticOrder S3; S3.init(g.M, g.N, gridDim.x, blockIdx.x);
        EpiGlu E; E.dry = dry; E.G = (const bf16_t*)(ws + W_GBUF); E.MIX = (bf16_t*)(ws + W_MIX); E.bglu = p.in[15]; E.rss = rss;
        p3_transposes(p, lds, 136);
        pg8::gemm_phase<EpiGlu, pg8::StaticOrder, GP_ALIGN, GP_SP2>(lds, g, S3, E);
        asm volatile("s_waitcnt vmcnt(0)" ::: "memory");
        __syncthreads();
        if (threadIdx.x == 0) { Unit u; if (S3.next(0, u)) { __builtin_amdgcn_fence(__ATOMIC_RELEASE, "agent"); asm volatile("s_waitcnt vmcnt(0)" ::: "memory");
            for (int i = 0; S3.next(i, u); ++i) __hip_atomic_fetch_add((unsigned*)(ws + W_BAR) + 4096 + 16 * (1 + u.pm), 1u, __ATOMIC_RELAXED, __HIP_MEMORY_SCOPE_AGENT); } } }
        { pg8::Gemm g{(const bf16_t*)(ws + W_MIX), (const bf16_t*)(ws + W_BTOUT), NTP, 1024, 1024, 1024}; S.init(g.M, g.N, gridDim.x, blockIdx.x);
        EpiOutProj E; E.dry = dry; E.xp = p.in[0]; E.xs = p.in[1]; E.X2B = (bf16_t*)(ws + W_X2B); E.rss2 = rss + 2 * MTOK;
        LAS float* fl = (LAS float*)(lds + 131072); E.fl = fl; E.pm0 = -1; E.pn0 = -1;
        if (threadIdx.x == 0) { bool any = false;
            for (int i = 0; i < 2; ++i) { Unit u0; if (!S.next(i, u0)) break; any = true; const unsigned* c = (const unsigned*)(ws + W_BAR) + 4096 + 16 * (1 + u0.pm);
                for (unsigned sp = 0; sp < (1u << 16); ++sp) { if (__hip_atomic_load(c, __ATOMIC_RELAXED, __HIP_MEMORY_SCOPE_AGENT) >= 2u) break; __builtin_amdgcn_s_sleep(2); } }
            if (any) { __builtin_amdgcn_fence(__ATOMIC_ACQUIRE, "agent"); asm volatile("s_waitcnt vmcnt(0)" ::: "memory"); } }
        __syncthreads();
        for (int i = 0; i < 2; ++i) { Unit u; if (S.next(i, u)) { if (i == 0) { E.pm0 = u.pm; E.pn0 = u.pn; }
            if (threadIdx.x < 256) { const int row = u.pm * 256 + threadIdx.x; const float a = rss[row] * (1.f / 512.f) + EPSV; const float b = rss[MTOK + row] * (1.f / 512.f) + EPSV;
                fl[i * 256 + threadIdx.x] = sqrtf(b / a); fl[512 + i * 256 + threadIdx.x] = rsqrtf(b); } } }
        __syncthreads();
        pg8::gemm_phase<EpiOutProj, pg8::StaticOrder, GP_ALIGN, GP_SP2>(lds, g, S, E); })
    PH_RUN(5, { pg8::Gemm g{(const bf16_t*)(ws + W_MIX), (const bf16_t*)(ws + W_BTOUT), MTOK, 1024, 1024, 1024};
        pg8::SampleOutOrder S4; S4.c = blockIdx.x; S4.base = (int)gridDim.x - 16; S4.cnt = (unsigned*)(ws + W_BAR) + 4096;
        EpiOutProj E; E.dry = dry; E.xp = p.in[0]; E.xs = p.in[1]; E.X2B = (bf16_t*)(ws + W_X2B); E.rss2 = rss + 2 * MTOK;
        LAS float* fl = (LAS float*)(lds + 131072); E.fl = fl; E.pm0 = -1; E.pn0 = -1;
        { Unit u; if (S4.next(0, u)) { E.pm0 = u.pm; E.pn0 = u.pn;
            if (threadIdx.x < 256) { const int row = u.pm * 256 + threadIdx.x; const float a = rss[row] * (1.f / 512.f) + EPSV; const float b = rss[MTOK + row] * (1.f / 512.f) + EPSV;
                fl[threadIdx.x] = sqrtf(b / a); fl[512 + threadIdx.x] = rsqrtf(b); } } }
        __syncthreads();
        pg8::gemm_phase<EpiOutProj, pg8::SampleOutOrder, GP_ALIGN, GP_SP2>(lds, g, S4, E);
        asm volatile("s_waitcnt vmcnt(0)" ::: "memory");
        __syncthreads();
        if (threadIdx.x == 0) { Unit u; if (S4.next(0, u)) { __builtin_amdgcn_fence(__ATOMIC_RELEASE, "agent"); asm volatile("s_waitcnt vmcnt(0)" ::: "memory");
            __hip_atomic_fetch_add(S4.cnt, 1u, __ATOMIC_RELAXED, __HIP_MEMORY_SCOPE_AGENT); } } }
        { pg8::Gemm g{(const bf16_t*)(ws + W_X2B), (const bf16_t*)(ws + W_BTGU), MTOK, 2 * DFF, 1024, 1024}; pg8::CountedGU S5; S5.init(g.M, g.N, gridDim.x, blockIdx.x); S5.cnt = (const unsigned*)(ws + W_BAR) + 4096;
        EpiGateUp E; E.dry = dry; E.ACT = (bf16_t*)(ws + W_ACT); E.rss2 = rss + 2 * MTOK;
        pg8::gemm_phase<EpiGateUp, pg8::CountedGU, GP_ALIGN, GP_SP2>(lds, g, S5, E); })
    PH_RUN(6, { pg8::Gemm g{(const bf16_t*)(ws + W_ACT), (const bf16_t*)(ws + W_BTDN), NTP, 1024, DFF, DFF}; S.init(g.M, g.N, gridDim.x, blockIdx.x);
        EpiDown E; E.dry = dry; E.X2B = (const bf16_t*)(ws + W_X2B); E.X3B = (bf16_t*)(ws + W_X3B);
        pg8::gemm_phase<EpiDown, pg8::StaticOrder, GP_ALIGN, GP_SP2>(lds, g, S, E); }
        { pg8::Gemm g{(const bf16_t*)(ws + W_ACT), (const bf16_t*)(ws + W_BTDN), MTOK, 1024, 256, DFF}; pg8::SplitKOrder S2; S2.init(gridDim.x, blockIdx.x);
        EpiDownPart E; E.dry = dry; E.PART = (bf16_t*)(ws + W_PART);
        pg8::gemm_phase<EpiDownPart, pg8::SplitKOrder, GP_ALIGN, GP_SP2>(lds, g, S2, E); })
    PH_RUN(7, phase7(p, dry);)
}

extern "C" void kernel_launch(void* const* d_in, const int* in_sizes, int n_in, void* d_out, int out_size, void* d_ws, size_t ws_size, hipStream_t stream) {
    static int grid = 0;
    if (grid == 0) {
        if (n_in != 28 || ws_size < W_END) { fprintf(stderr, "kernel_launch: unexpected n_in %d / ws %zu (need %zu)\n", n_in, ws_size, (size_t)W_END); grid = -1; return; }
        int dev = 0, cus = 0, per_cu = 0;
        if (hipGetDevice(&dev) != hipSuccess || hipDeviceGetAttribute(&cus, hipDeviceAttributeMultiprocessorCount, dev) != hipSuccess) { grid = -1; return; }
        if (hipFuncSetAttribute((const void*)mega_fwd, hipFuncAttributeMaxDynamicSharedMemorySize, LDS_BYTES) != hipSuccess) { fprintf(stderr, "kernel_launch: hipFuncSetAttribute failed\n"); grid = -1; return; }
        if (hipOccupancyMaxActiveBlocksPerMultiprocessor(&per_cu, (const void*)mega_fwd, 512, LDS_BYTES) != hipSuccess || per_cu < 1) { fprintf(stderr, "kernel_launch: occupancy query says %d\n", per_cu); per_cu = 1; }
        (void)hipGetLastError();
        grid = cus * 1;
    }
    if (grid < 0) return;
    if (hipMemsetAsync((unsigned char*)d_ws + W_BAR, 0, 32768, stream) != hipSuccess) { fprintf(stderr, "kernel_launch: memset failed\n"); return; }
    Params p{};
    for (int i = 0; i < 28; ++i) p.in[i] = (const float*)d_in[i];
    p.out = (float*)d_out; p.ws = (unsigned char*)d_ws;
#if MK_MULTI_LAUNCH
    for (int ph = 0; ph < 8; ++ph) { p.ph_lo = ph; p.ph_hi = ph + 1; hipLaunchKernelGGL(mega_fwd, dim3(grid), dim3(512), LDS_BYTES, stream, p); }
#else
    p.ph_lo = 0; p.ph_hi = 8;
    void* args[] = {&p};
    hipError_t e = hipLaunchCooperativeKernel((const void*)mega_fwd, dim3(grid), dim3(512), args, LDS_BYTES, stream);
    if (e != hipSuccess) fprintf(stderr, "kernel_launch: cooperative launch failed: %s (grid %d)\n", hipGetErrorString(e), grid);
#endif
}
```

```cpp
#include <hip/hip_runtime.h>
#include <hip/hip_cooperative_groups.h>
#include <cstdio>
#include <cstdint>
namespace cg = cooperative_groups;
#ifndef PHMASK
#define PHMASK 255
#endif
#ifndef PROBE_PH
#define PROBE_PH -1
#endif
#ifndef PROBE_P2MASK
#define PROBE_P2MASK 7
#endif
#ifndef PROBE_VAR
#define PROBE_VAR 0
#endif
#ifndef PROBE_N
#define PROBE_N 2
#endif
#ifndef GP_ALIGN
#define GP_ALIGN true
#endif
#ifndef GP_SP2
#define GP_SP2 true
#endif
#ifndef MK_MULTI_LAUNCH
#define MK_MULTI_LAUNCH 0
#endif
namespace pg8 {
#define PG8_LAS __attribute__((address_space(3)))
typedef unsigned short bf16_t;
typedef short bf16x8 __attribute__((ext_vector_type(8)));
typedef float f32x4 __attribute__((ext_vector_type(4)));
typedef unsigned u32x4 __attribute__((ext_vector_type(4)));
constexpr int BM = 256, BK = 64, HALF = 128, HTB = HALF * BK * 2  , STAGE_BYTES = 8 * HTB, NXCD = 8, WGM = 8;

__host__ __device__ __forceinline__ int lds_byte(int r, int c) { const int st = (r >> 4) * 2 + (c >> 5), rr = r & 15, cc = c & 31, ob = rr * 64 + cc * 2; return st * 1024 + (ob ^ (((ob >> 9) & 1) << 5)); }
__host__ __device__ __forceinline__ void stage_rc(int b, int& R, int& C) { const int st = b / 1024, sb = b % 1024, swz = sb ^ (((sb >> 9) & 1) << 5); R = (st >> 1) * 16 + swz / 64; C = (st & 1) * 32 + (swz % 64) / 2; }
__host__ __device__ __forceinline__ int perm32(int rho) { const int n = rho >> 4, i = rho & 15; return 8 * (i >> 2) + 4 * n + (i & 3); }

struct Unit { int pm, pn, ko; };
struct Gemm { const bf16_t* A; const bf16_t* Bt; int M, N, K, ld; };

struct StaticOrder {
    int nM, nN, nwg, G, c;
    __host__ __device__ void init(int M, int N, int G_, int c_) { nM = M / BM; nN = N / BM; nwg = nM * nN; G = G_; c = c_; }
    __host__ __device__ bool next(int i, Unit& u) const {
        const long L = (long)i * G + c; if (L >= nwg) return false;
        int wgid = (int)L; { const int q = nwg / NXCD, r = nwg % NXCD, xcd = wgid % NXCD, off = wgid / NXCD; wgid = (xcd < r ? xcd * (q + 1) : r * (q + 1) + (xcd - r) * q) + off; }
        const int nig = WGM * nN, gid = wgid / nig, fm = gid * WGM, gsz = (nM - fm) < WGM ? (nM - fm) : WGM;
        u.pm = fm + ((wgid % nig) % gsz); u.pn = (wgid % nig) / gsz; u.ko = 0; return true;
    }
    __device__ __forceinline__ void a_ready(const Unit&) const {}
    __device__ __forceinline__ void done(const Unit&) const {}
};
struct SplitKOrder {
    int G, c;
    __host__ __device__ void init(int G_, int c_) { G = G_; c = c_; }
    __host__ __device__ bool next(int i, Unit& u) const { const long L = (long)i * G + c; if (L >= 176) return false; const int ks = (int)L % 11, rem = (int)L / 11; u.pm = 64 + (rem >> 2); u.pn = rem & 3; u.ko = ks * 256; return true; }
    __device__ __forceinline__ void a_ready(const Unit&) const {}
    __device__ __forceinline__ void done(const Unit&) const {}
};
struct GluOrder : StaticOrder {
    unsigned* cnt;
    __device__ __forceinline__ void done(const Unit& u) const {
        asm volatile("s_waitcnt vmcnt(0)" ::: "memory");
        __builtin_amdgcn_fence(__ATOMIC_RELEASE, "agent");
        asm volatile("s_waitcnt vmcnt(0)" ::: "memory");
        if ((threadIdx.x & 63) == 0) __hip_atomic_fetch_add(cnt + 16 * (1 + u.pm), 1u, __ATOMIC_RELAXED, __HIP_MEMORY_SCOPE_AGENT);
    }
};
struct SampleOutOrder {
    int c, base; unsigned* cnt;
    __host__ __device__ bool next(int i, Unit& u) const { if (i != 0 || c < base) return false; const int k = c - base; u.pm = 64 + (k >> 2); u.pn = k & 3; u.ko = 0; return true; }
    __device__ __forceinline__ void a_ready(const Unit&) const {}
    __device__ __forceinline__ void done(const Unit&) const {}
};
struct CountedGU : StaticOrder {
    const unsigned* cnt;
    __device__ __forceinline__ void a_ready(const Unit& u) const {
        if (u.pm >= 64) {
            if (threadIdx.x < 64) {
                for (unsigned sp = 0; sp < (1u << 16); ++sp) { if ((unsigned)__builtin_amdgcn_readfirstlane((int)__hip_atomic_load(cnt, __ATOMIC_RELAXED, __HIP_MEMORY_SCOPE_AGENT)) >= 16u) break; __builtin_amdgcn_s_sleep(2); }
                __builtin_amdgcn_fence(__ATOMIC_ACQUIRE, "agent");
                asm volatile("s_waitcnt vmcnt(0)" ::: "memory");
            }
            asm volatile("" ::: "memory"); __builtin_amdgcn_s_barrier(); asm volatile("" ::: "memory");
        }
    }
};
template <class Epi, class Sched, bool ALIGN_EPI = false, bool SP2 = false>
__device__ __forceinline__ void gemm_phase(PG8_LAS unsigned char* lds, const Gemm g, const Sched& S, const Epi& E) {
    const int tid = threadIdx.x, wid = __builtin_amdgcn_readfirstlane(tid >> 6), lane = tid & 63, wr = wid >> 2, wc = wid & 3, fr = lane & 15, fq = lane >> 4;
    const int K = g.K, nt = K / BK, LD = g.ld;
    unsigned voffA[2], voffB[2];
#pragma unroll
    for (int i = 0; i < 2; ++i) { int R, C; stage_rc(tid * 16 + i * 8192, R, C); const int Rb = Epi::PERM ? ((R & ~31) + perm32(R & 31)) : R;
        voffA[i] = (unsigned)(R * LD + C) * 2u; voffB[i] = (unsigned)(Rb * LD + C) * 2u; }
    const size_t kstep = (size_t)(BK * 2);
    const size_t hstep = (size_t)HALF * LD * 2;
    const size_t tstep = 2 * hstep;
    const unsigned ldsw = (unsigned)wid * 1024u;
    const int aoff = lds_byte(wr * 64 + fr, fq * 8), boff = lds_byte(wc * 32 + fr, fq * 8);
#define PG8_SA(b, h) (((b) * 2 + (h)) * HTB)
#define PG8_SB(b, h) ((4 + (b) * 2 + (h)) * HTB)
#define PG8_STAGE(bufoff, gbase, voff) do { _Pragma("unroll") for (int _i = 0; _i < 2; ++_i) \
        __builtin_amdgcn_global_load_lds((const unsigned*)((const char*)(gbase) + (voff)[_i]), (PG8_LAS unsigned*)(lds + (bufoff) + ldsw + _i * 8192), 16, 0, 0); } while (0)
#define PG8_LDA(dst, b, h) do { _Pragma("unroll") for (int m = 0; m < 4; ++m) _Pragma("unroll") for (int k = 0; k < 2; ++k) dst[m][k] = *(const PG8_LAS bf16x8*)(lds + PG8_SA(b, h) + aoff + m * 2048 + k * 1024); } while (0)
#define PG8_LDB(dst, b, h) do { _Pragma("unroll") for (int n = 0; n < 2; ++n) _Pragma("unroll") for (int k = 0; k < 2; ++k) dst[n][k] = *(const PG8_LAS bf16x8*)(lds + PG8_SB(b, h) + boff + n * 2048 + k * 1024); } while (0)
#define PG8_MMA(ai, bj, At, Bt) do { __builtin_amdgcn_s_setprio(1); _Pragma("unroll") for (int m = 0; m < 4; ++m) _Pragma("unroll") for (int n = 0; n < 2; ++n) _Pragma("unroll") for (int k = 0; k < 2; ++k) \
        acc[ai][bj][m][n] = __builtin_amdgcn_mfma_f32_16x16x32_bf16(Bt[n][k], At[m][k], acc[ai][bj][m][n], 0, 0, 0); __builtin_amdgcn_s_setprio(0); } while (0)
#define PG8_WAIT_V(n) asm volatile("s_waitcnt vmcnt(" #n ")" ::: "memory")
#define PG8_WAIT_L(n) asm volatile("s_waitcnt lgkmcnt(" #n ")" ::: "memory")
#define PG8_BAR __builtin_amdgcn_s_barrier()
#define PG8_SCHED __builtin_amdgcn_sched_barrier(0)
    Unit cur, nxt; int ui = 0;
    if (!S.next(0, cur)) return;
    f32x4 acc[2][2][4][2];
#pragma unroll
    for (int a = 0; a < 2; ++a)
#pragma unroll
        for (int b = 0; b < 2; ++b)
#pragma unroll
            for (int m = 0; m < 4; ++m)
#pragma unroll
                for (int n = 0; n < 2; ++n) acc[a][b][m][n] = (f32x4){0.f, 0.f, 0.f, 0.f};
    bf16x8 At[4][2], B0[2][2], B1[2][2];
    const char* cA = (const char*)g.A + (size_t)cur.pm * tstep + (size_t)cur.ko * 2; const char* cB = (const char*)g.Bt + (size_t)cur.pn * tstep + (size_t)cur.ko * 2;
    S.a_ready(cur);
    if constexpr (SP2) {
        PG8_STAGE(PG8_SB(0, 0), cB, voffB); PG8_STAGE(PG8_SB(0, 1), cB + hstep, voffB); PG8_STAGE(PG8_SA(0, 0), cA, voffA); PG8_STAGE(PG8_SA(0, 1), cA + hstep, voffA);
        if (wr == 1) PG8_BAR;
        PG8_WAIT_V(2); PG8_BAR;
        PG8_STAGE(PG8_SB(1, 0), cB + kstep, voffB); PG8_STAGE(PG8_SA(1, 0), cA + kstep, voffA); PG8_STAGE(PG8_SB(1, 1), cB + hstep + kstep, voffB);
        PG8_WAIT_V(6); PG8_BAR;
    } else {
        PG8_STAGE(PG8_SB(0, 0), cB, voffB); PG8_STAGE(PG8_SA(0, 0), cA, voffA); PG8_STAGE(PG8_SB(0, 1), cB + hstep, voffB); PG8_STAGE(PG8_SA(0, 1), cA + hstep, voffA);
        if (wr == 1) PG8_BAR;
        PG8_WAIT_V(4); PG8_BAR;
        PG8_STAGE(PG8_SB(1, 0), cB + kstep, voffB); PG8_STAGE(PG8_SA(1, 0), cA + kstep, voffA); PG8_STAGE(PG8_SB(1, 1), cB + hstep + kstep, voffB);
        PG8_WAIT_V(6); PG8_BAR;
    }
    for (;;) {
        const bool has_next = S.next(ui + 1, nxt);
        const char* nA = has_next ? (const char*)g.A + (size_t)nxt.pm * tstep + (size_t)nxt.ko * 2 : cA; const char* nB = has_next ? (const char*)g.Bt + (size_t)nxt.pn * tstep + (size_t)nxt.ko * 2 : cB;
        for (int t = 0; t < nt; t += 2) {
            const bool last = (t == nt - 2);
            const char* a1 = cA + (size_t)(t + 1) * kstep;
            const char* a2 = last ? nA : cA + (size_t)(t + 2) * kstep; const char* b2 = last ? nB : cB + (size_t)(t + 2) * kstep;
            const char* a3 = a2 + kstep; const char* b3 = b2 + kstep;
            if (last && has_next) S.a_ready(nxt);
            if constexpr (Epi::HAS_MID) { if (t == Epi::MID_T) E.mid(acc, cur, wr, wc, fr, fq); }
            if constexpr (SP2) {
            PG8_LDB(B0, 0, 0); PG8_LDB(B1, 0, 1); PG8_SCHED; PG8_LDA(At, 0, 0); PG8_STAGE(PG8_SA(1, 1), a1 + hstep, voffA);
            PG8_WAIT_V(8); PG8_WAIT_L(0); PG8_BAR; PG8_MMA(0, 0, At, B0); PG8_MMA(0, 1, At, B1); PG8_BAR; PG8_SCHED;
            PG8_LDA(At, 0, 1); PG8_STAGE(PG8_SB(0, 0), b2, voffB); PG8_STAGE(PG8_SB(0, 1), b2 + hstep, voffB); PG8_STAGE(PG8_SA(0, 0), a2, voffA);
            PG8_WAIT_V(8); PG8_WAIT_L(0); PG8_BAR; PG8_MMA(1, 0, At, B0); PG8_MMA(1, 1, At, B1); PG8_BAR; PG8_SCHED;
            PG8_LDB(B0, 1, 0); PG8_LDB(B1, 1, 1); PG8_SCHED; PG8_LDA(At, 1, 0); PG8_STAGE(PG8_SA(0, 1), a2 + hstep, voffA);
            PG8_WAIT_V(8); PG8_WAIT_L(0); PG8_BAR; PG8_MMA(0, 0, At, B0); PG8_MMA(0, 1, At, B1); PG8_BAR; PG8_SCHED;
            PG8_LDA(At, 1, 1); PG8_STAGE(PG8_SB(1, 0), b3, voffB); PG8_STAGE(PG8_SB(1, 1), b3 + hstep, voffB); PG8_STAGE(PG8_SA(1, 0), a3, voffA);
            PG8_WAIT_V(8); PG8_WAIT_L(0); PG8_BAR; PG8_MMA(1, 0, At, B0); PG8_MMA(1, 1, At, B1); PG8_BAR; PG8_SCHED;
            } else {
            PG8_LDB(B0, 0, 0); PG8_SCHED; PG8_LDA(At, 0, 0); PG8_STAGE(PG8_SA(1, 1), a1 + hstep, voffA);
            PG8_WAIT_L(8); PG8_BAR; PG8_WAIT_L(0); PG8_MMA(0, 0, At, B0); PG8_BAR; PG8_SCHED;
            PG8_LDB(B1, 0, 1); PG8_STAGE(PG8_SB(0, 0), b2, voffB);
            PG8_BAR; PG8_WAIT_L(0); PG8_MMA(0, 1, At, B1); PG8_BAR;
            PG8_LDA(At, 0, 1); PG8_STAGE(PG8_SA(0, 0), a2, voffA);
            PG8_BAR; PG8_WAIT_L(0); PG8_MMA(1, 0, At, B0); PG8_BAR; PG8_SCHED;
            PG8_STAGE(PG8_SB(0, 1), b2 + hstep, voffB);
            PG8_WAIT_V(6); PG8_BAR; PG8_MMA(1, 1, At, B1); PG8_BAR;
            PG8_LDB(B0, 1, 0); PG8_SCHED; PG8_LDA(At, 1, 0); PG8_STAGE(PG8_SA(0, 1), a2 + hstep, voffA);
            PG8_WAIT_L(8); PG8_BAR; PG8_WAIT_L(0); PG8_MMA(0, 0, At, B0); PG8_BAR; PG8_SCHED;
            PG8_LDB(B1, 1, 1); PG8_STAGE(PG8_SB(1, 0), b3, voffB);
            PG8_BAR; PG8_WAIT_L(0); PG8_MMA(0, 1, At, B1); PG8_BAR;
            PG8_LDA(At, 1, 1); PG8_STAGE(PG8_SA(1, 0), a3, voffA);
            PG8_BAR; PG8_WAIT_L(0); PG8_MMA(1, 0, At, B0); PG8_BAR; PG8_SCHED;
            PG8_STAGE(PG8_SB(1, 1), b3 + hstep, voffB);
            PG8_WAIT_V(6); PG8_BAR; PG8_MMA(1, 1, At, B1); PG8_BAR;
            }
        }
        if constexpr (ALIGN_EPI) { if (wr == 0) PG8_BAR; }
        if constexpr (!Epi::AFTER_DRAIN) { E(acc, cur, wr, wc, fr, fq); S.done(cur); }
        if (!has_next) break;
#pragma unroll
        for (int a = 0; a < 2; ++a)
#pragma unroll
            for (int b = 0; b < 2; ++b)
#pragma unroll
                for (int m = 0; m < 4; ++m)
#pragma unroll
                    for (int n = 0; n < 2; ++n) acc[a][b][m][n] = (f32x4){0.f, 0.f, 0.f, 0.f};
        cur = nxt; cA = nA; cB = nB; ++ui;
        if constexpr (ALIGN_EPI) { if (wr == 1) PG8_BAR; }
    }
    PG8_WAIT_V(0);
    if constexpr (!ALIGN_EPI) { if (wr == 0) PG8_BAR; }
    PG8_BAR;
    if constexpr (Epi::AFTER_DRAIN) { E.fused(acc, cur, wr, wc, fr, fq, lds, wid, lane); S.done(cur); }
#undef PG8_SA
#undef PG8_SB
#undef PG8_STAGE
#undef PG8_LDA
#undef PG8_LDB
#undef PG8_MMA
#undef PG8_WAIT_V
#undef PG8_WAIT_L
#undef PG8_BAR
#undef PG8_SCHED
}
}

using pg8::bf16_t; using pg8::bf16x8; using pg8::f32x4; using pg8::Unit;
#define LAS __attribute__((address_space(3)))
typedef unsigned u32x2 __attribute__((ext_vector_type(2)));
typedef unsigned u32x4 __attribute__((ext_vector_type(4)));
typedef float f32x16 __attribute__((ext_vector_type(16)));

constexpr int DM = 1024, NTP = 16384, MTOK = 17408, INW = 1536, DFF = 2816;
constexpr float EPSV = 1e-6f;
constexpr size_t O_Y = 0, O_PRE = 17825792, O_PIM = 17842176, O_PV = 17858560, O_SRE = 18382848, O_SIM = 18644992, O_SV = 18907136;
constexpr size_t W_ACT = 0, W_XH = 0, W_GBUF = 0, W_MIX = 35651584, W_PBUF = 71303168, W_X2B = 98041856;
constexpr size_t W_BTIN = 133693440, W_BTGLU = W_BTIN + 3145728, W_BTOUT = W_BTGLU + 524288, W_BTGU = W_BTOUT + 2097152, W_BTDN = W_BTGU + 11534336;
constexpr size_t W_ATAB = W_BTDN + 5767168, W_BBT = W_ATAB + 16384, W_CMT = W_BBT + 131072, W_WTP = W_CMT + 131072, W_WTS = W_WTP + 262144, W_RSS = W_WTS + 262144;
constexpr size_t W_BAR = W_RSS + 4 * 17408 * 4;
constexpr size_t W_X3B = W_BAR + 32768;
constexpr size_t W_PART = W_X3B + 33554432;
constexpr size_t W_END = W_PART + 11 * 4194304;
constexpr int LDS_BYTES = 131072 + 4096 + 256;

struct Params { const float* in[28]; float* out; unsigned char* ws; int ph_lo, ph_hi; };

__device__ __forceinline__ unsigned pk2(float lo, float hi) { unsigned r; asm volatile("v_cvt_pk_bf16_f32 %0, %1, %2" : "=v"(r) : "v"(lo), "v"(hi)); return r; }
__device__ __forceinline__ float bflo(unsigned w) { return __uint_as_float(w << 16); }
__device__ __forceinline__ float bfhi(unsigned w) { return __uint_as_float(w & 0xffff0000u); }
__device__ __forceinline__ float sigmoidf_(float z) { return __builtin_amdgcn_rcpf(1.0f + __builtin_amdgcn_exp2f(-1.4426950408889634f * z)); }
__device__ __forceinline__ float gelu_t(float x) { const float z = 1.5957691216057308f * (x + 0.044715f * x * x * x); return x * sigmoidf_(z); }
__device__ __forceinline__ float wave_sum(float v) {
#define WS_DPP(ctrl, rmask) v += __int_as_float(__builtin_amdgcn_update_dpp(0, __float_as_int(v), ctrl, rmask, 0xf, true))
    WS_DPP(0x111, 0xf); WS_DPP(0x112, 0xf); WS_DPP(0x114, 0xf); WS_DPP(0x118, 0xf); WS_DPP(0x142, 0xa); WS_DPP(0x143, 0xc);
#undef WS_DPP
    return __int_as_float(__builtin_amdgcn_readlane(__float_as_int(v), 63));
}
#define LDS_WAIT() asm volatile("s_waitcnt lgkmcnt(0)" ::: "memory")
__device__ __forceinline__ const float* xrow_ptr(const Params& p, int tok) { return tok < NTP ? p.in[0] + (size_t)tok * DM : p.in[1] + (size_t)(tok - NTP) * DM; }

struct EpiBase { bool dry = false; static constexpr bool PERM = false, AFTER_DRAIN = false, HAS_MID = false; static constexpr int MID_T = -1;
    __device__ __forceinline__ void mid(f32x4 (&)[2][2][4][2], const Unit&, int, int, int, int) const {} };

__device__ __forceinline__ void row_ss_add(float* rss, int row, float ss, int fq) {
    ss += __shfl_xor(ss, 16); ss += __shfl_xor(ss, 32);
    if (fq == 0) unsafeAtomicAdd(rss + row, ss);
}

struct EpiInProj : EpiBase {
    static constexpr bool PERM = true;
    bf16_t* P;
    __device__ __forceinline__ void operator()(const f32x4 (&acc)[2][2][4][2], const Unit& u, int wr, int wc, int fr, int fq) const {
        const int row0 = u.pm * 256 + wr * 64 + fr, col0 = u.pn * 256 + wc * 32 + 8 * fq; const bool act = u.pn >= 2;
#pragma unroll
        for (int ai = 0; ai < 2; ++ai)
#pragma unroll
            for (int m = 0; m < 4; ++m) { bf16_t* rowp = P + (size_t)(row0 + ai * 128 + m * 16) * INW + col0;
#pragma unroll
                for (int bj = 0; bj < 2; ++bj) { f32x4 v0 = acc[ai][bj][m][0], v1 = acc[ai][bj][m][1];
                    if (act) { v0[0] = gelu_t(v0[0]); v0[1] = gelu_t(v0[1]); v0[2] = gelu_t(v0[2]); v0[3] = gelu_t(v0[3]); v1[0] = gelu_t(v1[0]); v1[1] = gelu_t(v1[1]); v1[2] = gelu_t(v1[2]); v1[3] = gelu_t(v1[3]); }
                    u32x4 w; w.x = pk2(v0[0], v0[1]); w.y = pk2(v0[2], v0[3]); w.z = pk2(v1[0], v1[1]); w.w = pk2(v1[2], v1[3]); *(u32x4*)(rowp + bj * 128) = w; } }
    }
};
struct EpiGlu : EpiBase {
    static constexpr bool PERM = true;
    const bf16_t* G; bf16_t* MIX; const float* bglu; float* rss;
    __device__ __forceinline__ void operator()(const f32x4 (&acc)[2][2][4][2], const Unit& u, int wr, int wc, int fr, int fq) const {
        const int row0 = u.pm * 256 + wr * 64 + fr, col0 = u.pn * 256 + wc * 32 + 8 * fq;
        f32x4 bv[2][2];
#pragma unroll
        for (int bj = 0; bj < 2; ++bj)
#pragma unroll
            for (int n = 0; n < 2; ++n) bv[bj][n] = *(const f32x4*)(bglu + col0 + bj * 128 + n * 4);
#pragma unroll
        for (int ai = 0; ai < 2; ++ai) { u32x4 gw[4][2];
#pragma unroll
            for (int m = 0; m < 4; ++m)
#pragma unroll
                for (int bj = 0; bj < 2; ++bj) gw[m][bj] = *(const u32x4*)(G + (size_t)(row0 + ai * 128 + m * 16) * 512 + col0 + bj * 128);
#pragma unroll
            for (int m = 0; m < 4; ++m) { const int row = row0 + ai * 128 + m * 16; float ss = 0.f;
#pragma unroll
                for (int bj = 0; bj < 2; ++bj) { const f32x4 z0 = acc[ai][bj][m][0] + bv[bj][0], z1 = acc[ai][bj][m][1] + bv[bj][1]; const u32x4 g4 = gw[m][bj];
                    const float o0 = bflo(g4.x) * sigmoidf_(z0[0]), o1 = bfhi(g4.x) * sigmoidf_(z0[1]), o2 = bflo(g4.y) * sigmoidf_(z0[2]), o3 = bfhi(g4.y) * sigmoidf_(z0[3]);
                    const float o4 = bflo(g4.z) * sigmoidf_(z1[0]), o5 = bfhi(g4.z) * sigmoidf_(z1[1]), o6 = bflo(g4.w) * sigmoidf_(z1[2]), o7 = bfhi(g4.w) * sigmoidf_(z1[3]);
                    ss += (o0 * o0 + o1 * o1 + o2 * o2 + o3 * o3) + (o4 * o4 + o5 * o5 + o6 * o6 + o7 * o7);
                    u32x4 w; w.x = pk2(o0, o1); w.y = pk2(o2, o3); w.z = pk2(o4, o5); w.w = pk2(o6, o7); *(u32x4*)(MIX + (size_t)row * DM + col0 + bj * 128) = w; }
                if (!dry) row_ss_add(rss, row, ss, fq); } }
    }
};
struct EpiOutProj : EpiBase {
    static constexpr bool HAS_MID = true, PERM = true; static constexpr int MID_T = 8;
    const float* xp; const float* xs; bf16_t* X2B; float* rss2; const LAS float* fl; int pm0, pn0;
    __device__ __forceinline__ void mid(f32x4 (&acc)[2][2][4][2], const Unit& u, int wr, int wc, int fr, int fq) const {
        const LAS float* f0 = fl + ((u.pm == pm0 && u.pn == pn0) ? 0 : 256) + wr * 64 + fr;
#pragma unroll
        for (int ai = 0; ai < 2; ++ai)
#pragma unroll
            for (int m = 0; m < 4; ++m) { const float f = f0[ai * 128 + m * 16];
#pragma unroll
                for (int bj = 0; bj < 2; ++bj)
#pragma unroll
                    for (int n = 0; n < 2; ++n) acc[ai][bj][m][n] = acc[ai][bj][m][n] * f; }
    }
    __device__ __forceinline__ void operator()(const f32x4 (&acc)[2][2][4][2], const Unit& u, int wr, int wc, int fr, int fq) const {
        const int row0 = u.pm * 256 + wr * 64 + fr, col0 = u.pn * 256 + wc * 32 + 8 * fq;
        const LAS float* r0 = fl + 512 + ((u.pm == pm0 && u.pn == pn0) ? 0 : 256) + wr * 64 + fr;
        const float* xbase = row0 < NTP ? xp + (size_t)row0 * DM : xs + (size_t)(row0 - NTP) * DM;
#pragma unroll
        for (int ai = 0; ai < 2; ++ai) { f32x4 xv[4][2][2];
#pragma unroll
            for (int m = 0; m < 4; ++m)
#pragma unroll
                for (int bj = 0; bj < 2; ++bj)
#pragma unroll
                    for (int n = 0; n < 2; ++n) xv[m][bj][n] = *(const f32x4*)(xbase + (size_t)(ai * 128 + m * 16) * DM + col0 + bj * 128 + n * 4);
#pragma unroll
            for (int m = 0; m < 4; ++m) { const int row = row0 + ai * 128 + m * 16; float ss = 0.f; const float rc = r0[ai * 128 + m * 16];
#pragma unroll
                for (int bj = 0; bj < 2; ++bj) { const f32x4 v0 = xv[m][bj][0] + acc[ai][bj][m][0] * rc, v1 = xv[m][bj][1] + acc[ai][bj][m][1] * rc;
                    ss += (v0[0] * v0[0] + v0[1] * v0[1] + v0[2] * v0[2] + v0[3] * v0[3]) + (v1[0] * v1[0] + v1[1] * v1[1] + v1[2] * v1[2] + v1[3] * v1[3]);
                    u32x4 w; w.x = pk2(v0[0], v0[1]); w.y = pk2(v0[2], v0[3]); w.z = pk2(v1[0], v1[1]); w.w = pk2(v1[2], v1[3]); *(u32x4*)(X2B + (size_t)row * DM + col0 + bj * 128) = w; }
                if (!dry) row_ss_add(rss2, row, ss, fq); } }
    }
};
struct EpiGateUp : EpiBase {
    static constexpr bool PERM = true;
    bf16_t* ACT; const float* rss2;
    __device__ __forceinline__ void operator()(const f32x4 (&acc)[2][2][4][2], const Unit& u, int wr, int wc, int fr, int fq) const {
        const int row0 = u.pm * 256 + wr * 64 + fr, f0 = u.pn * 128 + wc * 32 + 8 * fq;
        float r2v[2][4];
#pragma unroll
        for (int ai = 0; ai < 2; ++ai)
#pragma unroll
            for (int m = 0; m < 4; ++m) r2v[ai][m] = rss2[row0 + ai * 128 + m * 16];
#pragma unroll
        for (int ai = 0; ai < 2; ++ai)
#pragma unroll
            for (int m = 0; m < 4; ++m) { const int row = row0 + ai * 128 + m * 16; const float r2 = rsqrtf(r2v[ai][m] * (1.f / 1024.f) + EPSV); float o[8];
#pragma unroll
                for (int n = 0; n < 2; ++n) { const f32x4 g = acc[ai][0][m][n] * r2, up = acc[ai][1][m][n] * r2;
#pragma unroll
                    for (int j = 0; j < 4; ++j) o[4 * n + j] = g[j] * sigmoidf_(g[j]) * up[j]; }
                u32x4 w; w.x = pk2(o[0], o[1]); w.y = pk2(o[2], o[3]); w.z = pk2(o[4], o[5]); w.w = pk2(o[6], o[7]); *(u32x4*)(ACT + (size_t)row * DFF + f0) = w; }
    }
};
struct EpiDown : EpiBase {
    static constexpr bool PERM = true;
    const bf16_t* X2B; bf16_t* X3B;
    __device__ __forceinline__ void operator()(const f32x4 (&acc)[2][2][4][2], const Unit& u, int wr, int wc, int fr, int fq) const {
        const int row0 = u.pm * 256 + wr * 64 + fr, col0 = u.pn * 256 + wc * 32 + 8 * fq;
#pragma unroll
        for (int ai = 0; ai < 2; ++ai) { u32x4 xv[4][2];
#pragma unroll
            for (int m = 0; m < 4; ++m)
#pragma unroll
                for (int bj = 0; bj < 2; ++bj) xv[m][bj] = *(const u32x4*)(X2B + (size_t)(row0 + ai * 128 + m * 16) * DM + col0 + bj * 128);
#pragma unroll
            for (int m = 0; m < 4; ++m) { const int row = row0 + ai * 128 + m * 16;
#pragma unroll
                for (int bj = 0; bj < 2; ++bj) { const f32x4 a0 = acc[ai][bj][m][0], a1 = acc[ai][bj][m][1]; const u32x4 x = xv[m][bj];
                    u32x4 w; w.x = pk2(bflo(x.x) + a0[0], bfhi(x.x) + a0[1]); w.y = pk2(bflo(x.y) + a0[2], bfhi(x.y) + a0[3]); w.z = pk2(bflo(x.z) + a1[0], bfhi(x.z) + a1[1]); w.w = pk2(bflo(x.w) + a1[2], bfhi(x.w) + a1[3]);
                    *(u32x4*)(X3B + (size_t)row * DM + col0 + bj * 128) = w; } } }
    }
};
struct EpiDownPart : EpiBase {
    static constexpr bool PERM = true;
    bf16_t* PART;
    __device__ __forceinline__ void operator()(const f32x4 (&acc)[2][2][4][2], const Unit& u, int wr, int wc, int fr, int fq) const {
        const int row0 = (u.pm - 64) * 256 + wr * 64 + fr, col0 = u.pn * 256 + wc * 32 + 8 * fq; bf16_t* base = PART + (size_t)(u.ko >> 8) * 1048576;
#pragma unroll
        for (int ai = 0; ai < 2; ++ai)
#pragma unroll
            for (int m = 0; m < 4; ++m)
#pragma unroll
                for (int bj = 0; bj < 2; ++bj) { const f32x4 a0 = acc[ai][bj][m][0], a1 = acc[ai][bj][m][1];
                    u32x4 w; w.x = pk2(a0[0], a0[1]); w.y = pk2(a0[2], a0[3]); w.z = pk2(a1[0], a1[1]); w.w = pk2(a1[2], a1[3]);
                    *(u32x4*)(base + (size_t)(row0 + ai * 128 + m * 16) * DM + col0 + bj * 128) = w; }
    }
};

__device__ __forceinline__ void p0_transpose_item(const float* W, int K, int N, bf16_t* WT, int mode, int bjoff, const float* ks1, const float* ks2, int ksplit, LAS float* scr, int item, int lane) {
    const int nblk = N / 32, kb = item / nblk, nb = item % nblk, k0 = 64 * kb, n0 = 32 * nb;
#pragma unroll 8
    for (int i = 0; i < 32; ++i) { const int kk = 2 * i + (lane >> 5), k = k0 + kk; float sc = 1.f; if (ks1) sc = k < ksplit ? ks1[k] : ks2[k - ksplit];
        scr[kk * 33 + (lane & 31)] = W[(size_t)k * N + n0 + (lane & 31)] * sc; }
    LDS_WAIT();
    const int c = lane & 7;
#pragma unroll
    for (int j = 0; j < 4; ++j) { const int n = (lane >> 3) + 8 * j; const LAS float* s = scr + (8 * c) * 33 + n; const int nn = n0 + n;
        const int row = mode ? (((nn >> 7) << 8) + bjoff + (nn & 127)) : nn;
        u32x4 o; o.x = pk2(s[0 * 33], s[1 * 33]); o.y = pk2(s[2 * 33], s[3 * 33]); o.z = pk2(s[4 * 33], s[5 * 33]); o.w = pk2(s[6 * 33], s[7 * 33]);
        *(u32x4*)(WT + (size_t)row * K + k0 + 8 * c) = o; }
    LDS_WAIT();
}

__device__ __forceinline__ void phase0(const Params& p, LAS unsigned char* lds) {
    const int tid = threadIdx.x, lane = tid & 63, wave = tid >> 6;
    const int gw = blockIdx.x * 8 + wave, NGW = gridDim.x * 8;
    unsigned char* ws = p.ws;
    {   bf16_t* XH = (bf16_t*)(ws + W_XH); const f32x4* g4 = (const f32x4*)p.in[4] + lane;
        for (int tok = gw; tok < MTOK; tok += 2 * NGW) { const int tok2 = tok + NGW < MTOK ? tok + NGW : tok;
            const f32x4* xr = (const f32x4*)xrow_ptr(p, tok) + lane; const f32x4* xr2 = (const f32x4*)xrow_ptr(p, tok2) + lane; f32x4 v[4], v2[4]; float s = 0.f, s2 = 0.f;
#pragma unroll
            for (int j = 0; j < 4; ++j) { v[j] = xr[64 * j]; v2[j] = xr2[64 * j]; }
#pragma unroll
            for (int j = 0; j < 4; ++j) { s += (v[j][0] * v[j][0] + v[j][1] * v[j][1]) + (v[j][2] * v[j][2] + v[j][3] * v[j][3]); s2 += (v2[j][0] * v2[j][0] + v2[j][1] * v2[j][1]) + (v2[j][2] * v2[j][2] + v2[j][3] * v2[j][3]); }
            const float r = rsqrtf(wave_sum(s) * (1.f / 1024.f) + EPSV), r2 = rsqrtf(wave_sum(s2) * (1.f / 1024.f) + EPSV);
            u32x2* o8 = (u32x2*)(XH + (size_t)tok * DM) + lane; u32x2* o82 = (u32x2*)(XH + (size_t)tok2 * DM) + lane;
#pragma unroll
            for (int j = 0; j < 4; ++j) { const f32x4 g = g4[64 * j]; u32x2 w; w.x = pk2(v[j][0] * r * g[0], v[j][1] * r * g[1]); w.y = pk2(v[j][2] * r * g[2], v[j][3] * r * g[3]); o8[64 * j] = w;
                u32x2 w2; w2.x = pk2(v2[j][0] * r2 * g[0], v2[j][1] * r2 * g[1]); w2.y = pk2(v2[j][2] * r2 * g[2], v2[j][3] * r2 * g[3]); o82[64 * j] = w2; } }
    }
    {   LAS float* scr = (LAS float*)(lds + wave * 8448);
        constexpr int I_IN = 16 * 48, I_GLU = 8 * 16, I_OUT = 16 * 32, NIT = I_IN + I_GLU + I_OUT;
        for (int it = gw; it < NIT; it += NGW) { int r = it;
            if (r < I_IN) { p0_transpose_item(p.in[5], 1024, 1536, (bf16_t*)(ws + W_BTIN), 0, 0, nullptr, nullptr, 0, scr, r, lane); continue; } r -= I_IN;
            if (r < I_GLU) { p0_transpose_item(p.in[14], 512, 512, (bf16_t*)(ws + W_BTGLU), 0, 0, nullptr, nullptr, 0, scr, r, lane); continue; } r -= I_GLU;
            p0_transpose_item(p.in[22], 1024, 1024, (bf16_t*)(ws + W_BTOUT), 0, 0, p.in[20], p.in[21], 512, scr, r, lane); }
    }
    const int gt = blockIdx.x * 512 + tid, NGT = gridDim.x * 512;
    for (int idx = gt; idx < 2048; idx += NGT) { const int g = idx >> 6;
        const float dt = expf(p.in[8][g]), lr = p.in[6][idx], li = p.in[7][idx];
        const float mag = expf(lr * dt), ar = mag * cosf(li * dt), ai = mag * sinf(li * dt), den = lr * lr + li * li;
        const float qr = ((ar - 1.0f) * lr + ai * li) / den, qi = (ai * lr - (ar - 1.0f) * li) / den;
        float* AT = (float*)(ws + W_ATAB); AT[idx * 2] = ar; AT[idx * 2 + 1] = ai;
        bf16_t* BB = (bf16_t*)(ws + W_BBT); const int n = idx & 63;
#pragma unroll
        for (int i = 0; i < 16; i += 2) { const float br0 = p.in[9][idx * 16 + i], bi0 = p.in[10][idx * 16 + i], br1 = p.in[9][idx * 16 + i + 1], bi1 = p.in[10][idx * 16 + i + 1];
            *(unsigned*)(BB + ((size_t)(g * 2 + 0) * 64 + n) * 16 + i) = pk2(qr * br0 - qi * bi0, qr * br1 - qi * bi1);
            *(unsigned*)(BB + ((size_t)(g * 2 + 1) * 64 + n) * 16 + i) = pk2(qr * bi0 + qi * br0, qr * bi1 + qi * br1); } }
    for (int idx = gt; idx < 32768; idx += NGT) { const int g = idx >> 10, o = (idx >> 6) & 15, kp = (idx & 63) * 2;
        const int c5 = kp >> 2, e = kp & 3; const size_t base = ((size_t)(g * 16 + o)) * 64;
        float v0, v1; if (e == 0) { v0 = p.in[11][base + c5]; v1 = p.in[11][base + c5 + 32]; } else { v0 = -p.in[12][base + c5]; v1 = -p.in[12][base + c5 + 32]; }
        *(unsigned*)((bf16_t*)(ws + W_CMT) + ((size_t)(g * 16 + o)) * 128 + kp) = pk2(v0, v1); }
    for (int idx = gt; idx < 131072; idx += NGT) { const int which = idx >> 16, h = (idx >> 13) & 7, t = (idx >> 6) & 127, s = (idx & 63) * 2; const float* wsr = p.in[18] + (size_t)h * 16384;
        float v0, v1;
        if (which == 0) { v0 = s <= t ? wsr[t * 128 + s] : 0.f; v1 = (s + 1) <= t ? wsr[t * 128 + s + 1] : 0.f; }
        else { const bool same = (t >> 3) == (s >> 3); const int tt = t & 7, s0 = s & 7; v0 = (same && s0 <= tt) ? wsr[tt * 128 + s0] : 0.f; v1 = (same && (s0 + 1) <= tt) ? wsr[tt * 128 + s0 + 1] : 0.f; }
        *(unsigned*)((bf16_t*)(ws + (which ? W_WTS : W_WTP)) + (size_t)h * 16384 + t * 128 + s) = pk2(v0, v1); }
    for (int idx = gt; idx < 4 * MTOK; idx += NGT) __hip_atomic_store((unsigned*)(ws + W_RSS) + idx, 0u, __ATOMIC_RELAXED, __HIP_MEMORY_SCOPE_AGENT);
}

__device__ __forceinline__ void p3_transposes(const Params& p, LAS unsigned char* lds, int first_idle) {
    const int tid = threadIdx.x, lane = tid & 63, wave = tid >> 6;
    if ((int)blockIdx.x < first_idle) return;
    const int gw = ((int)blockIdx.x - first_idle) * 8 + wave, NGW = ((int)gridDim.x - first_idle) * 8;
    unsigned char* ws = p.ws; LAS float* scr = (LAS float*)(lds + wave * 8448);
    constexpr int I_G = 16 * 88, I_DN = 44 * 32, NIT = 2 * I_G + I_DN;
    for (int it = gw; it < NIT; it += NGW) { int r = it;
        if (r < I_G) { p0_transpose_item(p.in[24], 1024, 2816, (bf16_t*)(ws + W_BTGU), 1, 0, p.in[23], p.in[23], 1024, scr, r, lane); continue; } r -= I_G;
        if (r < I_G) { p0_transpose_item(p.in[25], 1024, 2816, (bf16_t*)(ws + W_BTGU), 1, 128, p.in[23], p.in[23], 1024, scr, r, lane); continue; } r -= I_G;
        p0_transpose_item(p.in[26], 2816, 1024, (bf16_t*)(ws + W_BTDN), 0, 0, nullptr, nullptr, 0, scr, r, lane); }
}

constexpr int HT_STRIDE = 272, HT_WAVE = 32 * HT_STRIDE, SSEG_OFF = 8 * HT_WAVE;
struct S5Ctx { bf16x8 Bf[4]; bf16x8 Cf[4]; float ar0, ai0, ar1, ai1; float dsk[4]; };

__device__ __forceinline__ bf16x8 s5_load_a(const bf16_t* P, int g, int tokA, int tokB, int lane) {
    const int rho = lane & 31, half = (rho >> 2) & 1, r = 4 * (rho >> 3) + (rho & 3);
    const int tok = (half ? tokB : tokA) + r;
    return *(const bf16x8*)(P + (size_t)tok * INW + g * 16 + 8 * (lane >> 5));
}
__device__ __forceinline__ void s5_bu(const bf16x8 a, const S5Ctx& c, f32x16 (&acc)[4]) {
#pragma unroll
    for (int j = 0; j < 4; ++j) { f32x16 z;
#pragma unroll
        for (int i = 0; i < 16; ++i) z[i] = 0.f;
        acc[j] = __builtin_amdgcn_mfma_f32_32x32x16_bf16(a, c.Bf[j], z, 0, 0, 0); }
}
#define S5_STEP(r) do { const float nr0 = c.ar0 * hr0 - c.ai0 * hi0 + acc[0][r], ni0 = c.ar0 * hi0 + c.ai0 * hr0 + acc[2][r]; \
        const float nr1 = c.ar1 * hr1 - c.ai1 * hi1 + acc[1][r], ni1 = c.ar1 * hi1 + c.ai1 * hr1 + acc[3][r]; hr0 = nr0; hi0 = ni0; hr1 = nr1; hi1 = ni1; } while (0)

__device__ __forceinline__ u32x2 s5_load_x(const bf16_t* P, int g, int tok0, int lane) { return *(const u32x2*)(P + (size_t)(tok0 + (lane & 15)) * INW + g * 16 + 4 * (lane >> 4)); }
__device__ __forceinline__ void s5_y(bf16_t* GB, const S5Ctx& c, int g, int tokA, int tokB, int lane, LAS unsigned char* ht, const u32x2 xwA, const u32x2 xwB, bool nostore = false) {
    const int cc = lane & 15, q = lane >> 4;
#pragma unroll
    for (int t16 = 0; t16 < 2; ++t16) { f32x4 y = {0.f, 0.f, 0.f, 0.f};
#pragma unroll
        for (int ks = 0; ks < 4; ++ks) { const bf16x8 b = *(const LAS bf16x8*)(ht + (16 * t16 + cc) * HT_STRIDE + 64 * ks + 16 * q);
            y = __builtin_amdgcn_mfma_f32_16x16x32_bf16(c.Cf[ks], b, y, 0, 0, 0); }
        const int tok = (t16 ? tokB : tokA) + cc; const u32x2 xw = t16 ? xwB : xwA;
        const float o0 = gelu_t(y[0] + c.dsk[0] * bflo(xw.x)), o1 = gelu_t(y[1] + c.dsk[1] * bfhi(xw.x)), o2 = gelu_t(y[2] + c.dsk[2] * bflo(xw.y)), o3 = gelu_t(y[3] + c.dsk[3] * bfhi(xw.y));
        u32x2 w; w.x = pk2(o0, o1); w.y = pk2(o2, o3); if (!nostore) *(u32x2*)(GB + (size_t)tok * 512 + g * 16 + 4 * q) = w; }
}
__device__ __forceinline__ void s5_load_ctx(const Params& p, S5Ctx& c, int g, int lane) {
    const unsigned char* ws = p.ws; const int c5 = lane & 31, hh = lane >> 5;
    const float* AT = (const float*)(ws + W_ATAB) + (size_t)g * 128; c.ar0 = AT[c5 * 2]; c.ai0 = AT[c5 * 2 + 1]; c.ar1 = AT[(c5 + 32) * 2]; c.ai1 = AT[(c5 + 32) * 2 + 1];
    const bf16_t* BB = (const bf16_t*)(ws + W_BBT);
#pragma unroll
    for (int j = 0; j < 4; ++j) c.Bf[j] = *(const bf16x8*)(BB + ((size_t)(g * 2 + (j >> 1)) * 64 + 32 * (j & 1) + c5) * 16 + 8 * hh);
    const bf16_t* CM = (const bf16_t*)(ws + W_CMT) + ((size_t)(g * 16 + (lane & 15))) * 128;
#pragma unroll
    for (int ks = 0; ks < 4; ++ks) c.Cf[ks] = *(const bf16x8*)(CM + 32 * ks + 8 * (lane >> 4));
#pragma unroll
    for (int j = 0; j < 4; ++j) c.dsk[j] = p.in[13][g * 16 + 4 * (lane >> 4) + j];
}
#define S5_WRITE(r) do { u32x2 w; w.x = pk2(hr0, hr1); w.y = pk2(hi0, hi1); *(LAS u32x2*)(ht + (16 * hh + (r)) * HT_STRIDE + 8 * c5) = w; } while (0)

__device__ __forceinline__ void s5_prompt_item(const Params& p, int item, LAS unsigned char* lds, bool dryA = false, bool dryB = false) {
    const int tid = threadIdx.x, lane = tid & 63, wave = tid >> 6, c5 = lane & 31, hh = lane >> 5;
    const int slot = item >> 3, g = 4 * (item & 7) + (slot & 3), b = slot >> 2, seqbase = b * 2048;
    const bf16_t* P = (const bf16_t*)(p.ws + W_PBUF); bf16_t* GB = (bf16_t*)(p.ws + W_GBUF);
    S5Ctx c; s5_load_ctx(p, c, g, lane);
    LAS unsigned char* ht = lds + wave * HT_WAVE; LAS float* sseg = (LAS float*)(lds + SSEG_OFF);
    float hr0 = 0.f, hi0 = 0.f, hr1 = 0.f, hi1 = 0.f; f32x16 acc[4];
    const int tbase = seqbase + 256 * wave;
    bf16x8 acur = s5_load_a(P, g, tbase, tbase + 128, lane);
    for (int tile = 0; tile < 8; ++tile) { const int tn = tile < 7 ? tile + 1 : 7; const bf16x8 anext = s5_load_a(P, g, tbase + 16 * tn, tbase + 16 * tn + 128, lane);
        s5_bu(acur, c, acc); acur = anext;
#pragma unroll
        for (int r = 0; r < 16; ++r) S5_STEP(r); }
    const int seg = 2 * wave + hh;
    sseg[(seg * 64 + c5) * 2] = hr0; sseg[(seg * 64 + c5) * 2 + 1] = hi0; sseg[(seg * 64 + c5 + 32) * 2] = hr1; sseg[(seg * 64 + c5 + 32) * 2 + 1] = hi1;
    float pr0 = c.ar0, pi0 = c.ai0, pr1 = c.ar1, pi1 = c.ai1;
#pragma unroll
    for (int i = 0; i < 7; ++i) { const float t0 = pr0 * pr0 - pi0 * pi0, u0 = 2.f * pr0 * pi0, t1 = pr1 * pr1 - pi1 * pi1, u1 = 2.f * pr1 * pi1; pr0 = t0; pi0 = u0; pr1 = t1; pi1 = u1; }
    __syncthreads();
    hr0 = hi0 = hr1 = hi1 = 0.f;
    for (int j = 0; j < seg; ++j) { const float s0r = sseg[(j * 64 + c5) * 2], s0i = sseg[(j * 64 + c5) * 2 + 1], s1r = sseg[(j * 64 + c5 + 32) * 2], s1i = sseg[(j * 64 + c5 + 32) * 2 + 1];
        const float nr0 = pr0 * hr0 - pi0 * hi0 + s0r, ni0 = pr0 * hi0 + pi0 * hr0 + s0i, nr1 = pr1 * hr1 - pi1 * hi1 + s1r, ni1 = pr1 * hi1 + pi1 * hr1 + s1i; hr0 = nr0; hi0 = ni0; hr1 = nr1; hi1 = ni1; }
    acur = s5_load_a(P, g, tbase, tbase + 128, lane);
    for (int tile = 0; tile < 8; ++tile) { const int tokA = tbase + 16 * tile, tokB = tokA + 128; const int tn = tile < 7 ? tile + 1 : 7;
        const bf16x8 anext = s5_load_a(P, g, tbase + 16 * tn, tbase + 16 * tn + 128, lane);
        const u32x2 xwA = s5_load_x(P, g, tokA, lane), xwB = s5_load_x(P, g, tokB, lane);
        s5_bu(acur, c, acc); acur = anext;
#pragma unroll
        for (int r = 0; r < 16; ++r) { S5_STEP(r); S5_WRITE(r); }
        LDS_WAIT();
        s5_y(GB, c, g, tokA, tokB, lane, ht, xwA, xwB, dryA);
        LDS_WAIT(); }
    if (seg == 15 && !dryB) { float* ore = p.out + O_PRE + (size_t)(b * 32 + g) * 64; float* oim = p.out + O_PIM + (size_t)(b * 32 + g) * 64;
        ore[c5] = hr0; ore[c5 + 32] = hr1; oim[c5] = hi0; oim[c5 + 32] = hi1; }
    __syncthreads();
}
__device__ __forceinline__ void s5_sample_item(const Params& p, int item, LAS unsigned char* lds) {
    const int tid = threadIdx.x, lane = tid & 63, wave = tid >> 6, c5 = lane & 31, hh = lane >> 5;
    const int g = 4 * (item & 7) + ((item >> 3) & 3), qq = item >> 5;
    const bf16_t* P = (const bf16_t*)(p.ws + W_PBUF); bf16_t* GB = (bf16_t*)(p.ws + W_GBUF);
    S5Ctx c; s5_load_ctx(p, c, g, lane);
    LAS unsigned char* ht = lds + wave * HT_WAVE;
    const int b0 = 32 * qq + 4 * wave, tokA = NTP + 8 * b0, tokB = tokA + 16, bA = b0 + 2 * hh;
    float hr0, hi0, hr1, hi1; f32x16 acc[4];
    const u32x2 xwA = s5_load_x(P, g, tokA, lane), xwB = s5_load_x(P, g, tokB, lane);
    s5_bu(s5_load_a(P, g, tokA, tokB, lane), c, acc);
#pragma unroll
    for (int half = 0; half < 2; ++half) { const size_t so = ((size_t)(bA + half) * 32 + g) * 64;
        hr0 = p.in[2][so + c5]; hr1 = p.in[2][so + c5 + 32]; hi0 = p.in[3][so + c5]; hi1 = p.in[3][so + c5 + 32];
#pragma unroll
        for (int r8 = 0; r8 < 8; ++r8) { S5_STEP(half * 8 + r8); S5_WRITE(half * 8 + r8); }
        p.out[O_SRE + so + c5] = hr0; p.out[O_SRE + so + c5 + 32] = hr1; p.out[O_SIM + so + c5] = hi0; p.out[O_SIM + so + c5 + 32] = hi1; }
    LDS_WAIT();
    s5_y(GB, c, g, tokA, tokB, lane, ht, xwA, xwB);
    LDS_WAIT();
    __syncthreads();
}

__device__ __forceinline__ void cm_item(const Params& p, int item, LAS unsigned char* lds, bool dry) {
    const int tid = threadIdx.x, lane = tid & 63, wave = tid >> 6;
    const bool sample = item >= 128; int tok0; float* vout = nullptr; const bf16_t* WT; int tmask;
    if (!sample) { const int b = item >> 4, cidx = item & 15; tok0 = b * 2048 + 128 * cidx; if (cidx == 15) vout = p.out + O_PV + (size_t)b * 128 * 512; WT = (const bf16_t*)(p.ws + W_WTP); tmask = 127; }
    else { const int j = item - 128; tok0 = NTP + 128 * j; vout = p.out + O_SV + (size_t)j * 128 * 512; WT = (const bf16_t*)(p.ws + W_WTS); tmask = 7; }
    const bf16_t* P = (const bf16_t*)(p.ws + W_PBUF); bf16_t* MIX = (bf16_t*)(p.ws + W_MIX); float* rss_cm = (float*)(p.ws + W_RSS) + MTOK;
    {   float lg[8], lb[8];
#pragma unroll
        for (int j = 0; j < 8; ++j) { lg[j] = p.in[16][8 * lane + j]; lb[j] = p.in[17][8 * lane + j]; }
        u32x4 rawv[16];
#pragma unroll
        for (int i = 0; i < 16; ++i) rawv[i] = *(const u32x4*)(P + (size_t)(tok0 + 16 * wave + i) * INW + 1024 + 8 * lane);
#pragma unroll
        for (int i = 0; i < 8; ++i) { const int s = 16 * wave + 2 * i; float v[2][8];
#pragma unroll
            for (int e = 0; e < 2; ++e) { const u32x4 raw = rawv[2 * i + e];
                v[e][0] = bflo(raw.x); v[e][1] = bfhi(raw.x); v[e][2] = bflo(raw.y); v[e][3] = bfhi(raw.y); v[e][4] = bflo(raw.z); v[e][5] = bfhi(raw.z); v[e][6] = bflo(raw.w); v[e][7] = bfhi(raw.w);
                float sm = 0.f;
#pragma unroll
                for (int j = 0; j < 8; ++j) sm += v[e][j];
                const float mu = wave_sum(sm) * (1.f / 512.f); float s2 = 0.f;
#pragma unroll
                for (int j = 0; j < 8; ++j) { v[e][j] -= mu; s2 += v[e][j] * v[e][j]; }
                const float rs = rsqrtf(wave_sum(s2) * (1.f / 512.f) + EPSV);
#pragma unroll
                for (int j = 0; j < 8; ++j) v[e][j] = v[e][j] * rs * lg[j] + lb[j];
                if (vout) { float* vo = vout + (size_t)(s + e) * 512 + 8 * lane; *(f32x4*)vo = (f32x4){v[e][0], v[e][1], v[e][2], v[e][3]}; *(f32x4*)(vo + 4) = (f32x4){v[e][4], v[e][5], v[e][6], v[e][7]}; } }
            const int chunk = (s >> 3) ^ (lane & 15);
#pragma unroll
            for (int j = 0; j < 8; ++j) *(LAS unsigned*)(lds + (8 * lane + j) * 256 + chunk * 16 + (s & 7) * 2) = pk2(v[0][j], v[1][j]); }
    }
    __syncthreads();
    {   const int h = wave, cc = lane & 15, q = lane >> 4;
        bf16x8 Af[4][4];
#pragma unroll
        for (int dt = 0; dt < 4; ++dt)
#pragma unroll
            for (int ks = 0; ks < 4; ++ks) { const int d = 64 * h + 16 * dt + cc; Af[dt][ks] = *(const LAS bf16x8*)(lds + d * 256 + (((4 * ks + q) ^ ((d >> 3) & 15)) * 16)); }
        const bf16_t* Wh = WT + (size_t)h * 16384; const float* bs = p.in[19] + h * 128;
        bf16x8 bwN[4]; u32x2 uwN[4]; float biasN;
#define CM_LOAD(tt_) do { const int t_ = 16 * (tt_) + cc; \
            _Pragma("unroll") for (int ks = 0; ks < 4; ++ks) if (ks <= ((tt_) >> 1)) bwN[ks] = *(const bf16x8*)(Wh + t_ * 128 + 32 * ks + 8 * q); \
            _Pragma("unroll") for (int dt = 0; dt < 4; ++dt) uwN[dt] = *(const u32x2*)(P + (size_t)(tok0 + t_) * INW + 512 + 64 * h + 16 * dt + 4 * q); \
            biasN = bs[t_ & tmask]; } while (0)
        CM_LOAD(0);
#pragma unroll
        for (int tt = 0; tt < 8; ++tt) { const int t = 16 * tt + cc; f32x4 acc[4]; bf16x8 bw[4]; u32x2 uw[4];
#pragma unroll
            for (int ks = 0; ks < 4; ++ks) bw[ks] = bwN[ks];
#pragma unroll
            for (int dt = 0; dt < 4; ++dt) uw[dt] = uwN[dt];
            const float bias = biasN;
            if (tt < 7) CM_LOAD(tt + 1);
#pragma unroll
            for (int dt = 0; dt < 4; ++dt) acc[dt] = (f32x4){0.f, 0.f, 0.f, 0.f};
#pragma unroll
            for (int ks = 0; ks < 4; ++ks) if (ks <= (tt >> 1)) {
#pragma unroll
                for (int dt = 0; dt < 4; ++dt) acc[dt] = __builtin_amdgcn_mfma_f32_16x16x32_bf16(Af[dt][ks], bw[ks], acc[dt], 0, 0, 0); }
            float ss = 0.f; const size_t tok = (size_t)(tok0 + t);
#pragma unroll
            for (int dt = 0; dt < 4; ++dt) { const int d = 64 * h + 16 * dt + 4 * q;
                const float o0 = bflo(uw[dt].x) * (acc[dt][0] + bias), o1 = bfhi(uw[dt].x) * (acc[dt][1] + bias), o2 = bflo(uw[dt].y) * (acc[dt][2] + bias), o3 = bfhi(uw[dt].y) * (acc[dt][3] + bias);
                ss += o0 * o0 + o1 * o1 + o2 * o2 + o3 * o3; u32x2 w; w.x = pk2(o0, o1); w.y = pk2(o2, o3); *(u32x2*)(MIX + tok * DM + 512 + d) = w; }
            ss += __shfl_xor(ss, 16); ss += __shfl_xor(ss, 32);
            if (q == 0 && !dry) unsafeAtomicAdd(rss_cm + tok0 + t, ss);
            asm volatile("" ::: "memory"); }
#undef CM_LOAD
    }
    __syncthreads();
}

__device__ __forceinline__ void phase2(const Params& p, LAS unsigned char* lds, bool dry = false, int mask = 7) {
    for (int it = blockIdx.x; it < 256 + 128 + 136; it += gridDim.x) {
        if (it < 256) { if (mask & 1) s5_prompt_item(p, it, lds, dry && (PROBE_VAR & 1), dry && (PROBE_VAR & 2)); }
        else if (it < 392) { if (mask & 2) cm_item(p, it - 256, lds, dry); }
        else { if (mask & 4) s5_sample_item(p, it - 392, lds); }
    }
}
__device__ __forceinline__ void phase7(const Params& p, bool dry = false) {
    const int tid = threadIdx.x, lane = tid & 63, wave = tid >> 6, gw = blockIdx.x * 8 + wave, NGW = gridDim.x * 8;
    const f32x4* nf = (const f32x4*)p.in[27] + lane; const bf16_t* X3B = (const bf16_t*)(p.ws + W_X3B); const bf16_t* X2B = (const bf16_t*)(p.ws + W_X2B); const bf16_t* PART = (const bf16_t*)(p.ws + W_PART);
    f32x4 g[4];
#pragma unroll
    for (int j = 0; j < 4; ++j) g[j] = nf[64 * j];
    for (int q = gw; q < NTP + 2 * (MTOK - NTP); q += NGW) { if (q >= NTP && ((q - NTP) & 1)) continue;
        const int tok = q < NTP ? q : NTP + ((q - NTP) >> 1); f32x4 v[4];
        const u32x2* src = (const u32x2*)((tok < NTP ? X3B : X2B) + (size_t)tok * DM) + lane;
#pragma unroll
        for (int j = 0; j < 4; ++j) { const u32x2 w = src[64 * j]; v[j] = (f32x4){bflo(w.x), bfhi(w.x), bflo(w.y), bfhi(w.y)}; }
        if (tok >= NTP) { const u32x2* pp = (const u32x2*)(PART + (size_t)(tok - NTP) * DM) + lane;
#pragma unroll
            for (int ks = 0; ks < 11; ++ks) { u32x2 t[4];
#pragma unroll
                for (int j = 0; j < 4; ++j) t[j] = pp[(size_t)ks * 262144 + 64 * j];
#pragma unroll
                for (int j = 0; j < 4; ++j) v[j] = v[j] + (f32x4){bflo(t[j].x), bfhi(t[j].x), bflo(t[j].y), bfhi(t[j].y)}; } }
        float s2 = 0.f;
#pragma unroll
        for (int j = 0; j < 4; ++j) s2 += (v[j][0] * v[j][0] + v[j][1] * v[j][1]) + (v[j][2] * v[j][2] + v[j][3] * v[j][3]);
        const float r = rsqrtf(wave_sum(s2) * (1.f / 1024.f) + EPSV);
        f32x4* xr = (f32x4*)(p.out + (size_t)tok * DM) + lane;
        if (!dry) {
#pragma unroll
            for (int j = 0; j < 4; ++j) xr[64 * j] = v[j] * r * g[j]; } }
}

#define XB_TMO      128
#define XB_XCNT(j)  (256  + 64 * (j))
#define XB_XSUB(j)  (1280 + 64 * (j))
#define XB_XGEN(j)  (2304 + 64 * (j))
#define XB_TOP      3328
#define XB_TOPGEN   3392
#define XCD_BAR_WORDS 3456
#define XB_SPIN_CAP (1u << 18)

__device__ __forceinline__ unsigned xb_ld(unsigned* p)              { return __hip_atomic_load(p, __ATOMIC_RELAXED, __HIP_MEMORY_SCOPE_AGENT); }
__device__ __forceinline__ unsigned xb_add(unsigned* p, unsigned v) { return __hip_atomic_fetch_add(p, v, __ATOMIC_RELAXED, __HIP_MEMORY_SCOPE_AGENT); }
__device__ __forceinline__ unsigned xb_xcc_id() { return (unsigned)__builtin_amdgcn_s_getreg((3 << 11) | 20) & 0xFu; }
#define XB_SPIN(cond, bar) do { unsigned _sp = 0; while (cond) { __builtin_amdgcn_s_sleep(1); \
    if ((++_sp & 255u) == 0u) { if (xb_ld(&(bar)[XB_TMO])) break; if (_sp > XB_SPIN_CAP) { atomicAdd(&(bar)[XB_TMO], 1u); break; } } } } while (0)

struct XcdBarrier {
    unsigned* bar; unsigned x;
    volatile LAS unsigned* st;
};

__device__ __forceinline__ XcdBarrier xcd_barrier_post(unsigned* bar, volatile LAS unsigned* st) {
    XcdBarrier b; b.bar = bar; b.x = xb_xcc_id(); b.st = st;
    if (threadIdx.x == 0) (void)xb_add(&bar[XB_XCNT(b.x)], 1u);
    return b;
}
__device__ __forceinline__ void xcd_barrier_complete(unsigned* bar, unsigned x, unsigned& nloc, unsigned& nx) {
    const unsigned G = gridDim.x * gridDim.y * gridDim.z;
    unsigned sum, cnt, mine, sp = 0u;
    for (;;) {
        sum = 0u; cnt = 0u; mine = 0u;
#pragma unroll
        for (unsigned j = 0; j < 16; ++j) { const unsigned c = xb_ld(&bar[XB_XCNT(j)]); sum += c; cnt += (c > 0u) ? 1u : 0u; mine = (j == x) ? c : mine; }
        if (sum == G) break;
        __builtin_amdgcn_s_sleep(1);
        if ((++sp & 255u) == 0u) { if (xb_ld(&bar[XB_TMO])) break; if (sp > XB_SPIN_CAP) { atomicAdd(&bar[XB_TMO], 1u); break; } }
    }
    nloc = mine > 0u ? mine : 1u; nx = cnt > 0u ? cnt : 1u;
}

__device__ __forceinline__ void xcd_barrier(const XcdBarrier& b) {
    asm volatile("s_waitcnt vmcnt(0)" ::: "memory");
    __syncthreads();
    if (threadIdx.x == 0) {
        unsigned* bar = b.bar;
        __builtin_amdgcn_s_waitcnt(0);
        unsigned nloc = b.st[0], nx = b.st[1];
        if (nloc == 0u) { xcd_barrier_complete(bar, b.x, nloc, nx); b.st[0] = nloc; b.st[1] = nx; }
        __builtin_amdgcn_s_sleep(64);
        __builtin_amdgcn_fence(__ATOMIC_RELEASE, "agent"); asm volatile("s_waitcnt vmcnt(0)" ::: "memory");
        const unsigned old = xb_add(&bar[XB_XSUB(b.x)], 1u);
        const unsigned gen = old / nloc;
        if (old + 1u == (gen + 1u) * nloc) {
            __builtin_amdgcn_fence(__ATOMIC_RELEASE, "agent");
            asm volatile("s_waitcnt vmcnt(0)" ::: "memory");
            const unsigned og = xb_add(&bar[XB_TOP], 1u);
            const unsigned tg = og / nx;
            if (og + 1u == (tg + 1u) * nx) xb_add(&bar[XB_TOPGEN], 1u);
            else XB_SPIN(xb_ld(&bar[XB_TOPGEN]) == tg, bar);
            __builtin_amdgcn_fence(__ATOMIC_ACQUIRE, "agent");
            xb_add(&bar[XB_XGEN(b.x)], 1u);
            asm volatile("s_waitcnt vmcnt(0)" ::: "memory");
        } else {
            XB_SPIN(xb_ld(&bar[XB_XGEN(b.x)]) == gen, bar);
            __builtin_amdgcn_fence(__ATOMIC_ACQUIRE, "agent");
            asm volatile("s_waitcnt vmcnt(0)" ::: "memory");
        }
    }
    __syncthreads();
}


__global__ __launch_bounds__(512, 2) void mega_fwd(Params p) {
    extern __shared__ __attribute__((aligned(16))) unsigned char shm_raw[];
    LAS unsigned char* lds = (LAS unsigned char*)shm_raw;
    cg::grid_group grid = cg::this_grid();
    unsigned char* ws = p.ws; float* rss = (float*)(ws + W_RSS);
    pg8::StaticOrder S;
    volatile LAS unsigned* xst = (volatile LAS unsigned*)(lds + 131072 + 4096);
    if (threadIdx.x < 4) xst[threadIdx.x] = 0u;
    __syncthreads();
    const XcdBarrier xb = xcd_barrier_post((unsigned*)(ws + W_BAR), xst);
    if (p.ph_lo < 0) grid.sync();
#define PH_RUN(n, ...) if ((PHMASK & (1 << n)) && p.ph_lo <= n && n < p.ph_hi) { if (n > p.ph_lo) xcd_barrier(xb); \
        for (int rep = 0; rep < (PROBE_PH == n ? 1 + PROBE_N : 1); ++rep) { if (rep) xcd_barrier(xb); const bool dry = rep > 0; __VA_ARGS__ } }
    PH_RUN(0, phase0(p, lds); (void)dry;)
    PH_RUN(1, pg8::Gemm g{(const bf16_t*)(ws + W_XH), (const bf16_t*)(ws + W_BTIN), MTOK, INW, 1024, 1024}; S.init(g.M, g.N, gridDim.x, blockIdx.x);
        EpiInProj E; E.dry = dry; E.P = (bf16_t*)(ws + W_PBUF); pg8::gemm_phase<EpiInProj, pg8::StaticOrder, GP_ALIGN, GP_SP2>(lds, g, S, E);)
    PH_RUN(2, phase2(p, lds, dry, dry ? PROBE_P2MASK : 7);)
    PH_RUN(3, { pg8::Gemm g{(const bf16_t*)(ws + W_GBUF), (const bf16_t*)(ws + W_BTGLU), MTOK, 512, 512, 512}; pg8::StaticOrder S3; S3.init(g.M, g.N, gridDim.x, blockIdx.x);
        EpiGlu E; E.dry = dry; E.G = (const bf16_t*)(ws + W_GBUF); E.MIX = (bf16_t*)(ws + W_MIX); E.bglu = p.in[15]; E.rss = rss;
        p3_transposes(p, lds, 136);
        pg8::gemm_phase<EpiGlu, pg8::StaticOrder, GP_ALIGN, GP_SP2>(lds, g, S3, E);
        asm volatile("s_waitcnt vmcnt(0)" ::: "memory");
        __syncthreads();
        if (threadIdx.x == 0) { Unit u; if (S3.next(0, u)) { __builtin_amdgcn_s_sleep(64); __builtin_amdgcn_fence(__ATOMIC_RELEASE, "agent"); asm volatile("s_waitcnt vmcnt(0)" ::: "memory");
            for (int i = 0; S3.next(i, u); ++i) __hip_atomic_fetch_add((unsigned*)(ws + W_BAR) + 4096 + 16 * (1 + u.pm), 1u, __ATOMIC_RELAXED, __HIP_MEMORY_SCOPE_AGENT); } } }
        { pg8::Gemm g{(const bf16_t*)(ws + W_MIX), (const bf16_t*)(ws + W_BTOUT), NTP, 1024, 1024, 1024}; S.init(g.M, g.N, gridDim.x, blockIdx.x);
        EpiOutProj E; E.dry = dry; E.xp = p.in[0]; E.xs = p.in[1]; E.X2B = (bf16_t*)(ws + W_X2B); E.rss2 = rss + 2 * MTOK;
        LAS float* fl = (LAS float*)(lds + 131072); E.fl = fl; E.pm0 = -1; E.pn0 = -1;
        if (threadIdx.x == 0) { bool any = false;
            for (int i = 0; i < 2; ++i) { Unit u0; if (!S.next(i, u0)) break; any = true; const unsigned* c = (const unsigned*)(ws + W_BAR) + 4096 + 16 * (1 + u0.pm);
                for (unsigned sp = 0; sp < (1u << 16); ++sp) { if (__hip_atomic_load(c, __ATOMIC_RELAXED, __HIP_MEMORY_SCOPE_AGENT) >= 2u) break; __builtin_amdgcn_s_sleep(2); } }
            if (any) { __builtin_amdgcn_fence(__ATOMIC_ACQUIRE, "agent"); asm volatile("s_waitcnt vmcnt(0)" ::: "memory"); } }
        __syncthreads();
        for (int i = 0; i < 2; ++i) { Unit u; if (S.next(i, u)) { if (i == 0) { E.pm0 = u.pm; E.pn0 = u.pn; }
            if (threadIdx.x < 256) { const int row = u.pm * 256 + threadIdx.x; const float a = rss[row] * (1.f / 512.f) + EPSV; const float b = rss[MTOK + row] * (1.f / 512.f) + EPSV;
                fl[i * 256 + threadIdx.x] = sqrtf(b / a); fl[512 + i * 256 + threadIdx.x] = rsqrtf(b); } } }
        __syncthreads();
        pg8::gemm_phase<EpiOutProj, pg8::StaticOrder, GP_ALIGN, GP_SP2>(lds, g, S, E); })
    PH_RUN(5, { pg8::Gemm g{(const bf16_t*)(ws + W_MIX), (const bf16_t*)(ws + W_BTOUT), MTOK, 1024, 1024, 1024};
        pg8::SampleOutOrder S4; S4.c = blockIdx.x; S4.base = (int)gridDim.x - 16; S4.cnt = (unsigned*)(ws + W_BAR) + 4096;
        EpiOutProj E; E.dry = dry; E.xp = p.in[0]; E.xs = p.in[1]; E.X2B = (bf16_t*)(ws + W_X2B); E.rss2 = rss + 2 * MTOK;
        LAS float* fl = (LAS float*)(lds + 131072); E.fl = fl; E.pm0 = -1; E.pn0 = -1;
        { Unit u; if (S4.next(0, u)) { E.pm0 = u.pm; E.pn0 = u.pn;
            if (threadIdx.x < 256) { const int row = u.pm * 256 + threadIdx.x; const float a = rss[row] * (1.f / 512.f) + EPSV; const float b = rss[MTOK + row] * (1.f / 512.f) + EPSV;
                fl[threadIdx.x] = sqrtf(b / a); fl[512 + threadIdx.x] = rsqrtf(b); } } }
        __syncthreads();
        pg8::gemm_phase<EpiOutProj, pg8::SampleOutOrder, GP_ALIGN, GP_SP2>(lds, g, S4, E);
        asm volatile("s_waitcnt vmcnt(0)" ::: "memory");
        __syncthreads();
        if (threadIdx.x == 0) { Unit u; if (S4.next(0, u)) { __builtin_amdgcn_s_sleep(64); __builtin_amdgcn_fence(__ATOMIC_RELEASE, "agent"); asm volatile("s_waitcnt vmcnt(0)" ::: "memory");
            __hip_atomic_fetch_add(S4.cnt, 1u, __ATOMIC_RELAXED, __HIP_MEMORY_SCOPE_AGENT); } } }
        { pg8::Gemm g{(const bf16_t*)(ws + W_X2B), (const bf16_t*)(ws + W_BTGU), MTOK, 2 * DFF, 1024, 1024}; pg8::CountedGU S5; S5.init(g.M, g.N, gridDim.x, blockIdx.x); S5.cnt = (const unsigned*)(ws + W_BAR) + 4096;
        EpiGateUp E; E.dry = dry; E.ACT = (bf16_t*)(ws + W_ACT); E.rss2 = rss + 2 * MTOK;
        pg8::gemm_phase<EpiGateUp, pg8::CountedGU, GP_ALIGN, GP_SP2>(lds, g, S5, E); })
    PH_RUN(6, { pg8::Gemm g{(const bf16_t*)(ws + W_ACT), (const bf16_t*)(ws + W_BTDN), NTP, 1024, DFF, DFF}; S.init(g.M, g.N, gridDim.x, blockIdx.x);
        EpiDown E; E.dry = dry; E.X2B = (const bf16_t*)(ws + W_X2B); E.X3B = (bf16_t*)(ws + W_X3B);
        pg8::gemm_phase<EpiDown, pg8::StaticOrder, GP_ALIGN, GP_SP2>(lds, g, S, E); }
        { pg8::Gemm g{(const bf16_t*)(ws + W_ACT), (const bf16_t*)(ws + W_BTDN), MTOK, 1024, 256, DFF}; pg8::SplitKOrder S2; S2.init(gridDim.x, blockIdx.x);
        EpiDownPart E; E.dry = dry; E.PART = (bf16_t*)(ws + W_PART);
        pg8::gemm_phase<EpiDownPart, pg8::SplitKOrder, GP_ALIGN, GP_SP2>(lds, g, S2, E); })
    PH_RUN(7, phase7(p, dry);)
}

extern "C" void kernel_launch(void* const* d_in, const int* in_sizes, int n_in, void* d_out, int out_size, void* d_ws, size_t ws_size, hipStream_t stream) {
    static int grid = 0;
    if (grid == 0) {
        if (n_in != 28 || ws_size < W_END) { fprintf(stderr, "kernel_launch: unexpected n_in %d / ws %zu (need %zu)\n", n_in, ws_size, (size_t)W_END); grid = -1; return; }
        int dev = 0, cus = 0, per_cu = 0;
        if (hipGetDevice(&dev) != hipSuccess || hipDeviceGetAttribute(&cus, hipDeviceAttributeMultiprocessorCount, dev) != hipSuccess) { grid = -1; return; }
        if (hipFuncSetAttribute((const void*)mega_fwd, hipFuncAttributeMaxDynamicSharedMemorySize, LDS_BYTES) != hipSuccess) { fprintf(stderr, "kernel_launch: hipFuncSetAttribute failed\n"); grid = -1; return; }
        if (hipOccupancyMaxActiveBlocksPerMultiprocessor(&per_cu, (const void*)mega_fwd, 512, LDS_BYTES) != hipSuccess || per_cu < 1) { fprintf(stderr, "kernel_launch: occupancy query says %d\n", per_cu); per_cu = 1; }
        (void)hipGetLastError();
        grid = cus * 1;
    }
    if (grid < 0) return;
    if (hipMemsetAsync((unsigned char*)d_ws + W_BAR, 0, 32768, stream) != hipSuccess) { fprintf(stderr, "kernel_launch: memset failed\n"); return; }
    Params p{};
    for (int i = 0; i < 28; ++i) p.in[i] = (const float*)d_in[i];
    p.out = (float*)d_out; p.ws = (unsigned char*)d_ws;
#if MK_MULTI_LAUNCH
    for (int ph = 0; ph < 8; ++ph) { p.ph_lo = ph; p.ph_hi = ph + 1; hipLaunchKernelGGL(mega_fwd, dim3(grid), dim3(512), LDS_BYTES, stream, p); }
#else
    p.ph_lo = 0; p.ph_hi = 8;
    void* args[] = {&p};
    hipError_t e = hipLaunchCooperativeKernel((const void*)mega_fwd, dim3(grid), dim3(512), args, LDS_BYTES, stream);
    if (e != hipSuccess) fprintf(stderr, "kernel_launch: cooperative launch failed: %s (grid %d)\n", hipGetErrorString(e), grid);
#endif
}
```

```cpp
#include <hip/hip_runtime.h>
#include <hip/hip_cooperative_groups.h>
#include <cstdio>
#include <cstdint>
namespace cg = cooperative_groups;
#ifndef PHMASK
#define PHMASK 255
#endif
#ifndef PROBE_PH
#define PROBE_PH -1
#endif
#ifndef PROBE_P2MASK
#define PROBE_P2MASK 7
#endif
#ifndef PROBE_VAR
#define PROBE_VAR 0
#endif
#ifndef PROBE_N
#define PROBE_N 2
#endif
#ifndef GP_ALIGN
#define GP_ALIGN true
#endif
#ifndef GP_SP2
#define GP_SP2 true
#endif
#ifndef MK_MULTI_LAUNCH
#define MK_MULTI_LAUNCH 0
#endif
namespace pg8 {
#define PG8_LAS __attribute__((address_space(3)))
typedef unsigned short bf16_t;
typedef short bf16x8 __attribute__((ext_vector_type(8)));
typedef float f32x4 __attribute__((ext_vector_type(4)));
typedef unsigned u32x4 __attribute__((ext_vector_type(4)));
constexpr int BM = 256, BK = 64, HALF = 128, HTB = HALF * BK * 2  , STAGE_BYTES = 8 * HTB, NXCD = 8, WGM = 8;

__host__ __device__ __forceinline__ int lds_byte(int r, int c) { const int st = (r >> 4) * 2 + (c >> 5), rr = r & 15, cc = c & 31, ob = rr * 64 + cc * 2; return st * 1024 + (ob ^ (((ob >> 9) & 1) << 5)); }
__host__ __device__ __forceinline__ void stage_rc(int b, int& R, int& C) { const int st = b / 1024, sb = b % 1024, swz = sb ^ (((sb >> 9) & 1) << 5); R = (st >> 1) * 16 + swz / 64; C = (st & 1) * 32 + (swz % 64) / 2; }
__host__ __device__ __forceinline__ int perm32(int rho) { const int n = rho >> 4, i = rho & 15; return 8 * (i >> 2) + 4 * n + (i & 3); }

struct Unit { int pm, pn, ko; };
struct Gemm { const bf16_t* A; const bf16_t* Bt; int M, N, K, ld; };

struct StaticOrder {
    int nM, nN, nwg, G, c;
    __host__ __device__ void init(int M, int N, int G_, int c_) { nM = M / BM; nN = N / BM; nwg = nM * nN; G = G_; c = c_; }
    __host__ __device__ bool next(int i, Unit& u) const {
        const long L = (long)i * G + c; if (L >= nwg) return false;
        int wgid = (int)L; { const int q = nwg / NXCD, r = nwg % NXCD, xcd = wgid % NXCD, off = wgid / NXCD; wgid = (xcd < r ? xcd * (q + 1) : r * (q + 1) + (xcd - r) * q) + off; }
        const int nig = WGM * nN, gid = wgid / nig, fm = gid * WGM, gsz = (nM - fm) < WGM ? (nM - fm) : WGM;
        u.pm = fm + ((wgid % nig) % gsz); u.pn = (wgid % nig) / gsz; u.ko = 0; return true;
    }
    __device__ __forceinline__ void a_ready(const Unit&) const {}
    __device__ __forceinline__ void done(const Unit&) const {}
};
struct SplitKOrder {
    int G, c;
    __host__ __device__ void init(int G_, int c_) { G = G_; c = c_; }
    __host__ __device__ bool next(int i, Unit& u) const { const long L = (long)i * G + c; if (L >= 176) return false; const int ks = (int)L % 11, rem = (int)L / 11; u.pm = 64 + (rem >> 2); u.pn = rem & 3; u.ko = ks * 256; return true; }
    __device__ __forceinline__ void a_ready(const Unit&) const {}
    __device__ __forceinline__ void done(const Unit&) const {}
};
struct GluOrder : StaticOrder {
    unsigned* cnt;
    __device__ __forceinline__ void done(const Unit& u) const {
        asm volatile("s_waitcnt vmcnt(0)" ::: "memory");
        __builtin_amdgcn_fence(__ATOMIC_RELEASE, "agent");
        asm volatile("s_waitcnt vmcnt(0)" ::: "memory");
        if ((threadIdx.x & 63) == 0) __hip_atomic_fetch_add(cnt + 16 * (1 + u.pm), 1u, __ATOMIC_RELAXED, __HIP_MEMORY_SCOPE_AGENT);
    }
};
struct SampleOutOrder {
    int c, base; unsigned* cnt;
    __host__ __device__ bool next(int i, Unit& u) const { if (i != 0 || c < base) return false; const int k = c - base; u.pm = 64 + (k >> 2); u.pn = k & 3; u.ko = 0; return true; }
    __device__ __forceinline__ void a_ready(const Unit&) const {}
    __device__ __forceinline__ void done(const Unit&) const {}
};
struct CountedGU : StaticOrder {
    const unsigned* cnt;
    __device__ __forceinline__ void a_ready(const Unit& u) const {
        if (u.pm >= 64) {
            if (threadIdx.x < 64) {
                for (unsigned sp = 0; sp < (1u << 16); ++sp) { if ((unsigned)__builtin_amdgcn_readfirstlane((int)__hip_atomic_load(cnt, __ATOMIC_RELAXED, __HIP_MEMORY_SCOPE_AGENT)) >= 16u) break; __builtin_amdgcn_s_sleep(2); }
                __builtin_amdgcn_fence(__ATOMIC_ACQUIRE, "agent");
                asm volatile("s_waitcnt vmcnt(0)" ::: "memory");
            }
            asm volatile("" ::: "memory"); __builtin_amdgcn_s_barrier(); asm volatile("" ::: "memory");
        }
    }
};
template <class Epi, class Sched, bool ALIGN_EPI = false, bool SP2 = false>
__device__ __forceinline__ void gemm_phase(PG8_LAS unsigned char* lds, const Gemm g, const Sched& S, const Epi& E) {
    const int tid = threadIdx.x, wid = __builtin_amdgcn_readfirstlane(tid >> 6), lane = tid & 63, wr = wid >> 2, wc = wid & 3, fr = lane & 15, fq = lane >> 4;
    const int K = g.K, nt = K / BK, LD = g.ld;
    unsigned voffA[2], voffB[2];
#pragma unroll
    for (int i = 0; i < 2; ++i) { int R, C; stage_rc(tid * 16 + i * 8192, R, C); const int Rb = Epi::PERM ? ((R & ~31) + perm32(R & 31)) : R;
        voffA[i] = (unsigned)(R * LD + C) * 2u; voffB[i] = (unsigned)(Rb * LD + C) * 2u; }
    const size_t kstep = (size_t)(BK * 2);
    const size_t hstep = (size_t)HALF * LD * 2;
    const size_t tstep = 2 * hstep;
    const unsigned ldsw = (unsigned)wid * 1024u;
    const int aoff = lds_byte(wr * 64 + fr, fq * 8), boff = lds_byte(wc * 32 + fr, fq * 8);
#define PG8_SA(b, h) (((b) * 2 + (h)) * HTB)
#define PG8_SB(b, h) ((4 + (b) * 2 + (h)) * HTB)
#define PG8_STAGE(bufoff, gbase, voff) do { _Pragma("unroll") for (int _i = 0; _i < 2; ++_i) \
        __builtin_amdgcn_global_load_lds((const unsigned*)((const char*)(gbase) + (voff)[_i]), (PG8_LAS unsigned*)(lds + (bufoff) + ldsw + _i * 8192), 16, 0, 0); } while (0)
#define PG8_LDA(dst, b, h) do { _Pragma("unroll") for (int m = 0; m < 4; ++m) _Pragma("unroll") for (int k = 0; k < 2; ++k) dst[m][k] = *(const PG8_LAS bf16x8*)(lds + PG8_SA(b, h) + aoff + m * 2048 + k * 1024); } while (0)
#define PG8_LDB(dst, b, h) do { _Pragma("unroll") for (int n = 0; n < 2; ++n) _Pragma("unroll") for (int k = 0; k < 2; ++k) dst[n][k] = *(const PG8_LAS bf16x8*)(lds + PG8_SB(b, h) + boff + n * 2048 + k * 1024); } while (0)
#define PG8_MMA(ai, bj, At, Bt) do { __builtin_amdgcn_s_setprio(1); _Pragma("unroll") for (int m = 0; m < 4; ++m) _Pragma("unroll") for (int n = 0; n < 2; ++n) _Pragma("unroll") for (int k = 0; k < 2; ++k) \
        acc[ai][bj][m][n] = __builtin_amdgcn_mfma_f32_16x16x32_bf16(Bt[n][k], At[m][k], acc[ai][bj][m][n], 0, 0, 0); __builtin_amdgcn_s_setprio(0); } while (0)
#define PG8_WAIT_V(n) asm volatile("s_waitcnt vmcnt(" #n ")" ::: "memory")
#define PG8_WAIT_L(n) asm volatile("s_waitcnt lgkmcnt(" #n ")" ::: "memory")
#define PG8_BAR __builtin_amdgcn_s_barrier()
#define PG8_SCHED __builtin_amdgcn_sched_barrier(0)
    Unit cur, nxt; int ui = 0;
    if (!S.next(0, cur)) return;
    f32x4 acc[2][2][4][2];
#pragma unroll
    for (int a = 0; a < 2; ++a)
#pragma unroll
        for (int b = 0; b < 2; ++b)
#pragma unroll
            for (int m = 0; m < 4; ++m)
#pragma unroll
                for (int n = 0; n < 2; ++n) acc[a][b][m][n] = (f32x4){0.f, 0.f, 0.f, 0.f};
    bf16x8 At[4][2], B0[2][2], B1[2][2];
    const char* cA = (const char*)g.A + (size_t)cur.pm * tstep + (size_t)cur.ko * 2; const char* cB = (const char*)g.Bt + (size_t)cur.pn * tstep + (size_t)cur.ko * 2;
    S.a_ready(cur);
    if constexpr (SP2) {
        PG8_STAGE(PG8_SB(0, 0), cB, voffB); PG8_STAGE(PG8_SB(0, 1), cB + hstep, voffB); PG8_STAGE(PG8_SA(0, 0), cA, voffA); PG8_STAGE(PG8_SA(0, 1), cA + hstep, voffA);
        if (wr == 1) PG8_BAR;
        PG8_WAIT_V(2); PG8_BAR;
        PG8_STAGE(PG8_SB(1, 0), cB + kstep, voffB); PG8_STAGE(PG8_SA(1, 0), cA + kstep, voffA); PG8_STAGE(PG8_SB(1, 1), cB + hstep + kstep, voffB);
        PG8_WAIT_V(6); PG8_BAR;
    } else {
        PG8_STAGE(PG8_SB(0, 0), cB, voffB); PG8_STAGE(PG8_SA(0, 0), cA, voffA); PG8_STAGE(PG8_SB(0, 1), cB + hstep, voffB); PG8_STAGE(PG8_SA(0, 1), cA + hstep, voffA);
        if (wr == 1) PG8_BAR;
        PG8_WAIT_V(4); PG8_BAR;
        PG8_STAGE(PG8_SB(1, 0), cB + kstep, voffB); PG8_STAGE(PG8_SA(1, 0), cA + kstep, voffA); PG8_STAGE(PG8_SB(1, 1), cB + hstep + kstep, voffB);
        PG8_WAIT_V(6); PG8_BAR;
    }
    for (;;) {
        const bool has_next = S.next(ui + 1, nxt);
        const char* nA = has_next ? (const char*)g.A + (size_t)nxt.pm * tstep + (size_t)nxt.ko * 2 : cA; const char* nB = has_next ? (const char*)g.Bt + (size_t)nxt.pn * tstep + (size_t)nxt.ko * 2 : cB;
        for (int t = 0; t < nt; t += 2) {
            const bool last = (t == nt - 2);
            const char* a1 = cA + (size_t)(t + 1) * kstep;
            const char* a2 = last ? nA : cA + (size_t)(t + 2) * kstep; const char* b2 = last ? nB : cB + (size_t)(t + 2) * kstep;
            const char* a3 = a2 + kstep; const char* b3 = b2 + kstep;
            if (last && has_next) S.a_ready(nxt);
            if constexpr (Epi::HAS_MID) { if (t == Epi::MID_T) E.mid(acc, cur, wr, wc, fr, fq); }
            if constexpr (SP2) {
            PG8_LDB(B0, 0, 0); PG8_LDB(B1, 0, 1); PG8_SCHED; PG8_LDA(At, 0, 0); PG8_STAGE(PG8_SA(1, 1), a1 + hstep, voffA);
            PG8_WAIT_V(8); PG8_WAIT_L(0); PG8_BAR; PG8_MMA(0, 0, At, B0); PG8_MMA(0, 1, At, B1); PG8_BAR; PG8_SCHED;
            PG8_LDA(At, 0, 1); PG8_STAGE(PG8_SB(0, 0), b2, voffB); PG8_STAGE(PG8_SB(0, 1), b2 + hstep, voffB); PG8_STAGE(PG8_SA(0, 0), a2, voffA);
            PG8_WAIT_V(8); PG8_WAIT_L(0); PG8_BAR; PG8_MMA(1, 0, At, B0); PG8_MMA(1, 1, At, B1); PG8_BAR; PG8_SCHED;
            PG8_LDB(B0, 1, 0); PG8_LDB(B1, 1, 1); PG8_SCHED; PG8_LDA(At, 1, 0); PG8_STAGE(PG8_SA(0, 1), a2 + hstep, voffA);
            PG8_WAIT_V(8); PG8_WAIT_L(0); PG8_BAR; PG8_MMA(0, 0, At, B0); PG8_MMA(0, 1, At, B1); PG8_BAR; PG8_SCHED;
            PG8_LDA(At, 1, 1); PG8_STAGE(PG8_SB(1, 0), b3, voffB); PG8_STAGE(PG8_SB(1, 1), b3 + hstep, voffB); PG8_STAGE(PG8_SA(1, 0), a3, voffA);
            PG8_WAIT_V(8); PG8_WAIT_L(0); PG8_BAR; PG8_MMA(1, 0, At, B0); PG8_MMA(1, 1, At, B1); PG8_BAR; PG8_SCHED;
            } else {
            PG8_LDB(B0, 0, 0); PG8_SCHED; PG8_LDA(At, 0, 0); PG8_STAGE(PG8_SA(1, 1), a1 + hstep, voffA);
            PG8_WAIT_L(8); PG8_BAR; PG8_WAIT_L(0); PG8_MMA(0, 0, At, B0); PG8_BAR; PG8_SCHED;
            PG8_LDB(B1, 0, 1); PG8_STAGE(PG8_SB(0, 0), b2, voffB);
            PG8_BAR; PG8_WAIT_L(0); PG8_MMA(0, 1, At, B1); PG8_BAR;
            PG8_LDA(At, 0, 1); PG8_STAGE(PG8_SA(0, 0), a2, voffA);
            PG8_BAR; PG8_WAIT_L(0); PG8_MMA(1, 0, At, B0); PG8_BAR; PG8_SCHED;
            PG8_STAGE(PG8_SB(0, 1), b2 + hstep, voffB);
            PG8_WAIT_V(6); PG8_BAR; PG8_MMA(1, 1, At, B1); PG8_BAR;
            PG8_LDB(B0, 1, 0); PG8_SCHED; PG8_LDA(At, 1, 0); PG8_STAGE(PG8_SA(0, 1), a2 + hstep, voffA);
            PG8_WAIT_L(8); PG8_BAR; PG8_WAIT_L(0); PG8_MMA(0, 0, At, B0); PG8_BAR; PG8_SCHED;
            PG8_LDB(B1, 1, 1); PG8_STAGE(PG8_SB(1, 0), b3, voffB);
            PG8_BAR; PG8_WAIT_L(0); PG8_MMA(0, 1, At, B1); PG8_BAR;
            PG8_LDA(At, 1, 1); PG8_STAGE(PG8_SA(1, 0), a3, voffA);
            PG8_BAR; PG8_WAIT_L(0); PG8_MMA(1, 0, At, B0); PG8_BAR; PG8_SCHED;
            PG8_STAGE(PG8_SB(1, 1), b3 + hstep, voffB);
            PG8_WAIT_V(6); PG8_BAR; PG8_MMA(1, 1, At, B1); PG8_BAR;
            }
        }
        if constexpr (ALIGN_EPI) { if (wr == 0) PG8_BAR; }
        if constexpr (!Epi::AFTER_DRAIN) { E(acc, cur, wr, wc, fr, fq); S.done(cur); }
        if (!has_next) break;
#pragma unroll
        for (int a = 0; a < 2; ++a)
#pragma unroll
            for (int b = 0; b < 2; ++b)
#pragma unroll
                for (int m = 0; m < 4; ++m)
#pragma unroll
                    for (int n = 0; n < 2; ++n) acc[a][b][m][n] = (f32x4){0.f, 0.f, 0.f, 0.f};
        cur = nxt; cA = nA; cB = nB; ++ui;
        if constexpr (ALIGN_EPI) { if (wr == 1) PG8_BAR; }
    }
    PG8_WAIT_V(0);
    if constexpr (!ALIGN_EPI) { if (wr == 0) PG8_BAR; }
    PG8_BAR;
    if constexpr (Epi::AFTER_DRAIN) { E.fused(acc, cur, wr, wc, fr, fq, lds, wid, lane); S.done(cur); }
#undef PG8_SA
#undef PG8_SB
#undef PG8_STAGE
#undef PG8_LDA
#undef PG8_LDB
#undef PG8_MMA
#undef PG8_WAIT_V
#undef PG8_WAIT_L
#undef PG8_BAR
#undef PG8_SCHED
}
}

using pg8::bf16_t; using pg8::bf16x8; using pg8::f32x4; using pg8::Unit;
#define LAS __attribute__((address_space(3)))
typedef unsigned u32x2 __attribute__((ext_vector_type(2)));
typedef unsigned u32x4 __attribute__((ext_vector_type(4)));
typedef float f32x16 __attribute__((ext_vector_type(16)));

constexpr int DM = 1024, NTP = 16384, MTOK = 17408, INW = 1536, DFF = 2816;
constexpr float EPSV = 1e-6f;
constexpr size_t O_Y = 0, O_PRE = 17825792, O_PIM = 17842176, O_PV = 17858560, O_SRE = 18382848, O_SIM = 18644992, O_SV = 18907136;
constexpr size_t W_ACT = 0, W_XH = 0, W_GBUF = 0, W_MIX = 35651584, W_PBUF = 71303168, W_X2B = 98041856;
constexpr size_t W_BTIN = 133693440, W_BTGLU = W_BTIN + 3145728, W_BTOUT = W_BTGLU + 524288, W_BTGU = W_BTOUT + 2097152, W_BTDN = W_BTGU + 11534336;
constexpr size_t W_ATAB = W_BTDN + 5767168, W_BBT = W_ATAB + 16384, W_CMT = W_BBT + 131072, W_WTP = W_CMT + 131072, W_WTS = W_WTP + 262144, W_RSS = W_WTS + 262144;
constexpr size_t W_BAR = W_RSS + 4 * 17408 * 4;
constexpr size_t W_X3B = W_BAR + 32768;
constexpr size_t W_PART = W_X3B + 33554432;
constexpr size_t W_END = W_PART + 11 * 4194304;
constexpr int LDS_BYTES = 131072 + 4096 + 256;

struct Params { const float* in[28]; float* out; unsigned char* ws; int ph_lo, ph_hi; };

__device__ __forceinline__ unsigned pk2(float lo, float hi) { unsigned r; asm volatile("v_cvt_pk_bf16_f32 %0, %1, %2" : "=v"(r) : "v"(lo), "v"(hi)); return r; }
__device__ __forceinline__ float bflo(unsigned w) { return __uint_as_float(w << 16); }
__device__ __forceinline__ float bfhi(unsigned w) { return __uint_as_float(w & 0xffff0000u); }
__device__ __forceinline__ float sigmoidf_(float z) { return __builtin_amdgcn_rcpf(1.0f + __builtin_amdgcn_exp2f(-1.4426950408889634f * z)); }
__device__ __forceinline__ float gelu_t(float x) { const float z = 1.5957691216057308f * (x + 0.044715f * x * x * x); return x * sigmoidf_(z); }
__device__ __forceinline__ float wave_sum(float v) {
#define WS_DPP(ctrl, rmask) v += __int_as_float(__builtin_amdgcn_update_dpp(0, __float_as_int(v), ctrl, rmask, 0xf, true))
    WS_DPP(0x111, 0xf); WS_DPP(0x112, 0xf); WS_DPP(0x114, 0xf); WS_DPP(0x118, 0xf); WS_DPP(0x142, 0xa); WS_DPP(0x143, 0xc);
#undef WS_DPP
    return __int_as_float(__builtin_amdgcn_readlane(__float_as_int(v), 63));
}
#define LDS_WAIT() asm volatile("s_waitcnt lgkmcnt(0)" ::: "memory")
__device__ __forceinline__ const float* xrow_ptr(const Params& p, int tok) { return tok < NTP ? p.in[0] + (size_t)tok * DM : p.in[1] + (size_t)(tok - NTP) * DM; }

struct EpiBase { bool dry = false; static constexpr bool PERM = false, AFTER_DRAIN = false, HAS_MID = false; static constexpr int MID_T = -1;
    __device__ __forceinline__ void mid(f32x4 (&)[2][2][4][2], const Unit&, int, int, int, int) const {} };

__device__ __forceinline__ void row_ss_add(float* rss, int row, float ss, int fq) {
    ss += __shfl_xor(ss, 16); ss += __shfl_xor(ss, 32);
    if (fq == 0) unsafeAtomicAdd(rss + row, ss);
}

struct EpiInProj : EpiBase {
    static constexpr bool PERM = true;
    bf16_t* P;
    __device__ __forceinline__ void operator()(const f32x4 (&acc)[2][2][4][2], const Unit& u, int wr, int wc, int fr, int fq) const {
        const int row0 = u.pm * 256 + wr * 64 + fr, col0 = u.pn * 256 + wc * 32 + 8 * fq; const bool act = u.pn >= 2;
#pragma unroll
        for (int ai = 0; ai < 2; ++ai)
#pragma unroll
            for (int m = 0; m < 4; ++m) { bf16_t* rowp = P + (size_t)(row0 + ai * 128 + m * 16) * INW + col0;
#pragma unroll
                for (int bj = 0; bj < 2; ++bj) { f32x4 v0 = acc[ai][bj][m][0], v1 = acc[ai][bj][m][1];
                    if (act) { v0[0] = gelu_t(v0[0]); v0[1] = gelu_t(v0[1]); v0[2] = gelu_t(v0[2]); v0[3] = gelu_t(v0[3]); v1[0] = gelu_t(v1[0]); v1[1] = gelu_t(v1[1]); v1[2] = gelu_t(v1[2]); v1[3] = gelu_t(v1[3]); }
                    u32x4 w; w.x = pk2(v0[0], v0[1]); w.y = pk2(v0[2], v0[3]); w.z = pk2(v1[0], v1[1]); w.w = pk2(v1[2], v1[3]); *(u32x4*)(rowp + bj * 128) = w; } }
    }
};
struct EpiGlu : EpiBase {
    static constexpr bool PERM = true;
    const bf16_t* G; bf16_t* MIX; const float* bglu; float* rss;
    __device__ __forceinline__ void operator()(const f32x4 (&acc)[2][2][4][2], const Unit& u, int wr, int wc, int fr, int fq) const {
        const int row0 = u.pm * 256 + wr * 64 + fr, col0 = u.pn * 256 + wc * 32 + 8 * fq;
        f32x4 bv[2][2];
#pragma unroll
        for (int bj = 0; bj < 2; ++bj)
#pragma unroll
            for (int n = 0; n < 2; ++n) bv[bj][n] = *(const f32x4*)(bglu + col0 + bj * 128 + n * 4);
#pragma unroll
        for (int ai = 0; ai < 2; ++ai) { u32x4 gw[4][2];
#pragma unroll
            for (int m = 0; m < 4; ++m)
#pragma unroll
                for (int bj = 0; bj < 2; ++bj) gw[m][bj] = *(const u32x4*)(G + (size_t)(row0 + ai * 128 + m * 16) * 512 + col0 + bj * 128);
#pragma unroll
            for (int m = 0; m < 4; ++m) { const int row = row0 + ai * 128 + m * 16; float ss = 0.f;
#pragma unroll
                for (int bj = 0; bj < 2; ++bj) { const f32x4 z0 = acc[ai][bj][m][0] + bv[bj][0], z1 = acc[ai][bj][m][1] + bv[bj][1]; const u32x4 g4 = gw[m][bj];
                    const float o0 = bflo(g4.x) * sigmoidf_(z0[0]), o1 = bfhi(g4.x) * sigmoidf_(z0[1]), o2 = bflo(g4.y) * sigmoidf_(z0[2]), o3 = bfhi(g4.y) * sigmoidf_(z0[3]);
                    const float o4 = bflo(g4.z) * sigmoidf_(z1[0]), o5 = bfhi(g4.z) * sigmoidf_(z1[1]), o6 = bflo(g4.w) * sigmoidf_(z1[2]), o7 = bfhi(g4.w) * sigmoidf_(z1[3]);
                    ss += (o0 * o0 + o1 * o1 + o2 * o2 + o3 * o3) + (o4 * o4 + o5 * o5 + o6 * o6 + o7 * o7);
                    u32x4 w; w.x = pk2(o0, o1); w.y = pk2(o2, o3); w.z = pk2(o4, o5); w.w = pk2(o6, o7); *(u32x4*)(MIX + (size_t)row * DM + col0 + bj * 128) = w; }
                if (!dry) row_ss_add(rss, row, ss, fq); } }
    }
};
struct EpiOutProj : EpiBase {
    static constexpr bool HAS_MID = true, PERM = true; static constexpr int MID_T = 8;
    const float* xp; const float* xs; bf16_t* X2B; float* rss2; const LAS float* fl; int pm0, pn0;
    __device__ __forceinline__ void mid(f32x4 (&acc)[2][2][4][2], const Unit& u, int wr, int wc, int fr, int fq) const {
        const LAS float* f0 = fl + ((u.pm == pm0 && u.pn == pn0) ? 0 : 256) + wr * 64 + fr;
#pragma unroll
        for (int ai = 0; ai < 2; ++ai)
#pragma unroll
            for (int m = 0; m < 4; ++m) { const float f = f0[ai * 128 + m * 16];
#pragma unroll
                for (int bj = 0; bj < 2; ++bj)
#pragma unroll
                    for (int n = 0; n < 2; ++n) acc[ai][bj][m][n] = acc[ai][bj][m][n] * f; }
    }
    __device__ __forceinline__ void operator()(const f32x4 (&acc)[2][2][4][2], const Unit& u, int wr, int wc, int fr, int fq) const {
        const int row0 = u.pm * 256 + wr * 64 + fr, col0 = u.pn * 256 + wc * 32 + 8 * fq;
        const LAS float* r0 = fl + 512 + ((u.pm == pm0 && u.pn == pn0) ? 0 : 256) + wr * 64 + fr;
        const float* xbase = row0 < NTP ? xp + (size_t)row0 * DM : xs + (size_t)(row0 - NTP) * DM;
#pragma unroll
        for (int ai = 0; ai < 2; ++ai) { f32x4 xv[4][2][2];
#pragma unroll
            for (int m = 0; m < 4; ++m)
#pragma unroll
                for (int bj = 0; bj < 2; ++bj)
#pragma unroll
                    for (int n = 0; n < 2; ++n) xv[m][bj][n] = *(const f32x4*)(xbase + (size_t)(ai * 128 + m * 16) * DM + col0 + bj * 128 + n * 4);
#pragma unroll
            for (int m = 0; m < 4; ++m) { const int row = row0 + ai * 128 + m * 16; float ss = 0.f; const float rc = r0[ai * 128 + m * 16];
#pragma unroll
                for (int bj = 0; bj < 2; ++bj) { const f32x4 v0 = xv[m][bj][0] + acc[ai][bj][m][0] * rc, v1 = xv[m][bj][1] + acc[ai][bj][m][1] * rc;
                    ss += (v0[0] * v0[0] + v0[1] * v0[1] + v0[2] * v0[2] + v0[3] * v0[3]) + (v1[0] * v1[0] + v1[1] * v1[1] + v1[2] * v1[2] + v1[3] * v1[3]);
                    u32x4 w; w.x = pk2(v0[0], v0[1]); w.y = pk2(v0[2], v0[3]); w.z = pk2(v1[0], v1[1]); w.w = pk2(v1[2], v1[3]); *(u32x4*)(X2B + (size_t)row * DM + col0 + bj * 128) = w; }
                if (!dry) row_ss_add(rss2, row, ss, fq); } }
    }
};
struct EpiGateUp : EpiBase {
    static constexpr bool PERM = true;
    bf16_t* ACT; const float* rss2;
    __device__ __forceinline__ void operator()(const f32x4 (&acc)[2][2][4][2], const Unit& u, int wr, int wc, int fr, int fq) const {
        const int row0 = u.pm * 256 + wr * 64 + fr, f0 = u.pn * 128 + wc * 32 + 8 * fq;
        float r2v[2][4];
#pragma unroll
        for (int ai = 0; ai < 2; ++ai)
#pragma unroll
            for (int m = 0; m < 4; ++m) r2v[ai][m] = rss2[row0 + ai * 128 + m * 16];
#pragma unroll
        for (int ai = 0; ai < 2; ++ai)
#pragma unroll
            for (int m = 0; m < 4; ++m) { const int row = row0 + ai * 128 + m * 16; const float r2 = rsqrtf(r2v[ai][m] * (1.f / 1024.f) + EPSV); float o[8];
#pragma unroll
                for (int n = 0; n < 2; ++n) { const f32x4 g = acc[ai][0][m][n] * r2, up = acc[ai][1][m][n] * r2;
#pragma unroll
                    for (int j = 0; j < 4; ++j) o[4 * n + j] = g[j] * sigmoidf_(g[j]) * up[j]; }
                u32x4 w; w.x = pk2(o[0], o[1]); w.y = pk2(o[2], o[3]); w.z = pk2(o[4], o[5]); w.w = pk2(o[6], o[7]); *(u32x4*)(ACT + (size_t)row * DFF + f0) = w; }
    }
};
struct EpiDown : EpiBase {
    static constexpr bool PERM = true;
    const bf16_t* X2B; bf16_t* X3B;
    __device__ __forceinline__ void operator()(const f32x4 (&acc)[2][2][4][2], const Unit& u, int wr, int wc, int fr, int fq) const {
        const int row0 = u.pm * 256 + wr * 64 + fr, col0 = u.pn * 256 + wc * 32 + 8 * fq;
#pragma unroll
        for (int ai = 0; ai < 2; ++ai) { u32x4 xv[4][2];
#pragma unroll
            for (int m = 0; m < 4; ++m)
#pragma unroll
                for (int bj = 0; bj < 2; ++bj) xv[m][bj] = *(const u32x4*)(X2B + (size_t)(row0 + ai * 128 + m * 16) * DM + col0 + bj * 128);
#pragma unroll
            for (int m = 0; m < 4; ++m) { const int row = row0 + ai * 128 + m * 16;
#pragma unroll
                for (int bj = 0; bj < 2; ++bj) { const f32x4 a0 = acc[ai][bj][m][0], a1 = acc[ai][bj][m][1]; const u32x4 x = xv[m][bj];
                    u32x4 w; w.x = pk2(bflo(x.x) + a0[0], bfhi(x.x) + a0[1]); w.y = pk2(bflo(x.y) + a0[2], bfhi(x.y) + a0[3]); w.z = pk2(bflo(x.z) + a1[0], bfhi(x.z) + a1[1]); w.w = pk2(bflo(x.w) + a1[2], bfhi(x.w) + a1[3]);
                    *(u32x4*)(X3B + (size_t)row * DM + col0 + bj * 128) = w; } } }
    }
};
struct EpiDownPart : EpiBase {
    static constexpr bool PERM = true;
    bf16_t* PART;
    __device__ __forceinline__ void operator()(const f32x4 (&acc)[2][2][4][2], const Unit& u, int wr, int wc, int fr, int fq) const {
        const int row0 = (u.pm - 64) * 256 + wr * 64 + fr, col0 = u.pn * 256 + wc * 32 + 8 * fq; bf16_t* base = PART + (size_t)(u.ko >> 8) * 1048576;
#pragma unroll
        for (int ai = 0; ai < 2; ++ai)
#pragma unroll
            for (int m = 0; m < 4; ++m)
#pragma unroll
                for (int bj = 0; bj < 2; ++bj) { const f32x4 a0 = acc[ai][bj][m][0], a1 = acc[ai][bj][m][1];
                    u32x4 w; w.x = pk2(a0[0], a0[1]); w.y = pk2(a0[2], a0[3]); w.z = pk2(a1[0], a1[1]); w.w = pk2(a1[2], a1[3]);
                    *(u32x4*)(base + (size_t)(row0 + ai * 128 + m * 16) * DM + col0 + bj * 128) = w; }
    }
};

__device__ __forceinline__ void p0_transpose_item(const float* W, int K, int N, bf16_t* WT, int mode, int bjoff, const float* ks1, const float* ks2, int ksplit, LAS float* scr, int item, int lane) {
    const int nblk = N / 32, kb = item / nblk, nb = item % nblk, k0 = 64 * kb, n0 = 32 * nb;
#pragma unroll 8
    for (int i = 0; i < 32; ++i) { const int kk = 2 * i + (lane >> 5), k = k0 + kk; float sc = 1.f; if (ks1) sc = k < ksplit ? ks1[k] : ks2[k - ksplit];
        scr[kk * 33 + (lane & 31)] = W[(size_t)k * N + n0 + (lane & 31)] * sc; }
    LDS_WAIT();
    const int c = lane & 7;
#pragma unroll
    for (int j = 0; j < 4; ++j) { const int n = (lane >> 3) + 8 * j; const LAS float* s = scr + (8 * c) * 33 + n; const int nn = n0 + n;
        const int row = mode ? (((nn >> 7) << 8) + bjoff + (nn & 127)) : nn;
        u32x4 o; o.x = pk2(s[0 * 33], s[1 * 33]); o.y = pk2(s[2 * 33], s[3 * 33]); o.z = pk2(s[4 * 33], s[5 * 33]); o.w = pk2(s[6 * 33], s[7 * 33]);
        *(u32x4*)(WT + (size_t)row * K + k0 + 8 * c) = o; }
    LDS_WAIT();
}

__device__ __forceinline__ void phase0(const Params& p, LAS unsigned char* lds) {
    const int tid = threadIdx.x, lane = tid & 63, wave = tid >> 6;
    const int gw = blockIdx.x * 8 + wave, NGW = gridDim.x * 8;
    unsigned char* ws = p.ws;
    {   bf16_t* XH = (bf16_t*)(ws + W_XH); const f32x4* g4 = (const f32x4*)p.in[4] + lane;
        for (int tok = gw; tok < MTOK; tok += 2 * NGW) { const int tok2 = tok + NGW < MTOK ? tok + NGW : tok;
            const f32x4* xr = (const f32x4*)xrow_ptr(p, tok) + lane; const f32x4* xr2 = (const f32x4*)xrow_ptr(p, tok2) + lane; f32x4 v[4], v2[4]; float s = 0.f, s2 = 0.f;
#pragma unroll
            for (int j = 0; j < 4; ++j) { v[j] = xr[64 * j]; v2[j] = xr2[64 * j]; }
#pragma unroll
            for (int j = 0; j < 4; ++j) { s += (v[j][0] * v[j][0] + v[j][1] * v[j][1]) + (v[j][2] * v[j][2] + v[j][3] * v[j][3]); s2 += (v2[j][0] * v2[j][0] + v2[j][1] * v2[j][1]) + (v2[j][2] * v2[j][2] + v2[j][3] * v2[j][3]); }
            const float r = rsqrtf(wave_sum(s) * (1.f / 1024.f) + EPSV), r2 = rsqrtf(wave_sum(s2) * (1.f / 1024.f) + EPSV);
            u32x2* o8 = (u32x2*)(XH + (size_t)tok * DM) + lane; u32x2* o82 = (u32x2*)(XH + (size_t)tok2 * DM) + lane;
#pragma unroll
            for (int j = 0; j < 4; ++j) { const f32x4 g = g4[64 * j]; u32x2 w; w.x = pk2(v[j][0] * r * g[0], v[j][1] * r * g[1]); w.y = pk2(v[j][2] * r * g[2], v[j][3] * r * g[3]); o8[64 * j] = w;
                u32x2 w2; w2.x = pk2(v2[j][0] * r2 * g[0], v2[j][1] * r2 * g[1]); w2.y = pk2(v2[j][2] * r2 * g[2], v2[j][3] * r2 * g[3]); o82[64 * j] = w2; } }
    }
    {   LAS float* scr = (LAS float*)(lds + wave * 8448);
        constexpr int I_IN = 16 * 48, I_GLU = 8 * 16, I_OUT = 16 * 32, NIT = I_IN + I_GLU + I_OUT;
        for (int it = gw; it < NIT; it += NGW) { int r = it;
            if (r < I_IN) { p0_transpose_item(p.in[5], 1024, 1536, (bf16_t*)(ws + W_BTIN), 0, 0, nullptr, nullptr, 0, scr, r, lane); continue; } r -= I_IN;
            if (r < I_GLU) { p0_transpose_item(p.in[14], 512, 512, (bf16_t*)(ws + W_BTGLU), 0, 0, nullptr, nullptr, 0, scr, r, lane); continue; } r -= I_GLU;
            p0_transpose_item(p.in[22], 1024, 1024, (bf16_t*)(ws + W_BTOUT), 0, 0, p.in[20], p.in[21], 512, scr, r, lane); }
    }
    const int gt = blockIdx.x * 512 + tid, NGT = gridDim.x * 512;
    for (int idx = gt; idx < 2048; idx += NGT) { const int g = idx >> 6;
        const float dt = expf(p.in[8][g]), lr = p.in[6][idx], li = p.in[7][idx];
        const float mag = expf(lr * dt), ar = mag * cosf(li * dt), ai = mag * sinf(li * dt), den = lr * lr + li * li;
        const float qr = ((ar - 1.0f) * lr + ai * li) / den, qi = (ai * lr - (ar - 1.0f) * li) / den;
        float* AT = (float*)(ws + W_ATAB); AT[idx * 2] = ar; AT[idx * 2 + 1] = ai;
        bf16_t* BB = (bf16_t*)(ws + W_BBT); const int n = idx & 63;
#pragma unroll
        for (int i = 0; i < 16; i += 2) { const float br0 = p.in[9][idx * 16 + i], bi0 = p.in[10][idx * 16 + i], br1 = p.in[9][idx * 16 + i + 1], bi1 = p.in[10][idx * 16 + i + 1];
            *(unsigned*)(BB + ((size_t)(g * 2 + 0) * 64 + n) * 16 + i) = pk2(qr * br0 - qi * bi0, qr * br1 - qi * bi1);
            *(unsigned*)(BB + ((size_t)(g * 2 + 1) * 64 + n) * 16 + i) = pk2(qr * bi0 + qi * br0, qr * bi1 + qi * br1); } }
    for (int idx = gt; idx < 32768; idx += NGT) { const int g = idx >> 10, o = (idx >> 6) & 15, kp = (idx & 63) * 2;
        const int c5 = kp >> 2, e = kp & 3; const size_t base = ((size_t)(g * 16 + o)) * 64;
        float v0, v1; if (e == 0) { v0 = p.in[11][base + c5]; v1 = p.in[11][base + c5 + 32]; } else { v0 = -p.in[12][base + c5]; v1 = -p.in[12][base + c5 + 32]; }
        *(unsigned*)((bf16_t*)(ws + W_CMT) + ((size_t)(g * 16 + o)) * 128 + kp) = pk2(v0, v1); }
    for (int idx = gt; idx < 131072; idx += NGT) { const int which = idx >> 16, h = (idx >> 13) & 7, t = (idx >> 6) & 127, s = (idx & 63) * 2; const float* wsr = p.in[18] + (size_t)h * 16384;
        float v0, v1;
        if (which == 0) { v0 = s <= t ? wsr[t * 128 + s] : 0.f; v1 = (s + 1) <= t ? wsr[t * 128 + s + 1] : 0.f; }
        else { const bool same = (t >> 3) == (s >> 3); const int tt = t & 7, s0 = s & 7; v0 = (same && s0 <= tt) ? wsr[tt * 128 + s0] : 0.f; v1 = (same && (s0 + 1) <= tt) ? wsr[tt * 128 + s0 + 1] : 0.f; }
        *(unsigned*)((bf16_t*)(ws + (which ? W_WTS : W_WTP)) + (size_t)h * 16384 + t * 128 + s) = pk2(v0, v1); }
    for (int idx = gt; idx < 4 * MTOK; idx += NGT) __hip_atomic_store((unsigned*)(ws + W_RSS) + idx, 0u, __ATOMIC_RELAXED, __HIP_MEMORY_SCOPE_AGENT);
}

__device__ __forceinline__ void p3_transposes(const Params& p, LAS unsigned char* lds, int first_idle) {
    const int tid = threadIdx.x, lane = tid & 63, wave = tid >> 6;
    if ((int)blockIdx.x < first_idle) return;
    const int gw = ((int)blockIdx.x - first_idle) * 8 + wave, NGW = ((int)gridDim.x - first_idle) * 8;
    unsigned char* ws = p.ws; LAS float* scr = (LAS float*)(lds + wave * 8448);
    constexpr int I_G = 16 * 88, I_DN = 44 * 32, NIT = 2 * I_G + I_DN;
    for (int it = gw; it < NIT; it += NGW) { int r = it;
        if (r < I_G) { p0_transpose_item(p.in[24], 1024, 2816, (bf16_t*)(ws + W_BTGU), 1, 0, p.in[23], p.in[23], 1024, scr, r, lane); continue; } r -= I_G;
        if (r < I_G) { p0_transpose_item(p.in[25], 1024, 2816, (bf16_t*)(ws + W_BTGU), 1, 128, p.in[23], p.in[23], 1024, scr, r, lane); continue; } r -= I_G;
        p0_transpose_item(p.in[26], 2816, 1024, (bf16_t*)(ws + W_BTDN), 0, 0, nullptr, nullptr, 0, scr, r, lane); }
}

constexpr int HT_STRIDE = 272, HT_WAVE = 32 * HT_STRIDE, SSEG_OFF = 8 * HT_WAVE;
struct S5Ctx { bf16x8 Bf[4]; bf16x8 Cf[4]; float ar0, ai0, ar1, ai1; float dsk[4]; };

__device__ __forceinline__ bf16x8 s5_load_a(const bf16_t* P, int g, int tokA, int tokB, int lane) {
    const int rho = lane & 31, half = (rho >> 2) & 1, r = 4 * (rho >> 3) + (rho & 3);
    const int tok = (half ? tokB : tokA) + r;
    return *(const bf16x8*)(P + (size_t)tok * INW + g * 16 + 8 * (lane >> 5));
}
__device__ __forceinline__ void s5_bu(const bf16x8 a, const S5Ctx& c, f32x16 (&acc)[4]) {
#pragma unroll
    for (int j = 0; j < 4; ++j) { f32x16 z;
#pragma unroll
        for (int i = 0; i < 16; ++i) z[i] = 0.f;
        acc[j] = __builtin_amdgcn_mfma_f32_32x32x16_bf16(a, c.Bf[j], z, 0, 0, 0); }
}
#define S5_STEP(r) do { const float nr0 = c.ar0 * hr0 - c.ai0 * hi0 + acc[0][r], ni0 = c.ar0 * hi0 + c.ai0 * hr0 + acc[2][r]; \
        const float nr1 = c.ar1 * hr1 - c.ai1 * hi1 + acc[1][r], ni1 = c.ar1 * hi1 + c.ai1 * hr1 + acc[3][r]; hr0 = nr0; hi0 = ni0; hr1 = nr1; hi1 = ni1; } while (0)

__device__ __forceinline__ u32x2 s5_load_x(const bf16_t* P, int g, int tok0, int lane) { return *(const u32x2*)(P + (size_t)(tok0 + (lane & 15)) * INW + g * 16 + 4 * (lane >> 4)); }
__device__ __forceinline__ void s5_y(bf16_t* GB, const S5Ctx& c, int g, int tokA, int tokB, int lane, LAS unsigned char* ht, const u32x2 xwA, const u32x2 xwB, bool nostore = false) {
    const int cc = lane & 15, q = lane >> 4;
#pragma unroll
    for (int t16 = 0; t16 < 2; ++t16) { f32x4 y = {0.f, 0.f, 0.f, 0.f};
#pragma unroll
        for (int ks = 0; ks < 4; ++ks) { const bf16x8 b = *(const LAS bf16x8*)(ht + (16 * t16 + cc) * HT_STRIDE + 64 * ks + 16 * q);
            y = __builtin_amdgcn_mfma_f32_16x16x32_bf16(c.Cf[ks], b, y, 0, 0, 0); }
        const int tok = (t16 ? tokB : tokA) + cc; const u32x2 xw = t16 ? xwB : xwA;
        const float o0 = gelu_t(y[0] + c.dsk[0] * bflo(xw.x)), o1 = gelu_t(y[1] + c.dsk[1] * bfhi(xw.x)), o2 = gelu_t(y[2] + c.dsk[2] * bflo(xw.y)), o3 = gelu_t(y[3] + c.dsk[3] * bfhi(xw.y));
        u32x2 w; w.x = pk2(o0, o1); w.y = pk2(o2, o3); if (!nostore) *(u32x2*)(GB + (size_t)tok * 512 + g * 16 + 4 * q) = w; }
}
__device__ __forceinline__ void s5_load_ctx(const Params& p, S5Ctx& c, int g, int lane) {
    const unsigned char* ws = p.ws; const int c5 = lane & 31, hh = lane >> 5;
    const float* AT = (const float*)(ws + W_ATAB) + (size_t)g * 128; c.ar0 = AT[c5 * 2]; c.ai0 = AT[c5 * 2 + 1]; c.ar1 = AT[(c5 + 32) * 2]; c.ai1 = AT[(c5 + 32) * 2 + 1];
    const bf16_t* BB = (const bf16_t*)(ws + W_BBT);
#pragma unroll
    for (int j = 0; j < 4; ++j) c.Bf[j] = *(const bf16x8*)(BB + ((size_t)(g * 2 + (j >> 1)) * 64 + 32 * (j & 1) + c5) * 16 + 8 * hh);
    const bf16_t* CM = (const bf16_t*)(ws + W_CMT) + ((size_t)(g * 16 + (lane & 15))) * 128;
#pragma unroll
    for (int ks = 0; ks < 4; ++ks) c.Cf[ks] = *(const bf16x8*)(CM + 32 * ks + 8 * (lane >> 4));
#pragma unroll
    for (int j = 0; j < 4; ++j) c.dsk[j] = p.in[13][g * 16 + 4 * (lane >> 4) + j];
}
#define S5_WRITE(r) do { u32x2 w; w.x = pk2(hr0, hr1); w.y = pk2(hi0, hi1); *(LAS u32x2*)(ht + (16 * hh + (r)) * HT_STRIDE + 8 * c5) = w; } while (0)

__device__ __forceinline__ void s5_prompt_item(const Params& p, int item, LAS unsigned char* lds, bool dryA = false, bool dryB = false) {
    const int tid = threadIdx.x, lane = tid & 63, wave = tid >> 6, c5 = lane & 31, hh = lane >> 5;
    const int slot = item >> 3, g = 4 * (item & 7) + (slot & 3), b = slot >> 2, seqbase = b * 2048;
    const bf16_t* P = (const bf16_t*)(p.ws + W_PBUF); bf16_t* GB = (bf16_t*)(p.ws + W_GBUF);
    S5Ctx c; s5_load_ctx(p, c, g, lane);
    LAS unsigned char* ht = lds + wave * HT_WAVE; LAS float* sseg = (LAS float*)(lds + SSEG_OFF);
    float hr0 = 0.f, hi0 = 0.f, hr1 = 0.f, hi1 = 0.f; f32x16 acc[4];
    const int tbase = seqbase + 256 * wave;
    bf16x8 acur = s5_load_a(P, g, tbase, tbase + 128, lane);
    for (int tile = 0; tile < 8; ++tile) { const int tn = tile < 7 ? tile + 1 : 7; const bf16x8 anext = s5_load_a(P, g, tbase + 16 * tn, tbase + 16 * tn + 128, lane);
        s5_bu(acur, c, acc); acur = anext;
#pragma unroll
        for (int r = 0; r < 16; ++r) S5_STEP(r); }
    const int seg = 2 * wave + hh;
    sseg[(seg * 64 + c5) * 2] = hr0; sseg[(seg * 64 + c5) * 2 + 1] = hi0; sseg[(seg * 64 + c5 + 32) * 2] = hr1; sseg[(seg * 64 + c5 + 32) * 2 + 1] = hi1;
    float pr0 = c.ar0, pi0 = c.ai0, pr1 = c.ar1, pi1 = c.ai1;
#pragma unroll
    for (int i = 0; i < 7; ++i) { const float t0 = pr0 * pr0 - pi0 * pi0, u0 = 2.f * pr0 * pi0, t1 = pr1 * pr1 - pi1 * pi1, u1 = 2.f * pr1 * pi1; pr0 = t0; pi0 = u0; pr1 = t1; pi1 = u1; }
    __syncthreads();
    hr0 = hi0 = hr1 = hi1 = 0.f;
    for (int j = 0; j < seg; ++j) { const float s0r = sseg[(j * 64 + c5) * 2], s0i = sseg[(j * 64 + c5) * 2 + 1], s1r = sseg[(j * 64 + c5 + 32) * 2], s1i = sseg[(j * 64 + c5 + 32) * 2 + 1];
        const float nr0 = pr0 * hr0 - pi0 * hi0 + s0r, ni0 = pr0 * hi0 + pi0 * hr0 + s0i, nr1 = pr1 * hr1 - pi1 * hi1 + s1r, ni1 = pr1 * hi1 + pi1 * hr1 + s1i; hr0 = nr0; hi0 = ni0; hr1 = nr1; hi1 = ni1; }
    acur = s5_load_a(P, g, tbase, tbase + 128, lane);
    for (int tile = 0; tile < 8; ++tile) { const int tokA = tbase + 16 * tile, tokB = tokA + 128; const int tn = tile < 7 ? tile + 1 : 7;
        const bf16x8 anext = s5_load_a(P, g, tbase + 16 * tn, tbase + 16 * tn + 128, lane);
        const u32x2 xwA = s5_load_x(P, g, tokA, lane), xwB = s5_load_x(P, g, tokB, lane);
        s5_bu(acur, c, acc); acur = anext;
#pragma unroll
        for (int r = 0; r < 16; ++r) { S5_STEP(r); S5_WRITE(r); }
        LDS_WAIT();
        s5_y(GB, c, g, tokA, tokB, lane, ht, xwA, xwB, dryA);
        LDS_WAIT(); }
    if (seg == 15 && !dryB) { float* ore = p.out + O_PRE + (size_t)(b * 32 + g) * 64; float* oim = p.out + O_PIM + (size_t)(b * 32 + g) * 64;
        ore[c5] = hr0; ore[c5 + 32] = hr1; oim[c5] = hi0; oim[c5 + 32] = hi1; }
    __syncthreads();
}
__device__ __forceinline__ void s5_sample_item(const Params& p, int item, LAS unsigned char* lds) {
    const int tid = threadIdx.x, lane = tid & 63, wave = tid >> 6, c5 = lane & 31, hh = lane >> 5;
    const int g = 4 * (item & 7) + ((item >> 3) & 3), qq = item >> 5;
    const bf16_t* P = (const bf16_t*)(p.ws + W_PBUF); bf16_t* GB = (bf16_t*)(p.ws + W_GBUF);
    S5Ctx c; s5_load_ctx(p, c, g, lane);
    LAS unsigned char* ht = lds + wave * HT_WAVE;
    const int b0 = 32 * qq + 4 * wave, tokA = NTP + 8 * b0, tokB = tokA + 16, bA = b0 + 2 * hh;
    float hr0, hi0, hr1, hi1; f32x16 acc[4];
    const u32x2 xwA = s5_load_x(P, g, tokA, lane), xwB = s5_load_x(P, g, tokB, lane);
    s5_bu(s5_load_a(P, g, tokA, tokB, lane), c, acc);
#pragma unroll
    for (int half = 0; half < 2; ++half) { const size_t so = ((size_t)(bA + half) * 32 + g) * 64;
        hr0 = p.in[2][so + c5]; hr1 = p.in[2][so + c5 + 32]; hi0 = p.in[3][so + c5]; hi1 = p.in[3][so + c5 + 32];
#pragma unroll
        for (int r8 = 0; r8 < 8; ++r8) { S5_STEP(half * 8 + r8); S5_WRITE(half * 8 + r8); }
        p.out[O_SRE + so + c5] = hr0; p.out[O_SRE + so + c5 + 32] = hr1; p.out[O_SIM + so + c5] = hi0; p.out[O_SIM + so + c5 + 32] = hi1; }
    LDS_WAIT();
    s5_y(GB, c, g, tokA, tokB, lane, ht, xwA, xwB);
    LDS_WAIT();
    __syncthreads();
}

__device__ __forceinline__ void cm_item(const Params& p, int item, LAS unsigned char* lds, bool dry) {
    const int tid = threadIdx.x, lane = tid & 63, wave = tid >> 6;
    const bool sample = item >= 128; int tok0; float* vout = nullptr; const bf16_t* WT; int tmask;
    if (!sample) { const int b = item >> 4, cidx = item & 15; tok0 = b * 2048 + 128 * cidx; if (cidx == 15) vout = p.out + O_PV + (size_t)b * 128 * 512; WT = (const bf16_t*)(p.ws + W_WTP); tmask = 127; }
    else { const int j = item - 128; tok0 = NTP + 128 * j; vout = p.out + O_SV + (size_t)j * 128 * 512; WT = (const bf16_t*)(p.ws + W_WTS); tmask = 7; }
    const bf16_t* P = (const bf16_t*)(p.ws + W_PBUF); bf16_t* MIX = (bf16_t*)(p.ws + W_MIX); float* rss_cm = (float*)(p.ws + W_RSS) + MTOK;
    {   float lg[8], lb[8];
#pragma unroll
        for (int j = 0; j < 8; ++j) { lg[j] = p.in[16][8 * lane + j]; lb[j] = p.in[17][8 * lane + j]; }
        u32x4 rawv[16];
#pragma unroll
        for (int i = 0; i < 16; ++i) rawv[i] = *(const u32x4*)(P + (size_t)(tok0 + 16 * wave + i) * INW + 1024 + 8 * lane);
#pragma unroll
        for (int i = 0; i < 8; ++i) { const int s = 16 * wave + 2 * i; float v[2][8];
#pragma unroll
            for (int e = 0; e < 2; ++e) { const u32x4 raw = rawv[2 * i + e];
                v[e][0] = bflo(raw.x); v[e][1] = bfhi(raw.x); v[e][2] = bflo(raw.y); v[e][3] = bfhi(raw.y); v[e][4] = bflo(raw.z); v[e][5] = bfhi(raw.z); v[e][6] = bflo(raw.w); v[e][7] = bfhi(raw.w);
                float sm = 0.f;
#pragma unroll
                for (int j = 0; j < 8; ++j) sm += v[e][j];
                const float mu = wave_sum(sm) * (1.f / 512.f); float s2 = 0.f;
#pragma unroll
                for (int j = 0; j < 8; ++j) { v[e][j] -= mu; s2 += v[e][j] * v[e][j]; }
                const float rs = rsqrtf(wave_sum(s2) * (1.f / 512.f) + EPSV);
#pragma unroll
                for (int j = 0; j < 8; ++j) v[e][j] = v[e][j] * rs * lg[j] + lb[j];
                if (vout) { float* vo = vout + (size_t)(s + e) * 512 + 8 * lane; *(f32x4*)vo = (f32x4){v[e][0], v[e][1], v[e][2], v[e][3]}; *(f32x4*)(vo + 4) = (f32x4){v[e][4], v[e][5], v[e][6], v[e][7]}; } }
            const int chunk = (s >> 3) ^ (lane & 15);
#pragma unroll
            for (int j = 0; j < 8; ++j) *(LAS unsigned*)(lds + (8 * lane + j) * 256 + chunk * 16 + (s & 7) * 2) = pk2(v[0][j], v[1][j]); }
    }
    __syncthreads();
    {   const int h = wave, cc = lane & 15, q = lane >> 4;
        bf16x8 Af[4][4];
#pragma unroll
        for (int dt = 0; dt < 4; ++dt)
#pragma unroll
            for (int ks = 0; ks < 4; ++ks) { const int d = 64 * h + 32 * (dt >> 1) + 8 * (cc >> 2) + 4 * (dt & 1) + (cc & 3);
                Af[dt][ks] = *(const LAS bf16x8*)(lds + d * 256 + (((4 * ks + q) ^ ((d >> 3) & 15)) * 16)); }
        const bf16_t* Wh = WT + (size_t)h * 16384; const float* bs = p.in[19] + h * 128;
        bf16x8 bwN[4]; u32x4 uwN[2]; float biasN;
#define CM_LOAD(tt_) do { const int t_ = 16 * (tt_) + cc; \
            _Pragma("unroll") for (int ks = 0; ks < 4; ++ks) if (ks <= ((tt_) >> 1)) bwN[ks] = *(const bf16x8*)(Wh + t_ * 128 + 32 * ks + 8 * q); \
            _Pragma("unroll") for (int k2 = 0; k2 < 2; ++k2) uwN[k2] = *(const u32x4*)(P + (size_t)(tok0 + t_) * INW + 512 + 64 * h + 32 * k2 + 8 * q); \
            biasN = bs[t_ & tmask]; } while (0)
        CM_LOAD(0);
#pragma unroll
        for (int tt = 0; tt < 8; ++tt) { const int t = 16 * tt + cc; f32x4 acc[4]; bf16x8 bw[4]; u32x4 uw[2];
#pragma unroll
            for (int ks = 0; ks < 4; ++ks) bw[ks] = bwN[ks];
#pragma unroll
            for (int k2 = 0; k2 < 2; ++k2) uw[k2] = uwN[k2];
            const float bias = biasN;
            if (tt < 7) CM_LOAD(tt + 1);
#pragma unroll
            for (int dt = 0; dt < 4; ++dt) acc[dt] = (f32x4){0.f, 0.f, 0.f, 0.f};
#pragma unroll
            for (int ks = 0; ks < 4; ++ks) if (ks <= (tt >> 1)) {
#pragma unroll
                for (int dt = 0; dt < 4; ++dt) acc[dt] = __builtin_amdgcn_mfma_f32_16x16x32_bf16(Af[dt][ks], bw[ks], acc[dt], 0, 0, 0); }
            float ss = 0.f; const size_t tok = (size_t)(tok0 + t);
#pragma unroll
            for (int k2 = 0; k2 < 2; ++k2) { const int d = 64 * h + 32 * k2 + 8 * q; const f32x4 a0 = acc[2 * k2], a1 = acc[2 * k2 + 1]; const u32x4 u4 = uw[k2];
                const float o0 = bflo(u4.x) * (a0[0] + bias), o1 = bfhi(u4.x) * (a0[1] + bias), o2 = bflo(u4.y) * (a0[2] + bias), o3 = bfhi(u4.y) * (a0[3] + bias);
                const float o4 = bflo(u4.z) * (a1[0] + bias), o5 = bfhi(u4.z) * (a1[1] + bias), o6 = bflo(u4.w) * (a1[2] + bias), o7 = bfhi(u4.w) * (a1[3] + bias);
                ss += (o0 * o0 + o1 * o1 + o2 * o2 + o3 * o3) + (o4 * o4 + o5 * o5 + o6 * o6 + o7 * o7);
                u32x4 w; w.x = pk2(o0, o1); w.y = pk2(o2, o3); w.z = pk2(o4, o5); w.w = pk2(o6, o7); *(u32x4*)(MIX + tok * DM + 512 + d) = w; }
            ss += __shfl_xor(ss, 16); ss += __shfl_xor(ss, 32);
            if (q == 0 && !dry) unsafeAtomicAdd(rss_cm + tok0 + t, ss);
            asm volatile("" ::: "memory"); }
#undef CM_LOAD
    }
    __syncthreads();
}

__device__ __forceinline__ void phase2(const Params& p, LAS unsigned char* lds, bool dry = false, int mask = 7) {
    for (int it = blockIdx.x; it < 256 + 128 + 136; it += gridDim.x) {
        if (it < 256) { if (mask & 1) s5_prompt_item(p, it, lds, dry && (PROBE_VAR & 1), dry && (PROBE_VAR & 2)); }
        else if (it < 392) { if (mask & 2) cm_item(p, it - 256, lds, dry); }
        else { if (mask & 4) s5_sample_item(p, it - 392, lds); }
    }
}
__device__ __forceinline__ void phase7(const Params& p, bool dry = false) {
    const int tid = threadIdx.x, lane = tid & 63, wave = tid >> 6, gw = blockIdx.x * 8 + wave, NGW = gridDim.x * 8;
    const f32x4* nf = (const f32x4*)p.in[27] + lane; const bf16_t* X3B = (const bf16_t*)(p.ws + W_X3B); const bf16_t* X2B = (const bf16_t*)(p.ws + W_X2B); const bf16_t* PART = (const bf16_t*)(p.ws + W_PART);
    f32x4 g[4];
#pragma unroll
    for (int j = 0; j < 4; ++j) g[j] = nf[64 * j];
    for (int q = gw; q < NTP + 2 * (MTOK - NTP); q += NGW) { if (q >= NTP && ((q - NTP) & 1)) continue;
        const int tok = q < NTP ? q : NTP + ((q - NTP) >> 1); f32x4 v[4];
        const u32x2* src = (const u32x2*)((tok < NTP ? X3B : X2B) + (size_t)tok * DM) + lane;
#pragma unroll
        for (int j = 0; j < 4; ++j) { const u32x2 w = src[64 * j]; v[j] = (f32x4){bflo(w.x), bfhi(w.x), bflo(w.y), bfhi(w.y)}; }
        if (tok >= NTP) { const u32x2* pp = (const u32x2*)(PART + (size_t)(tok - NTP) * DM) + lane;
#pragma unroll
            for (int ks = 0; ks < 11; ++ks) { u32x2 t[4];
#pragma unroll
                for (int j = 0; j < 4; ++j) t[j] = pp[(size_t)ks * 262144 + 64 * j];
#pragma unroll
                for (int j = 0; j < 4; ++j) v[j] = v[j] + (f32x4){bflo(t[j].x), bfhi(t[j].x), bflo(t[j].y), bfhi(t[j].y)}; } }
        float s2 = 0.f;
#pragma unroll
        for (int j = 0; j < 4; ++j) s2 += (v[j][0] * v[j][0] + v[j][1] * v[j][1]) + (v[j][2] * v[j][2] + v[j][3] * v[j][3]);
        const float r = rsqrtf(wave_sum(s2) * (1.f / 1024.f) + EPSV);
        f32x4* xr = (f32x4*)(p.out + (size_t)tok * DM) + lane;
        if (!dry) {
#pragma unroll
            for (int j = 0; j < 4; ++j) xr[64 * j] = v[j] * r * g[j]; } }
}

#define XB_TMO      128
#define XB_XCNT(j)  (256  + 64 * (j))
#define XB_XSUB(j)  (1280 + 64 * (j))
#define XB_XGEN(j)  (2304 + 64 * (j))
#define XB_TOP      3328
#define XB_TOPGEN   3392
#define XCD_BAR_WORDS 3456
#define XB_SPIN_CAP (1u << 18)

__device__ __forceinline__ unsigned xb_ld(unsigned* p)              { return __hip_atomic_load(p, __ATOMIC_RELAXED, __HIP_MEMORY_SCOPE_AGENT); }
__device__ __forceinline__ unsigned xb_add(unsigned* p, unsigned v) { return __hip_atomic_fetch_add(p, v, __ATOMIC_RELAXED, __HIP_MEMORY_SCOPE_AGENT); }
__device__ __forceinline__ unsigned xb_xcc_id() { return (unsigned)__builtin_amdgcn_s_getreg((3 << 11) | 20) & 0xFu; }
#define XB_SPIN(cond, bar) do { unsigned _sp = 0; while (cond) { __builtin_amdgcn_s_sleep(1); \
    if ((++_sp & 255u) == 0u) { if (xb_ld(&(bar)[XB_TMO])) break; if (_sp > XB_SPIN_CAP) { atomicAdd(&(bar)[XB_TMO], 1u); break; } } } } while (0)

struct XcdBarrier {
    unsigned* bar; unsigned x;
    volatile LAS unsigned* st;
};

__device__ __forceinline__ XcdBarrier xcd_barrier_post(unsigned* bar, volatile LAS unsigned* st) {
    XcdBarrier b; b.bar = bar; b.x = xb_xcc_id(); b.st = st;
    if (threadIdx.x == 0) (void)xb_add(&bar[XB_XCNT(b.x)], 1u);
    return b;
}
__device__ __forceinline__ void xcd_barrier_complete(unsigned* bar, unsigned x, unsigned& nloc, unsigned& nx) {
    const unsigned G = gridDim.x * gridDim.y * gridDim.z;
    unsigned sum, cnt, mine, sp = 0u;
    for (;;) {
        sum = 0u; cnt = 0u; mine = 0u;
#pragma unroll
        for (unsigned j = 0; j < 16; ++j) { const unsigned c = xb_ld(&bar[XB_XCNT(j)]); sum += c; cnt += (c > 0u) ? 1u : 0u; mine = (j == x) ? c : mine; }
        if (sum == G) break;
        __builtin_amdgcn_s_sleep(1);
        if ((++sp & 255u) == 0u) { if (xb_ld(&bar[XB_TMO])) break; if (sp > XB_SPIN_CAP) { atomicAdd(&bar[XB_TMO], 1u); break; } }
    }
    nloc = mine > 0u ? mine : 1u; nx = cnt > 0u ? cnt : 1u;
}

__device__ __forceinline__ void xcd_barrier(const XcdBarrier& b) {
    asm volatile("s_waitcnt vmcnt(0)" ::: "memory");
    __syncthreads();
    if (threadIdx.x == 0) {
        unsigned* bar = b.bar;
        __builtin_amdgcn_s_waitcnt(0);
        unsigned nloc = b.st[0], nx = b.st[1];
        if (nloc == 0u) { xcd_barrier_complete(bar, b.x, nloc, nx); b.st[0] = nloc; b.st[1] = nx; }
        __builtin_amdgcn_s_sleep(64);
        __builtin_amdgcn_fence(__ATOMIC_RELEASE, "agent"); asm volatile("s_waitcnt vmcnt(0)" ::: "memory");
        const unsigned old = xb_add(&bar[XB_XSUB(b.x)], 1u);
        const unsigned gen = old / nloc;
        if (old + 1u == (gen + 1u) * nloc) {
            __builtin_amdgcn_fence(__ATOMIC_RELEASE, "agent");
            asm volatile("s_waitcnt vmcnt(0)" ::: "memory");
            const unsigned og = xb_add(&bar[XB_TOP], 1u);
            const unsigned tg = og / nx;
            if (og + 1u == (tg + 1u) * nx) xb_add(&bar[XB_TOPGEN], 1u);
            else XB_SPIN(xb_ld(&bar[XB_TOPGEN]) == tg, bar);
            __builtin_amdgcn_fence(__ATOMIC_ACQUIRE, "agent");
            xb_add(&bar[XB_XGEN(b.x)], 1u);
            asm volatile("s_waitcnt vmcnt(0)" ::: "memory");
        } else {
            XB_SPIN(xb_ld(&bar[XB_XGEN(b.x)]) == gen, bar);
            __builtin_amdgcn_fence(__ATOMIC_ACQUIRE, "agent");
            asm volatile("s_waitcnt vmcnt(0)" ::: "memory");
        }
    }
    __syncthreads();
}


__global__ __launch_bounds__(512, 2) void mega_fwd(Params p) {
    extern __shared__ __attribute__((aligned(16))) unsigned char shm_raw[];
    LAS unsigned char* lds = (LAS unsigned char*)shm_raw;
    cg::grid_group grid = cg::this_grid();
    unsigned char* ws = p.ws; float* rss = (float*)(ws + W_RSS);
    pg8::StaticOrder S;
    volatile LAS unsigned* xst = (volatile LAS unsigned*)(lds + 131072 + 4096);
    if (threadIdx.x < 4) xst[threadIdx.x] = 0u;
    __syncthreads();
    const XcdBarrier xb = xcd_barrier_post((unsigned*)(ws + W_BAR), xst);
    if (p.ph_lo < 0) grid.sync();
#define PH_RUN(n, ...) if ((PHMASK & (1 << n)) && p.ph_lo <= n && n < p.ph_hi) { if (n > p.ph_lo) xcd_barrier(xb); \
        for (int rep = 0; rep < (PROBE_PH == n ? 1 + PROBE_N : 1); ++rep) { if (rep) xcd_barrier(xb); const bool dry = rep > 0; __VA_ARGS__ } }
    PH_RUN(0, phase0(p, lds); (void)dry;)
    PH_RUN(1, pg8::Gemm g{(const bf16_t*)(ws + W_XH), (const bf16_t*)(ws + W_BTIN), MTOK, INW, 1024, 1024}; S.init(g.M, g.N, gridDim.x, blockIdx.x);
        EpiInProj E; E.dry = dry; E.P = (bf16_t*)(ws + W_PBUF); pg8::gemm_phase<EpiInProj, pg8::StaticOrder, GP_ALIGN, GP_SP2>(lds, g, S, E);)
    PH_RUN(2, phase2(p, lds, dry, dry ? PROBE_P2MASK : 7);)
    PH_RUN(3, { pg8::Gemm g{(const bf16_t*)(ws + W_GBUF), (const bf16_t*)(ws + W_BTGLU), MTOK, 512, 512, 512}; pg8::StaticOrder S3; S3.init(g.M, g.N, gridDim.x, blockIdx.x);
        EpiGlu E; E.dry = dry; E.G = (const bf16_t*)(ws + W_GBUF); E.MIX = (bf16_t*)(ws + W_MIX); E.bglu = p.in[15]; E.rss = rss;
        p3_transposes(p, lds, 136);
        pg8::gemm_phase<EpiGlu, pg8::StaticOrder, GP_ALIGN, GP_SP2>(lds, g, S3, E);
        asm volatile("s_waitcnt vmcnt(0)" ::: "memory");
        __syncthreads();
        if (threadIdx.x == 0) { Unit u; if (S3.next(0, u)) { __builtin_amdgcn_s_sleep(64); __builtin_amdgcn_fence(__ATOMIC_RELEASE, "agent"); asm volatile("s_waitcnt vmcnt(0)" ::: "memory");
            for (int i = 0; S3.next(i, u); ++i) __hip_atomic_fetch_add((unsigned*)(ws + W_BAR) + 4096 + 16 * (1 + u.pm), 1u, __ATOMIC_RELAXED, __HIP_MEMORY_SCOPE_AGENT); } } }
        { pg8::Gemm g{(const bf16_t*)(ws + W_MIX), (const bf16_t*)(ws + W_BTOUT), NTP, 1024, 1024, 1024}; S.init(g.M, g.N, gridDim.x, blockIdx.x);
        EpiOutProj E; E.dry = dry; E.xp = p.in[0]; E.xs = p.in[1]; E.X2B = (bf16_t*)(ws + W_X2B); E.rss2 = rss + 2 * MTOK;
        LAS float* fl = (LAS float*)(lds + 131072); E.fl = fl; E.pm0 = -1; E.pn0 = -1;
        if (threadIdx.x == 0) { bool any = false;
            for (int i = 0; i < 2; ++i) { Unit u0; if (!S.next(i, u0)) break; any = true; const unsigned* c = (const unsigned*)(ws + W_BAR) + 4096 + 16 * (1 + u0.pm);
                for (unsigned sp = 0; sp < (1u << 16); ++sp) { if (__hip_atomic_load(c, __ATOMIC_RELAXED, __HIP_MEMORY_SCOPE_AGENT) >= 2u) break; __builtin_amdgcn_s_sleep(2); } }
            if (any) { __builtin_amdgcn_fence(__ATOMIC_ACQUIRE, "agent"); asm volatile("s_waitcnt vmcnt(0)" ::: "memory"); } }
        __syncthreads();
        for (int i = 0; i < 2; ++i) { Unit u; if (S.next(i, u)) { if (i == 0) { E.pm0 = u.pm; E.pn0 = u.pn; }
            if (threadIdx.x < 256) { const int row = u.pm * 256 + threadIdx.x; const float a = rss[row] * (1.f / 512.f) + EPSV; const float b = rss[MTOK + row] * (1.f / 512.f) + EPSV;
                fl[i * 256 + threadIdx.x] = sqrtf(b / a); fl[512 + i * 256 + threadIdx.x] = rsqrtf(b); } } }
        __syncthreads();
        pg8::gemm_phase<EpiOutProj, pg8::StaticOrder, GP_ALIGN, GP_SP2>(lds, g, S, E); })
    PH_RUN(5, { pg8::Gemm g{(const bf16_t*)(ws + W_MIX), (const bf16_t*)(ws + W_BTOUT), MTOK, 1024, 1024, 1024};
        pg8::SampleOutOrder S4; S4.c = blockIdx.x; S4.base = (int)gridDim.x - 16; S4.cnt = (unsigned*)(ws + W_BAR) + 4096;
        EpiOutProj E; E.dry = dry; E.xp = p.in[0]; E.xs = p.in[1]; E.X2B = (bf16_t*)(ws + W_X2B); E.rss2 = rss + 2 * MTOK;
        LAS float* fl = (LAS float*)(lds + 131072); E.fl = fl; E.pm0 = -1; E.pn0 = -1;
        { Unit u; if (S4.next(0, u)) { E.pm0 = u.pm; E.pn0 = u.pn;
            if (threadIdx.x < 256) { const int row = u.pm * 256 + threadIdx.x; const float a = rss[row] * (1.f / 512.f) + EPSV; const float b = rss[MTOK + row] * (1.f / 512.f) + EPSV;
                fl[threadIdx.x] = sqrtf(b / a); fl[512 + threadIdx.x] = rsqrtf(b); } } }
        __syncthreads();
        pg8::gemm_phase<EpiOutProj, pg8::SampleOutOrder, GP_ALIGN, GP_SP2>(lds, g, S4, E);
        asm volatile("s_waitcnt vmcnt(0)" ::: "memory");
        __syncthreads();
        if (threadIdx.x == 0) { Unit u; if (S4.next(0, u)) { __builtin_amdgcn_s_sleep(64); __builtin_amdgcn_fence(__ATOMIC_RELEASE, "agent"); asm volatile("s_waitcnt vmcnt(0)" ::: "memory");
            __hip_atomic_fetch_add(S4.cnt, 1u, __ATOMIC_RELAXED, __HIP_MEMORY_SCOPE_AGENT); } } }
        { pg8::Gemm g{(const bf16_t*)(ws + W_X2B), (const bf16_t*)(ws + W_BTGU), MTOK, 2 * DFF, 1024, 1024}; pg8::CountedGU S5; S5.init(g.M, g.N, gridDim.x, blockIdx.x); S5.cnt = (const unsigned*)(ws + W_BAR) + 4096;
        EpiGateUp E; E.dry = dry; E.ACT = (bf16_t*)(ws + W_ACT); E.rss2 = rss + 2 * MTOK;
        pg8::gemm_phase<EpiGateUp, pg8::CountedGU, GP_ALIGN, GP_SP2>(lds, g, S5, E); })
    PH_RUN(6, { pg8::Gemm g{(const bf16_t*)(ws + W_ACT), (const bf16_t*)(ws + W_BTDN), NTP, 1024, DFF, DFF}; S.init(g.M, g.N, gridDim.x, blockIdx.x);
        EpiDown E; E.dry = dry; E.X2B = (const bf16_t*)(ws + W_X2B); E.X3B = (bf16_t*)(ws + W_X3B);
        pg8::gemm_phase<EpiDown, pg8::StaticOrder, GP_ALIGN, GP_SP2>(lds, g, S, E); }
        { pg8::Gemm g{(const bf16_t*)(ws + W_ACT), (const bf16_t*)(ws + W_BTDN), MTOK, 1024, 256, DFF}; pg8::SplitKOrder S2; S2.init(gridDim.x, blockIdx.x);
        EpiDownPart E; E.dry = dry; E.PART = (bf16_t*)(ws + W_PART);
        pg8::gemm_phase<EpiDownPart, pg8::SplitKOrder, GP_ALIGN, GP_SP2>(lds, g, S2, E); })
    PH_RUN(7, phase7(p, dry);)
}

extern "C" void kernel_launch(void* const* d_in, const int* in_sizes, int n_in, void* d_out, int out_size, void* d_ws, size_t ws_size, hipStream_t stream) {
    static int grid = 0;
    if (grid == 0) {
        if (n_in != 28 || ws_size < W_END) { fprintf(stderr, "kernel_launch: unexpected n_in %d / ws %zu (need %zu)\n", n_in, ws_size, (size_t)W_END); grid = -1; return; }
        int dev = 0, cus = 0, per_cu = 0;
        if (hipGetDevice(&dev) != hipSuccess || hipDeviceGetAttribute(&cus, hipDeviceAttributeMultiprocessorCount, dev) != hipSuccess) { grid = -1; return; }
        if (hipFuncSetAttribute((const void*)mega_fwd, hipFuncAttributeMaxDynamicSharedMemorySize, LDS_BYTES) != hipSuccess) { fprintf(stderr, "kernel_launch: hipFuncSetAttribute failed\n"); grid = -1; return; }
        if (hipOccupancyMaxActiveBlocksPerMultiprocessor(&per_cu, (const void*)mega_fwd, 512, LDS_BYTES) != hipSuccess || per_cu < 1) { fprintf(stderr, "kernel_launch: occupancy query says %d\n", per_cu); per_cu = 1; }
        (void)hipGetLastError();
        grid = cus * 1;
    }
    if (grid < 0) return;
    if (hipMemsetAsync((unsigned char*)d_ws + W_BAR, 0, 32768, stream) != hipSuccess) { fprintf(stderr, "kernel_launch: memset failed\n"); return; }
    Params p{};
    for (int i = 0; i < 28; ++i) p.in[i] = (const float*)d_in[i];
    p.out = (float*)d_out; p.ws = (unsigned char*)d_ws;
#if MK_MULTI_LAUNCH
    for (int ph = 0; ph < 8; ++ph) { p.ph_lo = ph; p.ph_hi = ph + 1; hipLaunchKernelGGL(mega_fwd, dim3(grid), dim3(512), LDS_BYTES, stream, p); }
#else
    p.ph_lo = 0; p.ph_hi = 8;
    void* args[] = {&p};
    hipError_t e = hipLaunchCooperativeKernel((const void*)mega_fwd, dim3(grid), dim3(512), args, LDS_BYTES, stream);
    if (e != hipSuccess) fprintf(stderr, "kernel_launch: cooperative launch failed: %s (grid %d)\n", hipGetErrorString(e), grid);
#endif
}
```

```cpp
#include <hip/hip_runtime.h>
#include <hip/hip_cooperative_groups.h>
#include <cstdio>
#include <cstdint>
namespace cg = cooperative_groups;
#ifndef PHMASK
#define PHMASK 255
#endif
#ifndef PROBE_PH
#define PROBE_PH -1
#endif
#ifndef PROBE_P2MASK
#define PROBE_P2MASK 7
#endif
#ifndef PROBE_VAR
#define PROBE_VAR 0
#endif
#ifndef PROBE_N
#define PROBE_N 2
#endif
#ifndef GP_ALIGN
#define GP_ALIGN true
#endif
#ifndef GP_SP2
#define GP_SP2 true
#endif
#ifndef MK_MULTI_LAUNCH
#define MK_MULTI_LAUNCH 0
#endif
namespace pg8 {
#define PG8_LAS __attribute__((address_space(3)))
typedef unsigned short bf16_t;
typedef short bf16x8 __attribute__((ext_vector_type(8)));
typedef float f32x4 __attribute__((ext_vector_type(4)));
typedef unsigned u32x4 __attribute__((ext_vector_type(4)));
constexpr int BM = 256, BK = 64, HALF = 128, HTB = HALF * BK * 2  , STAGE_BYTES = 8 * HTB, NXCD = 8, WGM = 8;

__host__ __device__ __forceinline__ int lds_byte(int r, int c) { const int st = (r >> 4) * 2 + (c >> 5), rr = r & 15, cc = c & 31, ob = rr * 64 + cc * 2; return st * 1024 + (ob ^ (((ob >> 9) & 1) << 5)); }
__host__ __device__ __forceinline__ void stage_rc(int b, int& R, int& C) { const int st = b / 1024, sb = b % 1024, swz = sb ^ (((sb >> 9) & 1) << 5); R = (st >> 1) * 16 + swz / 64; C = (st & 1) * 32 + (swz % 64) / 2; }
__host__ __device__ __forceinline__ int perm32(int rho) { const int n = rho >> 4, i = rho & 15; return 8 * (i >> 2) + 4 * n + (i & 3); }

struct Unit { int pm, pn, ko; };
struct Gemm { const bf16_t* A; const bf16_t* Bt; int M, N, K, ld; };

struct StaticOrder {
    int nM, nN, nwg, G, c;
    __host__ __device__ void init(int M, int N, int G_, int c_) { nM = M / BM; nN = N / BM; nwg = nM * nN; G = G_; c = c_; }
    __host__ __device__ bool next(int i, Unit& u) const {
        const long L = (long)i * G + c; if (L >= nwg) return false;
        int wgid = (int)L; { const int q = nwg / NXCD, r = nwg % NXCD, xcd = wgid % NXCD, off = wgid / NXCD; wgid = (xcd < r ? xcd * (q + 1) : r * (q + 1) + (xcd - r) * q) + off; }
        const int nig = WGM * nN, gid = wgid / nig, fm = gid * WGM, gsz = (nM - fm) < WGM ? (nM - fm) : WGM;
        u.pm = fm + ((wgid % nig) % gsz); u.pn = (wgid % nig) / gsz; u.ko = 0; return true;
    }
    __device__ __forceinline__ void a_ready(const Unit&) const {}
    __device__ __forceinline__ void done(const Unit&) const {}
};
struct SplitKOrder {
    int G, c;
    __host__ __device__ void init(int G_, int c_) { G = G_; c = c_; }
    __host__ __device__ bool next(int i, Unit& u) const { const long L = (long)i * G + c; if (L >= 176) return false; const int ks = (int)L % 11, rem = (int)L / 11; u.pm = 64 + (rem >> 2); u.pn = rem & 3; u.ko = ks * 256; return true; }
    __device__ __forceinline__ void a_ready(const Unit&) const {}
    __device__ __forceinline__ void done(const Unit&) const {}
};
struct GluOrder : StaticOrder {
    unsigned* cnt;
    __device__ __forceinline__ void done(const Unit& u) const {
        asm volatile("s_waitcnt vmcnt(0)" ::: "memory");
        __builtin_amdgcn_fence(__ATOMIC_RELEASE, "agent");
        asm volatile("s_waitcnt vmcnt(0)" ::: "memory");
        if ((threadIdx.x & 63) == 0) __hip_atomic_fetch_add(cnt + 16 * (1 + u.pm), 1u, __ATOMIC_RELAXED, __HIP_MEMORY_SCOPE_AGENT);
    }
};
struct SampleOutOrder {
    int c, base; unsigned* cnt;
    __host__ __device__ bool next(int i, Unit& u) const { if (i != 0 || c < base) return false; const int k = c - base; u.pm = 64 + (k >> 2); u.pn = k & 3; u.ko = 0; return true; }
    __device__ __forceinline__ void a_ready(const Unit&) const {}
    __device__ __forceinline__ void done(const Unit&) const {}
};
struct CountedGU : StaticOrder {
    const unsigned* cnt;
    __device__ __forceinline__ void a_ready(const Unit& u) const {
        if (u.pm >= 64) {
            if (threadIdx.x < 64) {
                for (unsigned sp = 0; sp < (1u << 16); ++sp) { if ((unsigned)__builtin_amdgcn_readfirstlane((int)__hip_atomic_load(cnt, __ATOMIC_RELAXED, __HIP_MEMORY_SCOPE_AGENT)) >= 16u) break; __builtin_amdgcn_s_sleep(2); }
                __builtin_amdgcn_fence(__ATOMIC_ACQUIRE, "agent");
                asm volatile("s_waitcnt vmcnt(0)" ::: "memory");
            }
            asm volatile("" ::: "memory"); __builtin_amdgcn_s_barrier(); asm volatile("" ::: "memory");
        }
    }
};
template <class Epi, class Sched, bool ALIGN_EPI = false, bool SP2 = false>
__device__ __forceinline__ void gemm_phase(PG8_LAS unsigned char* lds, const Gemm g, const Sched& S, const Epi& E) {
    const int tid = threadIdx.x, wid = __builtin_amdgcn_readfirstlane(tid >> 6), lane = tid & 63, wr = wid >> 2, wc = wid & 3, fr = lane & 15, fq = lane >> 4;
    const int K = g.K, nt = K / BK, LD = g.ld;
    unsigned voffA[2], voffB[2];
#pragma unroll
    for (int i = 0; i < 2; ++i) { int R, C; stage_rc(tid * 16 + i * 8192, R, C); const int Rb = Epi::PERM ? ((R & ~31) + perm32(R & 31)) : R;
        voffA[i] = (unsigned)(R * LD + C) * 2u; voffB[i] = (unsigned)(Rb * LD + C) * 2u; }
    const size_t kstep = (size_t)(BK * 2);
    const size_t hstep = (size_t)HALF * LD * 2;
    const size_t tstep = 2 * hstep;
    const unsigned ldsw = (unsigned)wid * 1024u;
    const int aoff = lds_byte(wr * 64 + fr, fq * 8), boff = lds_byte(wc * 32 + fr, fq * 8);
#define PG8_SA(b, h) (((b) * 2 + (h)) * HTB)
#define PG8_SB(b, h) ((4 + (b) * 2 + (h)) * HTB)
#define PG8_STAGE(bufoff, gbase, voff) do { _Pragma("unroll") for (int _i = 0; _i < 2; ++_i) \
        __builtin_amdgcn_global_load_lds((const unsigned*)((const char*)(gbase) + (voff)[_i]), (PG8_LAS unsigned*)(lds + (bufoff) + ldsw + _i * 8192), 16, 0, 0); } while (0)
#define PG8_LDA(dst, b, h) do { _Pragma("unroll") for (int m = 0; m < 4; ++m) _Pragma("unroll") for (int k = 0; k < 2; ++k) dst[m][k] = *(const PG8_LAS bf16x8*)(lds + PG8_SA(b, h) + aoff + m * 2048 + k * 1024); } while (0)
#define PG8_LDB(dst, b, h) do { _Pragma("unroll") for (int n = 0; n < 2; ++n) _Pragma("unroll") for (int k = 0; k < 2; ++k) dst[n][k] = *(const PG8_LAS bf16x8*)(lds + PG8_SB(b, h) + boff + n * 2048 + k * 1024); } while (0)
#define PG8_MMA(ai, bj, At, Bt) do { __builtin_amdgcn_s_setprio(1); _Pragma("unroll") for (int m = 0; m < 4; ++m) _Pragma("unroll") for (int n = 0; n < 2; ++n) _Pragma("unroll") for (int k = 0; k < 2; ++k) \
        acc[ai][bj][m][n] = __builtin_amdgcn_mfma_f32_16x16x32_bf16(Bt[n][k], At[m][k], acc[ai][bj][m][n], 0, 0, 0); __builtin_amdgcn_s_setprio(0); } while (0)
#define PG8_WAIT_V(n) asm volatile("s_waitcnt vmcnt(" #n ")" ::: "memory")
#define PG8_WAIT_L(n) asm volatile("s_waitcnt lgkmcnt(" #n ")" ::: "memory")
#define PG8_BAR __builtin_amdgcn_s_barrier()
#define PG8_SCHED __builtin_amdgcn_sched_barrier(0)
    Unit cur, nxt; int ui = 0;
    if (!S.next(0, cur)) return;
    f32x4 acc[2][2][4][2];
#pragma unroll
    for (int a = 0; a < 2; ++a)
#pragma unroll
        for (int b = 0; b < 2; ++b)
#pragma unroll
            for (int m = 0; m < 4; ++m)
#pragma unroll
                for (int n = 0; n < 2; ++n) acc[a][b][m][n] = (f32x4){0.f, 0.f, 0.f, 0.f};
    bf16x8 At[4][2], B0[2][2], B1[2][2];
    const char* cA = (const char*)g.A + (size_t)cur.pm * tstep + (size_t)cur.ko * 2; const char* cB = (const char*)g.Bt + (size_t)cur.pn * tstep + (size_t)cur.ko * 2;
    S.a_ready(cur);
    if constexpr (SP2) {
        PG8_STAGE(PG8_SB(0, 0), cB, voffB); PG8_STAGE(PG8_SB(0, 1), cB + hstep, voffB); PG8_STAGE(PG8_SA(0, 0), cA, voffA); PG8_STAGE(PG8_SA(0, 1), cA + hstep, voffA);
        if (wr == 1) PG8_BAR;
        PG8_WAIT_V(2); PG8_BAR;
        PG8_STAGE(PG8_SB(1, 0), cB + kstep, voffB); PG8_STAGE(PG8_SA(1, 0), cA + kstep, voffA); PG8_STAGE(PG8_SB(1, 1), cB + hstep + kstep, voffB);
        PG8_WAIT_V(6); PG8_BAR;
    } else {
        PG8_STAGE(PG8_SB(0, 0), cB, voffB); PG8_STAGE(PG8_SA(0, 0), cA, voffA); PG8_STAGE(PG8_SB(0, 1), cB + hstep, voffB); PG8_STAGE(PG8_SA(0, 1), cA + hstep, voffA);
        if (wr == 1) PG8_BAR;
        PG8_WAIT_V(4); PG8_BAR;
        PG8_STAGE(PG8_SB(1, 0), cB + kstep, voffB); PG8_STAGE(PG8_SA(1, 0), cA + kstep, voffA); PG8_STAGE(PG8_SB(1, 1), cB + hstep + kstep, voffB);
        PG8_WAIT_V(6); PG8_BAR;
    }
    for (;;) {
        const bool has_next = S.next(ui + 1, nxt);
        const char* nA = has_next ? (const char*)g.A + (size_t)nxt.pm * tstep + (size_t)nxt.ko * 2 : cA; const char* nB = has_next ? (const char*)g.Bt + (size_t)nxt.pn * tstep + (size_t)nxt.ko * 2 : cB;
        for (int t = 0; t < nt; t += 2) {
            const bool last = (t == nt - 2);
            const char* a1 = cA + (size_t)(t + 1) * kstep;
            const char* a2 = last ? nA : cA + (size_t)(t + 2) * kstep; const char* b2 = last ? nB : cB + (size_t)(t + 2) * kstep;
            const char* a3 = a2 + kstep; const char* b3 = b2 + kstep;
            if (last && has_next) S.a_ready(nxt);
            if constexpr (Epi::HAS_MID) { if (t == Epi::MID_T) E.mid(acc, cur, wr, wc, fr, fq); }
            if constexpr (SP2) {
            PG8_LDB(B0, 0, 0); PG8_LDB(B1, 0, 1); PG8_SCHED; PG8_LDA(At, 0, 0); PG8_STAGE(PG8_SA(1, 1), a1 + hstep, voffA);
            PG8_WAIT_V(8); PG8_WAIT_L(0); PG8_BAR; PG8_MMA(0, 0, At, B0); PG8_MMA(0, 1, At, B1); PG8_BAR; PG8_SCHED;
            PG8_LDA(At, 0, 1); PG8_STAGE(PG8_SB(0, 0), b2, voffB); PG8_STAGE(PG8_SB(0, 1), b2 + hstep, voffB); PG8_STAGE(PG8_SA(0, 0), a2, voffA);
            PG8_WAIT_V(8); PG8_WAIT_L(0); PG8_BAR; PG8_MMA(1, 0, At, B0); PG8_MMA(1, 1, At, B1); PG8_BAR; PG8_SCHED;
            PG8_LDB(B0, 1, 0); PG8_LDB(B1, 1, 1); PG8_SCHED; PG8_LDA(At, 1, 0); PG8_STAGE(PG8_SA(0, 1), a2 + hstep, voffA);
            PG8_WAIT_V(8); PG8_WAIT_L(0); PG8_BAR; PG8_MMA(0, 0, At, B0); PG8_MMA(0, 1, At, B1); PG8_BAR; PG8_SCHED;
            PG8_LDA(At, 1, 1); PG8_STAGE(PG8_SB(1, 0), b3, voffB); PG8_STAGE(PG8_SB(1, 1), b3 + hstep, voffB); PG8_STAGE(PG8_SA(1, 0), a3, voffA);
            PG8_WAIT_V(8); PG8_WAIT_L(0); PG8_BAR; PG8_MMA(1, 0, At, B0); PG8_MMA(1, 1, At, B1); PG8_BAR; PG8_SCHED;
            } else {
            PG8_LDB(B0, 0, 0); PG8_SCHED; PG8_LDA(At, 0, 0); PG8_STAGE(PG8_SA(1, 1), a1 + hstep, voffA);
            PG8_WAIT_L(8); PG8_BAR; PG8_WAIT_L(0); PG8_MMA(0, 0, At, B0); PG8_BAR; PG8_SCHED;
            PG8_LDB(B1, 0, 1); PG8_STAGE(PG8_SB(0, 0), b2, voffB);
            PG8_BAR; PG8_WAIT_L(0); PG8_MMA(0, 1, At, B1); PG8_BAR;
            PG8_LDA(At, 0, 1); PG8_STAGE(PG8_SA(0, 0), a2, voffA);
            PG8_BAR; PG8_WAIT_L(0); PG8_MMA(1, 0, At, B0); PG8_BAR; PG8_SCHED;
            PG8_STAGE(PG8_SB(0, 1), b2 + hstep, voffB);
            PG8_WAIT_V(6); PG8_BAR; PG8_MMA(1, 1, At, B1); PG8_BAR;
            PG8_LDB(B0, 1, 0); PG8_SCHED; PG8_LDA(At, 1, 0); PG8_STAGE(PG8_SA(0, 1), a2 + hstep, voffA);
            PG8_WAIT_L(8); PG8_BAR; PG8_WAIT_L(0); PG8_MMA(0, 0, At, B0); PG8_BAR; PG8_SCHED;
            PG8_LDB(B1, 1, 1); PG8_STAGE(PG8_SB(1, 0), b3, voffB);
            PG8_BAR; PG8_WAIT_L(0); PG8_MMA(0, 1, At, B1); PG8_BAR;
            PG8_LDA(At, 1, 1); PG8_STAGE(PG8_SA(1, 0), a3, voffA);
            PG8_BAR; PG8_WAIT_L(0); PG8_MMA(1, 0, At, B0); PG8_BAR; PG8_SCHED;
            PG8_STAGE(PG8_SB(1, 1), b3 + hstep, voffB);
            PG8_WAIT_V(6); PG8_BAR; PG8_MMA(1, 1, At, B1); PG8_BAR;
            }
        }
        if constexpr (ALIGN_EPI) { if (wr == 0) PG8_BAR; }
        if constexpr (!Epi::AFTER_DRAIN) { E(acc, cur, wr, wc, fr, fq); S.done(cur); }
        if (!has_next) break;
#pragma unroll
        for (int a = 0; a < 2; ++a)
#pragma unroll
            for (int b = 0; b < 2; ++b)
#pragma unroll
                for (int m = 0; m < 4; ++m)
#pragma unroll
                    for (int n = 0; n < 2; ++n) acc[a][b][m][n] = (f32x4){0.f, 0.f, 0.f, 0.f};
        cur = nxt; cA = nA; cB = nB; ++ui;
        if constexpr (ALIGN_EPI) { if (wr == 1) PG8_BAR; }
    }
    PG8_WAIT_V(0);
    if constexpr (!ALIGN_EPI) { if (wr == 0) PG8_BAR; }
    PG8_BAR;
    if constexpr (Epi::AFTER_DRAIN) { E.fused(acc, cur, wr, wc, fr, fq, lds, wid, lane); S.done(cur); }
#undef PG8_SA
#undef PG8_SB
#undef PG8_STAGE
#undef PG8_LDA
#undef PG8_LDB
#undef PG8_MMA
#undef PG8_WAIT_V
#undef PG8_WAIT_L
#undef PG8_BAR
#undef PG8_SCHED
}
}

using pg8::bf16_t; using pg8::bf16x8; using pg8::f32x4; using pg8::Unit;
#define LAS __attribute__((address_space(3)))
typedef unsigned u32x2 __attribute__((ext_vector_type(2)));
typedef unsigned u32x4 __attribute__((ext_vector_type(4)));
typedef float f32x16 __attribute__((ext_vector_type(16)));

constexpr int DM = 1024, NTP = 16384, MTOK = 17408, INW = 1536, DFF = 2816;
constexpr float EPSV = 1e-6f;
constexpr size_t O_Y = 0, O_PRE = 17825792, O_PIM = 17842176, O_PV = 17858560, O_SRE = 18382848, O_SIM = 18644992, O_SV = 18907136;
constexpr size_t W_ACT = 0, W_XH = 0, W_GBUF = 0, W_MIX = 35651584, W_PBUF = 71303168, W_X2B = 98041856;
constexpr size_t W_BTIN = 133693440, W_BTGLU = W_BTIN + 3145728, W_BTOUT = W_BTGLU + 524288, W_BTGU = W_BTOUT + 2097152, W_BTDN = W_BTGU + 11534336;
constexpr size_t W_ATAB = W_BTDN + 5767168, W_BBT = W_ATAB + 16384, W_CMT = W_BBT + 131072, W_WTP = W_CMT + 131072, W_WTS = W_WTP + 262144, W_RSS = W_WTS + 262144;
constexpr size_t W_BAR = W_RSS + 4 * 17408 * 4;
constexpr size_t W_X3B = W_BAR + 32768;
constexpr size_t W_PART = W_X3B + 33554432;
constexpr size_t W_END = W_PART + 11 * 4194304;
constexpr int LDS_BYTES = 131072 + 4096 + 256;

struct Params { const float* in[28]; float* out; unsigned char* ws; int ph_lo, ph_hi; };

__device__ __forceinline__ unsigned pk2(float lo, float hi) { unsigned r; asm volatile("v_cvt_pk_bf16_f32 %0, %1, %2" : "=v"(r) : "v"(lo), "v"(hi)); return r; }
__device__ __forceinline__ float bflo(unsigned w) { return __uint_as_float(w << 16); }
__device__ __forceinline__ float bfhi(unsigned w) { return __uint_as_float(w & 0xffff0000u); }
__device__ __forceinline__ float sigmoidf_(float z) { return __builtin_amdgcn_rcpf(1.0f + __builtin_amdgcn_exp2f(-1.4426950408889634f * z)); }
__device__ __forceinline__ float gelu_t(float x) { const float z = 1.5957691216057308f * (x + 0.044715f * x * x * x); return x * sigmoidf_(z); }
__device__ __forceinline__ float wave_sum(float v) {
#define WS_DPP(ctrl, rmask) v += __int_as_float(__builtin_amdgcn_update_dpp(0, __float_as_int(v), ctrl, rmask, 0xf, true))
    WS_DPP(0x111, 0xf); WS_DPP(0x112, 0xf); WS_DPP(0x114, 0xf); WS_DPP(0x118, 0xf); WS_DPP(0x142, 0xa); WS_DPP(0x143, 0xc);
#undef WS_DPP
    return __int_as_float(__builtin_amdgcn_readlane(__float_as_int(v), 63));
}
#define LDS_WAIT() asm volatile("s_waitcnt lgkmcnt(0)" ::: "memory")
__device__ __forceinline__ const float* xrow_ptr(const Params& p, int tok) { return tok < NTP ? p.in[0] + (size_t)tok * DM : p.in[1] + (size_t)(tok - NTP) * DM; }

struct EpiBase { bool dry = false; static constexpr bool PERM = false, AFTER_DRAIN = false, HAS_MID = false; static constexpr int MID_T = -1;
    __device__ __forceinline__ void mid(f32x4 (&)[2][2][4][2], const Unit&, int, int, int, int) const {} };

__device__ __forceinline__ void row_ss_add(float* rss, int row, float ss, int fq) {
    ss += __shfl_xor(ss, 16); ss += __shfl_xor(ss, 32);
    if (fq == 0) unsafeAtomicAdd(rss + row, ss);
}

struct EpiInProj : EpiBase {
    static constexpr bool PERM = true;
    bf16_t* P;
    __device__ __forceinline__ void operator()(const f32x4 (&acc)[2][2][4][2], const Unit& u, int wr, int wc, int fr, int fq) const {
        const int row0 = u.pm * 256 + wr * 64 + fr, col0 = u.pn * 256 + wc * 32 + 8 * fq; const bool act = u.pn >= 2;
#pragma unroll
        for (int ai = 0; ai < 2; ++ai)
#pragma unroll
            for (int m = 0; m < 4; ++m) { bf16_t* rowp = P + (size_t)(row0 + ai * 128 + m * 16) * INW + col0;
#pragma unroll
                for (int bj = 0; bj < 2; ++bj) { f32x4 v0 = acc[ai][bj][m][0], v1 = acc[ai][bj][m][1];
                    if (act) { v0[0] = gelu_t(v0[0]); v0[1] = gelu_t(v0[1]); v0[2] = gelu_t(v0[2]); v0[3] = gelu_t(v0[3]); v1[0] = gelu_t(v1[0]); v1[1] = gelu_t(v1[1]); v1[2] = gelu_t(v1[2]); v1[3] = gelu_t(v1[3]); }
                    u32x4 w; w.x = pk2(v0[0], v0[1]); w.y = pk2(v0[2], v0[3]); w.z = pk2(v1[0], v1[1]); w.w = pk2(v1[2], v1[3]); *(u32x4*)(rowp + bj * 128) = w; } }
    }
};
struct EpiGlu : EpiBase {
    static constexpr bool PERM = true;
    const bf16_t* G; bf16_t* MIX; const float* bglu; float* rss;
    __device__ __forceinline__ void operator()(const f32x4 (&acc)[2][2][4][2], const Unit& u, int wr, int wc, int fr, int fq) const {
        const int row0 = u.pm * 256 + wr * 64 + fr, col0 = u.pn * 256 + wc * 32 + 8 * fq;
        f32x4 bv[2][2];
#pragma unroll
        for (int bj = 0; bj < 2; ++bj)
#pragma unroll
            for (int n = 0; n < 2; ++n) bv[bj][n] = *(const f32x4*)(bglu + col0 + bj * 128 + n * 4);
#pragma unroll
        for (int ai = 0; ai < 2; ++ai) { u32x4 gw[4][2];
#pragma unroll
            for (int m = 0; m < 4; ++m)
#pragma unroll
                for (int bj = 0; bj < 2; ++bj) gw[m][bj] = *(const u32x4*)(G + (size_t)(row0 + ai * 128 + m * 16) * 512 + col0 + bj * 128);
#pragma unroll
            for (int m = 0; m < 4; ++m) { const int row = row0 + ai * 128 + m * 16; float ss = 0.f;
#pragma unroll
                for (int bj = 0; bj < 2; ++bj) { const f32x4 z0 = acc[ai][bj][m][0] + bv[bj][0], z1 = acc[ai][bj][m][1] + bv[bj][1]; const u32x4 g4 = gw[m][bj];
                    const float o0 = bflo(g4.x) * sigmoidf_(z0[0]), o1 = bfhi(g4.x) * sigmoidf_(z0[1]), o2 = bflo(g4.y) * sigmoidf_(z0[2]), o3 = bfhi(g4.y) * sigmoidf_(z0[3]);
                    const float o4 = bflo(g4.z) * sigmoidf_(z1[0]), o5 = bfhi(g4.z) * sigmoidf_(z1[1]), o6 = bflo(g4.w) * sigmoidf_(z1[2]), o7 = bfhi(g4.w) * sigmoidf_(z1[3]);
                    ss += (o0 * o0 + o1 * o1 + o2 * o2 + o3 * o3) + (o4 * o4 + o5 * o5 + o6 * o6 + o7 * o7);
                    u32x4 w; w.x = pk2(o0, o1); w.y = pk2(o2, o3); w.z = pk2(o4, o5); w.w = pk2(o6, o7); *(u32x4*)(MIX + (size_t)row * DM + col0 + bj * 128) = w; }
                if (!dry) row_ss_add(rss, row, ss, fq); } }
    }
};
struct EpiOutProj : EpiBase {
    static constexpr bool HAS_MID = true, PERM = true; static constexpr int MID_T = 8;
    const float* xp; const float* xs; bf16_t* X2B; float* rss2; const LAS float* fl; int pm0, pn0;
    __device__ __forceinline__ void mid(f32x4 (&acc)[2][2][4][2], const Unit& u, int wr, int wc, int fr, int fq) const {
        const LAS float* f0 = fl + ((u.pm == pm0 && u.pn == pn0) ? 0 : 256) + wr * 64 + fr;
#pragma unroll
        for (int ai = 0; ai < 2; ++ai)
#pragma unroll
            for (int m = 0; m < 4; ++m) { const float f = f0[ai * 128 + m * 16];
#pragma unroll
                for (int bj = 0; bj < 2; ++bj)
#pragma unroll
                    for (int n = 0; n < 2; ++n) acc[ai][bj][m][n] = acc[ai][bj][m][n] * f; }
    }
    __device__ __forceinline__ void operator()(const f32x4 (&acc)[2][2][4][2], const Unit& u, int wr, int wc, int fr, int fq) const {
        const int row0 = u.pm * 256 + wr * 64 + fr, col0 = u.pn * 256 + wc * 32 + 8 * fq;
        const LAS float* r0 = fl + 512 + ((u.pm == pm0 && u.pn == pn0) ? 0 : 256) + wr * 64 + fr;
        const float* xbase = row0 < NTP ? xp + (size_t)row0 * DM : xs + (size_t)(row0 - NTP) * DM;
#pragma unroll
        for (int ai = 0; ai < 2; ++ai) { f32x4 xv[4][2][2];
#pragma unroll
            for (int m = 0; m < 4; ++m)
#pragma unroll
                for (int bj = 0; bj < 2; ++bj)
#pragma unroll
                    for (int n = 0; n < 2; ++n) xv[m][bj][n] = *(const f32x4*)(xbase + (size_t)(ai * 128 + m * 16) * DM + col0 + bj * 128 + n * 4);
#pragma unroll
            for (int m = 0; m < 4; ++m) { const int row = row0 + ai * 128 + m * 16; float ss = 0.f; const float rc = r0[ai * 128 + m * 16];
#pragma unroll
                for (int bj = 0; bj < 2; ++bj) { const f32x4 v0 = xv[m][bj][0] + acc[ai][bj][m][0] * rc, v1 = xv[m][bj][1] + acc[ai][bj][m][1] * rc;
                    ss += (v0[0] * v0[0] + v0[1] * v0[1] + v0[2] * v0[2] + v0[3] * v0[3]) + (v1[0] * v1[0] + v1[1] * v1[1] + v1[2] * v1[2] + v1[3] * v1[3]);
                    u32x4 w; w.x = pk2(v0[0], v0[1]); w.y = pk2(v0[2], v0[3]); w.z = pk2(v1[0], v1[1]); w.w = pk2(v1[2], v1[3]); *(u32x4*)(X2B + (size_t)row * DM + col0 + bj * 128) = w; }
                if (!dry) row_ss_add(rss2, row, ss, fq); } }
    }
};
struct EpiGateUp : EpiBase {
    static constexpr bool PERM = true;
    bf16_t* ACT; const float* rss2;
    __device__ __forceinline__ void operator()(const f32x4 (&acc)[2][2][4][2], const Unit& u, int wr, int wc, int fr, int fq) const {
        const int row0 = u.pm * 256 + wr * 64 + fr, f0 = u.pn * 128 + wc * 32 + 8 * fq;
        float r2v[2][4];
#pragma unroll
        for (int ai = 0; ai < 2; ++ai)
#pragma unroll
            for (int m = 0; m < 4; ++m) r2v[ai][m] = rss2[row0 + ai * 128 + m * 16];
#pragma unroll
        for (int ai = 0; ai < 2; ++ai)
#pragma unroll
            for (int m = 0; m < 4; ++m) { const int row = row0 + ai * 128 + m * 16; const float r2 = rsqrtf(r2v[ai][m] * (1.f / 1024.f) + EPSV); float o[8];
#pragma unroll
                for (int n = 0; n < 2; ++n) { const f32x4 g = acc[ai][0][m][n] * r2, up = acc[ai][1][m][n] * r2;
#pragma unroll
                    for (int j = 0; j < 4; ++j) o[4 * n + j] = g[j] * sigmoidf_(g[j]) * up[j]; }
                u32x4 w; w.x = pk2(o[0], o[1]); w.y = pk2(o[2], o[3]); w.z = pk2(o[4], o[5]); w.w = pk2(o[6], o[7]); *(u32x4*)(ACT + (size_t)row * DFF + f0) = w; }
    }
};
struct EpiDown : EpiBase {
    static constexpr bool PERM = true;
    const bf16_t* X2B; bf16_t* X3B;
    __device__ __forceinline__ void operator()(const f32x4 (&acc)[2][2][4][2], const Unit& u, int wr, int wc, int fr, int fq) const {
        const int row0 = u.pm * 256 + wr * 64 + fr, col0 = u.pn * 256 + wc * 32 + 8 * fq;
#pragma unroll
        for (int ai = 0; ai < 2; ++ai) { u32x4 xv[4][2];
#pragma unroll
            for (int m = 0; m < 4; ++m)
#pragma unroll
                for (int bj = 0; bj < 2; ++bj) xv[m][bj] = *(const u32x4*)(X2B + (size_t)(row0 + ai * 128 + m * 16) * DM + col0 + bj * 128);
#pragma unroll
            for (int m = 0; m < 4; ++m) { const int row = row0 + ai * 128 + m * 16;
#pragma unroll
                for (int bj = 0; bj < 2; ++bj) { const f32x4 a0 = acc[ai][bj][m][0], a1 = acc[ai][bj][m][1]; const u32x4 x = xv[m][bj];
                    u32x4 w; w.x = pk2(bflo(x.x) + a0[0], bfhi(x.x) + a0[1]); w.y = pk2(bflo(x.y) + a0[2], bfhi(x.y) + a0[3]); w.z = pk2(bflo(x.z) + a1[0], bfhi(x.z) + a1[1]); w.w = pk2(bflo(x.w) + a1[2], bfhi(x.w) + a1[3]);
                    *(u32x4*)(X3B + (size_t)row * DM + col0 + bj * 128) = w; } } }
    }
};
struct EpiDownPart : EpiBase {
    static constexpr bool PERM = true;
    bf16_t* PART;
    __device__ __forceinline__ void operator()(const f32x4 (&acc)[2][2][4][2], const Unit& u, int wr, int wc, int fr, int fq) const {
        const int row0 = (u.pm - 64) * 256 + wr * 64 + fr, col0 = u.pn * 256 + wc * 32 + 8 * fq; bf16_t* base = PART + (size_t)(u.ko >> 8) * 1048576;
#pragma unroll
        for (int ai = 0; ai < 2; ++ai)
#pragma unroll
            for (int m = 0; m < 4; ++m)
#pragma unroll
                for (int bj = 0; bj < 2; ++bj) { const f32x4 a0 = acc[ai][bj][m][0], a1 = acc[ai][bj][m][1];
                    u32x4 w; w.x = pk2(a0[0], a0[1]); w.y = pk2(a0[2], a0[3]); w.z = pk2(a1[0], a1[1]); w.w = pk2(a1[2], a1[3]);
                    *(u32x4*)(base + (size_t)(row0 + ai * 128 + m * 16) * DM + col0 + bj * 128) = w; }
    }
};

__device__ __forceinline__ void p0_transpose_item(const float* W, int K, int N, bf16_t* WT, int mode, int bjoff, const float* ks1, const float* ks2, int ksplit, LAS float* scr, int item, int lane) {
    const int nblk = N / 32, kb = item / nblk, nb = item % nblk, k0 = 64 * kb, n0 = 32 * nb;
    const int r8 = lane >> 3, c4 = lane & 7;
#pragma unroll
    for (int i = 0; i < 8; ++i) { const int kk = 8 * i + r8, k = k0 + kk; float sc = 1.f; if (ks1) sc = k < ksplit ? ks1[k] : ks2[k - ksplit];
        const f32x4 v = *(const f32x4*)(W + (size_t)k * N + n0 + 4 * c4);
        LAS float* d = scr + kk * 33 + 4 * c4; d[0] = v[0] * sc; d[1] = v[1] * sc; d[2] = v[2] * sc; d[3] = v[3] * sc; }
    LDS_WAIT();
    const int c = lane & 7;
#pragma unroll
    for (int j = 0; j < 4; ++j) { const int n = (lane >> 3) + 8 * j; const LAS float* s = scr + (8 * c) * 33 + n; const int nn = n0 + n;
        const int row = mode ? (((nn >> 7) << 8) + bjoff + (nn & 127)) : nn;
        u32x4 o; o.x = pk2(s[0 * 33], s[1 * 33]); o.y = pk2(s[2 * 33], s[3 * 33]); o.z = pk2(s[4 * 33], s[5 * 33]); o.w = pk2(s[6 * 33], s[7 * 33]);
        *(u32x4*)(WT + (size_t)row * K + k0 + 8 * c) = o; }
    LDS_WAIT();
}

__device__ __forceinline__ void phase0(const Params& p, LAS unsigned char* lds) {
    const int tid = threadIdx.x, lane = tid & 63, wave = tid >> 6;
    const int gw = blockIdx.x * 8 + wave, NGW = gridDim.x * 8;
    unsigned char* ws = p.ws;
    {   bf16_t* XH = (bf16_t*)(ws + W_XH); const f32x4* g4 = (const f32x4*)p.in[4] + 2 * lane; f32x4 gg[2][2];
#pragma unroll
        for (int j = 0; j < 2; ++j) { gg[j][0] = g4[128 * j]; gg[j][1] = g4[128 * j + 1]; }
        for (int tok = gw; tok < MTOK; tok += 2 * NGW) { const int tok2 = tok + NGW < MTOK ? tok + NGW : tok;
            const f32x4* xr = (const f32x4*)xrow_ptr(p, tok) + 2 * lane; const f32x4* xr2 = (const f32x4*)xrow_ptr(p, tok2) + 2 * lane; f32x4 v[2][2], v2[2][2]; float s = 0.f, s2 = 0.f;
#pragma unroll
            for (int j = 0; j < 2; ++j) { v[j][0] = xr[128 * j]; v[j][1] = xr[128 * j + 1]; v2[j][0] = xr2[128 * j]; v2[j][1] = xr2[128 * j + 1]; }
#pragma unroll
            for (int j = 0; j < 2; ++j)
#pragma unroll
                for (int e = 0; e < 2; ++e) { const f32x4 a = v[j][e], c = v2[j][e]; s += (a[0] * a[0] + a[1] * a[1]) + (a[2] * a[2] + a[3] * a[3]); s2 += (c[0] * c[0] + c[1] * c[1]) + (c[2] * c[2] + c[3] * c[3]); }
            const float r = rsqrtf(wave_sum(s) * (1.f / 1024.f) + EPSV), r2 = rsqrtf(wave_sum(s2) * (1.f / 1024.f) + EPSV);
            u32x4* o16 = (u32x4*)(XH + (size_t)tok * DM) + lane; u32x4* o162 = (u32x4*)(XH + (size_t)tok2 * DM) + lane;
#pragma unroll
            for (int j = 0; j < 2; ++j) { const f32x4 g0 = gg[j][0], g1 = gg[j][1]; const f32x4 a0 = v[j][0] * r * g0, a1 = v[j][1] * r * g1, c0 = v2[j][0] * r2 * g0, c1 = v2[j][1] * r2 * g1;
                u32x4 w; w.x = pk2(a0[0], a0[1]); w.y = pk2(a0[2], a0[3]); w.z = pk2(a1[0], a1[1]); w.w = pk2(a1[2], a1[3]); o16[64 * j] = w;
                u32x4 w2; w2.x = pk2(c0[0], c0[1]); w2.y = pk2(c0[2], c0[3]); w2.z = pk2(c1[0], c1[1]); w2.w = pk2(c1[2], c1[3]); o162[64 * j] = w2; } }
    }
    {   LAS float* scr = (LAS float*)(lds + wave * 8448);
        constexpr int I_IN = 16 * 48, I_GLU = 8 * 16, I_OUT = 16 * 32, NIT = I_IN + I_GLU + I_OUT;
        for (int it = gw; it < NIT; it += NGW) { int r = it;
            if (r < I_IN) { p0_transpose_item(p.in[5], 1024, 1536, (bf16_t*)(ws + W_BTIN), 0, 0, nullptr, nullptr, 0, scr, r, lane); continue; } r -= I_IN;
            if (r < I_GLU) { p0_transpose_item(p.in[14], 512, 512, (bf16_t*)(ws + W_BTGLU), 0, 0, nullptr, nullptr, 0, scr, r, lane); continue; } r -= I_GLU;
            p0_transpose_item(p.in[22], 1024, 1024, (bf16_t*)(ws + W_BTOUT), 0, 0, p.in[20], p.in[21], 512, scr, r, lane); }
    }
    const int gt = blockIdx.x * 512 + tid, NGT = gridDim.x * 512;
    for (int idx = gt; idx < 2048; idx += NGT) { const int g = idx >> 6;
        const float dt = expf(p.in[8][g]), lr = p.in[6][idx], li = p.in[7][idx];
        const float mag = expf(lr * dt), ar = mag * cosf(li * dt), ai = mag * sinf(li * dt), den = lr * lr + li * li;
        const float qr = ((ar - 1.0f) * lr + ai * li) / den, qi = (ai * lr - (ar - 1.0f) * li) / den;
        float* AT = (float*)(ws + W_ATAB); AT[idx * 2] = ar; AT[idx * 2 + 1] = ai;
        bf16_t* BB = (bf16_t*)(ws + W_BBT); const int n = idx & 63;
#pragma unroll
        for (int i = 0; i < 16; i += 2) { const float br0 = p.in[9][idx * 16 + i], bi0 = p.in[10][idx * 16 + i], br1 = p.in[9][idx * 16 + i + 1], bi1 = p.in[10][idx * 16 + i + 1];
            *(unsigned*)(BB + ((size_t)(g * 2 + 0) * 64 + n) * 16 + i) = pk2(qr * br0 - qi * bi0, qr * br1 - qi * bi1);
            *(unsigned*)(BB + ((size_t)(g * 2 + 1) * 64 + n) * 16 + i) = pk2(qr * bi0 + qi * br0, qr * bi1 + qi * br1); } }
    for (int idx = gt; idx < 32768; idx += NGT) { const int g = idx >> 10, o = (idx >> 6) & 15, kp = (idx & 63) * 2;
        const int c5 = kp >> 2, e = kp & 3; const size_t base = ((size_t)(g * 16 + o)) * 64;
        float v0, v1; if (e == 0) { v0 = p.in[11][base + c5]; v1 = p.in[11][base + c5 + 32]; } else { v0 = -p.in[12][base + c5]; v1 = -p.in[12][base + c5 + 32]; }
        *(unsigned*)((bf16_t*)(ws + W_CMT) + ((size_t)(g * 16 + o)) * 128 + kp) = pk2(v0, v1); }
    for (int idx = gt; idx < 131072; idx += NGT) { const int which = idx >> 16, h = (idx >> 13) & 7, t = (idx >> 6) & 127, s = (idx & 63) * 2; const float* wsr = p.in[18] + (size_t)h * 16384;
        float v0, v1;
        if (which == 0) { v0 = s <= t ? wsr[t * 128 + s] : 0.f; v1 = (s + 1) <= t ? wsr[t * 128 + s + 1] : 0.f; }
        else { const bool same = (t >> 3) == (s >> 3); const int tt = t & 7, s0 = s & 7; v0 = (same && s0 <= tt) ? wsr[tt * 128 + s0] : 0.f; v1 = (same && (s0 + 1) <= tt) ? wsr[tt * 128 + s0 + 1] : 0.f; }
        *(unsigned*)((bf16_t*)(ws + (which ? W_WTS : W_WTP)) + (size_t)h * 16384 + t * 128 + s) = pk2(v0, v1); }
    for (int idx = gt; idx < 4 * MTOK; idx += NGT) __hip_atomic_store((unsigned*)(ws + W_RSS) + idx, 0u, __ATOMIC_RELAXED, __HIP_MEMORY_SCOPE_AGENT);
}

__device__ __forceinline__ void p3_transposes(const Params& p, LAS unsigned char* lds, int first_idle) {
    const int tid = threadIdx.x, lane = tid & 63, wave = tid >> 6;
    if ((int)blockIdx.x < first_idle) return;
    const int gw = ((int)blockIdx.x - first_idle) * 8 + wave, NGW = ((int)gridDim.x - first_idle) * 8;
    unsigned char* ws = p.ws; LAS float* scr = (LAS float*)(lds + wave * 8448);
    constexpr int I_G = 16 * 88, I_DN = 44 * 32, NIT = 2 * I_G + I_DN;
    for (int it = gw; it < NIT; it += NGW) { int r = it;
        if (r < I_G) { p0_transpose_item(p.in[24], 1024, 2816, (bf16_t*)(ws + W_BTGU), 1, 0, p.in[23], p.in[23], 1024, scr, r, lane); continue; } r -= I_G;
        if (r < I_G) { p0_transpose_item(p.in[25], 1024, 2816, (bf16_t*)(ws + W_BTGU), 1, 128, p.in[23], p.in[23], 1024, scr, r, lane); continue; } r -= I_G;
        p0_transpose_item(p.in[26], 2816, 1024, (bf16_t*)(ws + W_BTDN), 0, 0, nullptr, nullptr, 0, scr, r, lane); }
}

constexpr int HT_STRIDE = 272, HT_WAVE = 32 * HT_STRIDE, SSEG_OFF = 8 * HT_WAVE;
struct S5Ctx { bf16x8 Bf[4]; bf16x8 Cf[4]; float ar0, ai0, ar1, ai1; float dsk[4]; };

__device__ __forceinline__ bf16x8 s5_load_a(const bf16_t* P, int g, int tokA, int tokB, int lane) {
    const int rho = lane & 31, half = (rho >> 2) & 1, r = 4 * (rho >> 3) + (rho & 3);
    const int tok = (half ? tokB : tokA) + r;
    return *(const bf16x8*)(P + (size_t)tok * INW + g * 16 + 8 * (lane >> 5));
}
__device__ __forceinline__ void s5_bu(const bf16x8 a, const S5Ctx& c, f32x16 (&acc)[4]) {
#pragma unroll
    for (int j = 0; j < 4; ++j) { f32x16 z;
#pragma unroll
        for (int i = 0; i < 16; ++i) z[i] = 0.f;
        acc[j] = __builtin_amdgcn_mfma_f32_32x32x16_bf16(a, c.Bf[j], z, 0, 0, 0); }
}
#define S5_STEP(r) do { const float nr0 = c.ar0 * hr0 - c.ai0 * hi0 + acc[0][r], ni0 = c.ar0 * hi0 + c.ai0 * hr0 + acc[2][r]; \
        const float nr1 = c.ar1 * hr1 - c.ai1 * hi1 + acc[1][r], ni1 = c.ar1 * hi1 + c.ai1 * hr1 + acc[3][r]; hr0 = nr0; hi0 = ni0; hr1 = nr1; hi1 = ni1; } while (0)

__device__ __forceinline__ u32x2 s5_load_x(const bf16_t* P, int g, int tok0, int lane) { return *(const u32x2*)(P + (size_t)(tok0 + (lane & 15)) * INW + g * 16 + 4 * (lane >> 4)); }
__device__ __forceinline__ void s5_y(bf16_t* GB, const S5Ctx& c, int g, int tokA, int tokB, int lane, LAS unsigned char* ht, const u32x2 xwA, const u32x2 xwB, bool nostore = false) {
    const int cc = lane & 15, q = lane >> 4;
#pragma unroll
    for (int t16 = 0; t16 < 2; ++t16) { f32x4 y = {0.f, 0.f, 0.f, 0.f};
#pragma unroll
        for (int ks = 0; ks < 4; ++ks) { const bf16x8 b = *(const LAS bf16x8*)(ht + (16 * t16 + cc) * HT_STRIDE + 64 * ks + 16 * q);
            y = __builtin_amdgcn_mfma_f32_16x16x32_bf16(c.Cf[ks], b, y, 0, 0, 0); }
        const int tok = (t16 ? tokB : tokA) + cc; const u32x2 xw = t16 ? xwB : xwA;
        const float o0 = gelu_t(y[0] + c.dsk[0] * bflo(xw.x)), o1 = gelu_t(y[1] + c.dsk[1] * bfhi(xw.x)), o2 = gelu_t(y[2] + c.dsk[2] * bflo(xw.y)), o3 = gelu_t(y[3] + c.dsk[3] * bfhi(xw.y));
        u32x2 w; w.x = pk2(o0, o1); w.y = pk2(o2, o3); if (!nostore) *(u32x2*)(GB + (size_t)tok * 512 + g * 16 + 4 * q) = w; }
}
__device__ __forceinline__ void s5_load_ctx(const Params& p, S5Ctx& c, int g, int lane) {
    const unsigned char* ws = p.ws; const int c5 = lane & 31, hh = lane >> 5;
    const float* AT = (const float*)(ws + W_ATAB) + (size_t)g * 128; c.ar0 = AT[c5 * 2]; c.ai0 = AT[c5 * 2 + 1]; c.ar1 = AT[(c5 + 32) * 2]; c.ai1 = AT[(c5 + 32) * 2 + 1];
    const bf16_t* BB = (const bf16_t*)(ws + W_BBT);
#pragma unroll
    for (int j = 0; j < 4; ++j) c.Bf[j] = *(const bf16x8*)(BB + ((size_t)(g * 2 + (j >> 1)) * 64 + 32 * (j & 1) + c5) * 16 + 8 * hh);
    const bf16_t* CM = (const bf16_t*)(ws + W_CMT) + ((size_t)(g * 16 + (lane & 15))) * 128;
#pragma unroll
    for (int ks = 0; ks < 4; ++ks) c.Cf[ks] = *(const bf16x8*)(CM + 32 * ks + 8 * (lane >> 4));
#pragma unroll
    for (int j = 0; j < 4; ++j) c.dsk[j] = p.in[13][g * 16 + 4 * (lane >> 4) + j];
}
#define S5_WRITE(r) do { u32x2 w; w.x = pk2(hr0, hr1); w.y = pk2(hi0, hi1); *(LAS u32x2*)(ht + (16 * hh + (r)) * HT_STRIDE + 8 * c5) = w; } while (0)

__device__ __forceinline__ void s5_prompt_item(const Params& p, int item, LAS unsigned char* lds, bool dryA = false, bool dryB = false) {
    const int tid = threadIdx.x, lane = tid & 63, wave = tid >> 6, c5 = lane & 31, hh = lane >> 5;
    const int slot = item >> 3, g = 4 * (item & 7) + (slot & 3), b = slot >> 2, seqbase = b * 2048;
    const bf16_t* P = (const bf16_t*)(p.ws + W_PBUF); bf16_t* GB = (bf16_t*)(p.ws + W_GBUF);
    S5Ctx c; s5_load_ctx(p, c, g, lane);
    LAS unsigned char* ht = lds + wave * HT_WAVE; LAS float* sseg = (LAS float*)(lds + SSEG_OFF);
    float hr0 = 0.f, hi0 = 0.f, hr1 = 0.f, hi1 = 0.f; f32x16 acc[4];
    const int tbase = seqbase + 256 * wave;
    bf16x8 acur = s5_load_a(P, g, tbase, tbase + 128, lane);
    for (int tile = 0; tile < 8; ++tile) { const int tn = tile < 7 ? tile + 1 : 7; const bf16x8 anext = s5_load_a(P, g, tbase + 16 * tn, tbase + 16 * tn + 128, lane);
        s5_bu(acur, c, acc); acur = anext;
#pragma unroll
        for (int r = 0; r < 16; ++r) S5_STEP(r); }
    const int seg = 2 * wave + hh;
    sseg[(seg * 64 + c5) * 2] = hr0; sseg[(seg * 64 + c5) * 2 + 1] = hi0; sseg[(seg * 64 + c5 + 32) * 2] = hr1; sseg[(seg * 64 + c5 + 32) * 2 + 1] = hi1;
    float pr0 = c.ar0, pi0 = c.ai0, pr1 = c.ar1, pi1 = c.ai1;
#pragma unroll
    for (int i = 0; i < 7; ++i) { const float t0 = pr0 * pr0 - pi0 * pi0, u0 = 2.f * pr0 * pi0, t1 = pr1 * pr1 - pi1 * pi1, u1 = 2.f * pr1 * pi1; pr0 = t0; pi0 = u0; pr1 = t1; pi1 = u1; }
    __syncthreads();
    hr0 = hi0 = hr1 = hi1 = 0.f;
    for (int j = 0; j < seg; ++j) { const float s0r = sseg[(j * 64 + c5) * 2], s0i = sseg[(j * 64 + c5) * 2 + 1], s1r = sseg[(j * 64 + c5 + 32) * 2], s1i = sseg[(j * 64 + c5 + 32) * 2 + 1];
        const float nr0 = pr0 * hr0 - pi0 * hi0 + s0r, ni0 = pr0 * hi0 + pi0 * hr0 + s0i, nr1 = pr1 * hr1 - pi1 * hi1 + s1r, ni1 = pr1 * hi1 + pi1 * hr1 + s1i; hr0 = nr0; hi0 = ni0; hr1 = nr1; hi1 = ni1; }
    acur = s5_load_a(P, g, tbase, tbase + 128, lane);
    for (int tile = 0; tile < 8; ++tile) { const int tokA = tbase + 16 * tile, tokB = tokA + 128; const int tn = tile < 7 ? tile + 1 : 7;
        const bf16x8 anext = s5_load_a(P, g, tbase + 16 * tn, tbase + 16 * tn + 128, lane);
        const u32x2 xwA = s5_load_x(P, g, tokA, lane), xwB = s5_load_x(P, g, tokB, lane);
        s5_bu(acur, c, acc); acur = anext;
#pragma unroll
        for (int r = 0; r < 16; ++r) { S5_STEP(r); S5_WRITE(r); }
        LDS_WAIT();
        s5_y(GB, c, g, tokA, tokB, lane, ht, xwA, xwB, dryA);
        LDS_WAIT(); }
    if (seg == 15 && !dryB) { float* ore = p.out + O_PRE + (size_t)(b * 32 + g) * 64; float* oim = p.out + O_PIM + (size_t)(b * 32 + g) * 64;
        ore[c5] = hr0; ore[c5 + 32] = hr1; oim[c5] = hi0; oim[c5 + 32] = hi1; }
    __syncthreads();
}
__device__ __forceinline__ void s5_sample_item(const Params& p, int item, LAS unsigned char* lds) {
    const int tid = threadIdx.x, lane = tid & 63, wave = tid >> 6, c5 = lane & 31, hh = lane >> 5;
    const int g = 4 * (item & 7) + ((item >> 3) & 3), qq = item >> 5;
    const bf16_t* P = (const bf16_t*)(p.ws + W_PBUF); bf16_t* GB = (bf16_t*)(p.ws + W_GBUF);
    S5Ctx c; s5_load_ctx(p, c, g, lane);
    LAS unsigned char* ht = lds + wave * HT_WAVE;
    const int b0 = 32 * qq + 4 * wave, tokA = NTP + 8 * b0, tokB = tokA + 16, bA = b0 + 2 * hh;
    float hr0, hi0, hr1, hi1; f32x16 acc[4];
    const u32x2 xwA = s5_load_x(P, g, tokA, lane), xwB = s5_load_x(P, g, tokB, lane);
    s5_bu(s5_load_a(P, g, tokA, tokB, lane), c, acc);
#pragma unroll
    for (int half = 0; half < 2; ++half) { const size_t so = ((size_t)(bA + half) * 32 + g) * 64;
        hr0 = p.in[2][so + c5]; hr1 = p.in[2][so + c5 + 32]; hi0 = p.in[3][so + c5]; hi1 = p.in[3][so + c5 + 32];
#pragma unroll
        for (int r8 = 0; r8 < 8; ++r8) { S5_STEP(half * 8 + r8); S5_WRITE(half * 8 + r8); }
        p.out[O_SRE + so + c5] = hr0; p.out[O_SRE + so + c5 + 32] = hr1; p.out[O_SIM + so + c5] = hi0; p.out[O_SIM + so + c5 + 32] = hi1; }
    LDS_WAIT();
    s5_y(GB, c, g, tokA, tokB, lane, ht, xwA, xwB);
    LDS_WAIT();
    __syncthreads();
}

__device__ __forceinline__ void cm_item(const Params& p, int item, LAS unsigned char* lds, bool dry) {
    const int tid = threadIdx.x, lane = tid & 63, wave = tid >> 6;
    const bool sample = item >= 128; int tok0; float* vout = nullptr; const bf16_t* WT; int tmask;
    if (!sample) { const int b = item >> 4, cidx = item & 15; tok0 = b * 2048 + 128 * cidx; if (cidx == 15) vout = p.out + O_PV + (size_t)b * 128 * 512; WT = (const bf16_t*)(p.ws + W_WTP); tmask = 127; }
    else { const int j = item - 128; tok0 = NTP + 128 * j; vout = p.out + O_SV + (size_t)j * 128 * 512; WT = (const bf16_t*)(p.ws + W_WTS); tmask = 7; }
    const bf16_t* P = (const bf16_t*)(p.ws + W_PBUF); bf16_t* MIX = (bf16_t*)(p.ws + W_MIX); float* rss_cm = (float*)(p.ws + W_RSS) + MTOK;
    {   float lg[8], lb[8];
#pragma unroll
        for (int j = 0; j < 8; ++j) { lg[j] = p.in[16][8 * lane + j]; lb[j] = p.in[17][8 * lane + j]; }
        u32x4 rawv[16];
#pragma unroll
        for (int i = 0; i < 16; ++i) rawv[i] = *(const u32x4*)(P + (size_t)(tok0 + 16 * wave + i) * INW + 1024 + 8 * lane);
#pragma unroll
        for (int i = 0; i < 8; ++i) { const int s = 16 * wave + 2 * i; float v[2][8];
#pragma unroll
            for (int e = 0; e < 2; ++e) { const u32x4 raw = rawv[2 * i + e];
                v[e][0] = bflo(raw.x); v[e][1] = bfhi(raw.x); v[e][2] = bflo(raw.y); v[e][3] = bfhi(raw.y); v[e][4] = bflo(raw.z); v[e][5] = bfhi(raw.z); v[e][6] = bflo(raw.w); v[e][7] = bfhi(raw.w);
                float sm = 0.f;
#pragma unroll
                for (int j = 0; j < 8; ++j) sm += v[e][j];
                const float mu = wave_sum(sm) * (1.f / 512.f); float s2 = 0.f;
#pragma unroll
                for (int j = 0; j < 8; ++j) { v[e][j] -= mu; s2 += v[e][j] * v[e][j]; }
                const float rs = rsqrtf(wave_sum(s2) * (1.f / 512.f) + EPSV);
#pragma unroll
                for (int j = 0; j < 8; ++j) v[e][j] = v[e][j] * rs * lg[j] + lb[j];
                if (vout) { float* vo = vout + (size_t)(s + e) * 512 + 8 * lane; *(f32x4*)vo = (f32x4){v[e][0], v[e][1], v[e][2], v[e][3]}; *(f32x4*)(vo + 4) = (f32x4){v[e][4], v[e][5], v[e][6], v[e][7]}; } }
            const int chunk = (s >> 3) ^ (lane & 15);
#pragma unroll
            for (int j = 0; j < 8; ++j) *(LAS unsigned*)(lds + (8 * lane + j) * 256 + chunk * 16 + (s & 7) * 2) = pk2(v[0][j], v[1][j]); }
    }
    __syncthreads();
    {   const int h = wave, cc = lane & 15, q = lane >> 4;
        bf16x8 Af[4][4];
#pragma unroll
        for (int dt = 0; dt < 4; ++dt)
#pragma unroll
            for (int ks = 0; ks < 4; ++ks) { const int d = 64 * h + 32 * (dt >> 1) + 8 * (cc >> 2) + 4 * (dt & 1) + (cc & 3);
                Af[dt][ks] = *(const LAS bf16x8*)(lds + d * 256 + (((4 * ks + q) ^ ((d >> 3) & 15)) * 16)); }
        const bf16_t* Wh = WT + (size_t)h * 16384; const float* bs = p.in[19] + h * 128;
        bf16x8 bwN[4]; u32x4 uwN[2]; float biasN;
#define CM_LOAD(tt_) do { const int t_ = 16 * (tt_) + cc; \
            _Pragma("unroll") for (int ks = 0; ks < 4; ++ks) if (ks <= ((tt_) >> 1)) bwN[ks] = *(const bf16x8*)(Wh + t_ * 128 + 32 * ks + 8 * q); \
            _Pragma("unroll") for (int k2 = 0; k2 < 2; ++k2) uwN[k2] = *(const u32x4*)(P + (size_t)(tok0 + t_) * INW + 512 + 64 * h + 32 * k2 + 8 * q); \
            biasN = bs[t_ & tmask]; } while (0)
        CM_LOAD(0);
#pragma unroll
        for (int tt = 0; tt < 8; ++tt) { const int t = 16 * tt + cc; f32x4 acc[4]; bf16x8 bw[4]; u32x4 uw[2];
#pragma unroll
            for (int ks = 0; ks < 4; ++ks) bw[ks] = bwN[ks];
#pragma unroll
            for (int k2 = 0; k2 < 2; ++k2) uw[k2] = uwN[k2];
            const float bias = biasN;
            if (tt < 7) CM_LOAD(tt + 1);
#pragma unroll
            for (int dt = 0; dt < 4; ++dt) acc[dt] = (f32x4){0.f, 0.f, 0.f, 0.f};
#pragma unroll
            for (int ks = 0; ks < 4; ++ks) if (ks <= (tt >> 1)) {
#pragma unroll
                for (int dt = 0; dt < 4; ++dt) acc[dt] = __builtin_amdgcn_mfma_f32_16x16x32_bf16(Af[dt][ks], bw[ks], acc[dt], 0, 0, 0); }
            float ss = 0.f; const size_t tok = (size_t)(tok0 + t);
#pragma unroll
            for (int k2 = 0; k2 < 2; ++k2) { const int d = 64 * h + 32 * k2 + 8 * q; const f32x4 a0 = acc[2 * k2], a1 = acc[2 * k2 + 1]; const u32x4 u4 = uw[k2];
                const float o0 = bflo(u4.x) * (a0[0] + bias), o1 = bfhi(u4.x) * (a0[1] + bias), o2 = bflo(u4.y) * (a0[2] + bias), o3 = bfhi(u4.y) * (a0[3] + bias);
                const float o4 = bflo(u4.z) * (a1[0] + bias), o5 = bfhi(u4.z) * (a1[1] + bias), o6 = bflo(u4.w) * (a1[2] + bias), o7 = bfhi(u4.w) * (a1[3] + bias);
                ss += (o0 * o0 + o1 * o1 + o2 * o2 + o3 * o3) + (o4 * o4 + o5 * o5 + o6 * o6 + o7 * o7);
                u32x4 w; w.x = pk2(o0, o1); w.y = pk2(o2, o3); w.z = pk2(o4, o5); w.w = pk2(o6, o7); *(u32x4*)(MIX + tok * DM + 512 + d) = w; }
            ss += __shfl_xor(ss, 16); ss += __shfl_xor(ss, 32);
            if (q == 0 && !dry) unsafeAtomicAdd(rss_cm + tok0 + t, ss);
            asm volatile("" ::: "memory"); }
#undef CM_LOAD
    }
    __syncthreads();
}

__device__ __forceinline__ void phase2(const Params& p, LAS unsigned char* lds, bool dry = false, int mask = 7) {
    for (int it = blockIdx.x; it < 256 + 128 + 136; it += gridDim.x) {
        if (it < 256) { if (mask & 1) s5_prompt_item(p, it, lds, dry && (PROBE_VAR & 1), dry && (PROBE_VAR & 2)); }
        else if (it < 392) { if (mask & 2) cm_item(p, it - 256, lds, dry); }
        else { if (mask & 4) s5_sample_item(p, it - 392, lds); }
    }
}
__device__ __forceinline__ void phase7(const Params& p, bool dry = false) {
    const int tid = threadIdx.x, lane = tid & 63, wave = tid >> 6, gw = blockIdx.x * 8 + wave, NGW = gridDim.x * 8;
    const f32x4* nf = (const f32x4*)p.in[27] + 2 * lane; const bf16_t* X3B = (const bf16_t*)(p.ws + W_X3B); const bf16_t* X2B = (const bf16_t*)(p.ws + W_X2B); const bf16_t* PART = (const bf16_t*)(p.ws + W_PART);
    f32x4 g[2][2];
#pragma unroll
    for (int j = 0; j < 2; ++j) { g[j][0] = nf[128 * j]; g[j][1] = nf[128 * j + 1]; }
    for (int q = gw; q < NTP + 2 * (MTOK - NTP); q += NGW) { if (q >= NTP && ((q - NTP) & 1)) continue;
        const int tok = q < NTP ? q : NTP + ((q - NTP) >> 1); f32x4 v[2][2];
        const u32x4* src = (const u32x4*)((tok < NTP ? X3B : X2B) + (size_t)tok * DM) + lane;
#pragma unroll
        for (int j = 0; j < 2; ++j) { const u32x4 w = src[64 * j]; v[j][0] = (f32x4){bflo(w.x), bfhi(w.x), bflo(w.y), bfhi(w.y)}; v[j][1] = (f32x4){bflo(w.z), bfhi(w.z), bflo(w.w), bfhi(w.w)}; }
        if (tok >= NTP) { const u32x4* pp = (const u32x4*)(PART + (size_t)(tok - NTP) * DM) + lane;
#pragma unroll
            for (int ks = 0; ks < 11; ++ks) { u32x4 t[2];
#pragma unroll
                for (int j = 0; j < 2; ++j) t[j] = pp[(size_t)ks * 131072 + 64 * j];
#pragma unroll
                for (int j = 0; j < 2; ++j) { v[j][0] = v[j][0] + (f32x4){bflo(t[j].x), bfhi(t[j].x), bflo(t[j].y), bfhi(t[j].y)}; v[j][1] = v[j][1] + (f32x4){bflo(t[j].z), bfhi(t[j].z), bflo(t[j].w), bfhi(t[j].w)}; } } }
        float s2 = 0.f;
#pragma unroll
        for (int j = 0; j < 2; ++j)
#pragma unroll
            for (int e = 0; e < 2; ++e) { const f32x4 a = v[j][e]; s2 += (a[0] * a[0] + a[1] * a[1]) + (a[2] * a[2] + a[3] * a[3]); }
        const float r = rsqrtf(wave_sum(s2) * (1.f / 1024.f) + EPSV);
        f32x4* xr = (f32x4*)(p.out + (size_t)tok * DM) + 2 * lane;
        if (!dry) {
#pragma unroll
            for (int j = 0; j < 2; ++j) { xr[128 * j] = v[j][0] * r * g[j][0]; xr[128 * j + 1] = v[j][1] * r * g[j][1]; } } }
}

#define XB_TMO      128
#define XB_XCNT(j)  (256  + 64 * (j))
#define XB_XSUB(j)  (1280 + 64 * (j))
#define XB_XGEN(j)  (2304 + 64 * (j))
#define XB_TOP      3328
#define XB_TOPGEN   3392
#define XCD_BAR_WORDS 3456
#define XB_SPIN_CAP (1u << 18)

__device__ __forceinline__ unsigned xb_ld(unsigned* p)              { return __hip_atomic_load(p, __ATOMIC_RELAXED, __HIP_MEMORY_SCOPE_AGENT); }
__device__ __forceinline__ unsigned xb_add(unsigned* p, unsigned v) { return __hip_atomic_fetch_add(p, v, __ATOMIC_RELAXED, __HIP_MEMORY_SCOPE_AGENT); }
__device__ __forceinline__ unsigned xb_xcc_id() { return (unsigned)__builtin_amdgcn_s_getreg((3 << 11) | 20) & 0xFu; }
#define XB_SPIN(cond, bar) do { unsigned _sp = 0; while (cond) { __builtin_amdgcn_s_sleep(1); \
    if ((++_sp & 255u) == 0u) { if (xb_ld(&(bar)[XB_TMO])) break; if (_sp > XB_SPIN_CAP) { atomicAdd(&(bar)[XB_TMO], 1u); break; } } } } while (0)

struct XcdBarrier {
    unsigned* bar; unsigned x;
    volatile LAS unsigned* st;
};

__device__ __forceinline__ XcdBarrier xcd_barrier_post(unsigned* bar, volatile LAS unsigned* st) {
    XcdBarrier b; b.bar = bar; b.x = xb_xcc_id(); b.st = st;
    if (threadIdx.x == 0) (void)xb_add(&bar[XB_XCNT(b.x)], 1u);
    return b;
}
__device__ __forceinline__ void xcd_barrier_complete(unsigned* bar, unsigned x, unsigned& nloc, unsigned& nx) {
    const unsigned G = gridDim.x * gridDim.y * gridDim.z;
    unsigned sum, cnt, mine, sp = 0u;
    for (;;) {
        sum = 0u; cnt = 0u; mine = 0u;
#pragma unroll
        for (unsigned j = 0; j < 16; ++j) { const unsigned c = xb_ld(&bar[XB_XCNT(j)]); sum += c; cnt += (c > 0u) ? 1u : 0u; mine = (j == x) ? c : mine; }
        if (sum == G) break;
        __builtin_amdgcn_s_sleep(1);
        if ((++sp & 255u) == 0u) { if (xb_ld(&bar[XB_TMO])) break; if (sp > XB_SPIN_CAP) { atomicAdd(&bar[XB_TMO], 1u); break; } }
    }
    nloc = mine > 0u ? mine : 1u; nx = cnt > 0u ? cnt : 1u;
}

__device__ __forceinline__ void xcd_barrier(const XcdBarrier& b) {
    asm volatile("s_waitcnt vmcnt(0)" ::: "memory");
    __syncthreads();
    if (threadIdx.x == 0) {
        unsigned* bar = b.bar;
        __builtin_amdgcn_s_waitcnt(0);
        unsigned nloc = b.st[0], nx = b.st[1];
        if (nloc == 0u) { xcd_barrier_complete(bar, b.x, nloc, nx); b.st[0] = nloc; b.st[1] = nx; }
        __builtin_amdgcn_s_sleep(64);
        __builtin_amdgcn_fence(__ATOMIC_RELEASE, "agent"); asm volatile("s_waitcnt vmcnt(0)" ::: "memory");
        const unsigned old = xb_add(&bar[XB_XSUB(b.x)], 1u);
        const unsigned gen = old / nloc;
        if (old + 1u == (gen + 1u) * nloc) {
            __builtin_amdgcn_fence(__ATOMIC_RELEASE, "agent");
            asm volatile("s_waitcnt vmcnt(0)" ::: "memory");
            const unsigned og = xb_add(&bar[XB_TOP], 1u);
            const unsigned tg = og / nx;
            if (og + 1u == (tg + 1u) * nx) xb_add(&bar[XB_TOPGEN], 1u);
            else XB_SPIN(xb_ld(&bar[XB_TOPGEN]) == tg, bar);
            __builtin_amdgcn_fence(__ATOMIC_ACQUIRE, "agent");
            xb_add(&bar[XB_XGEN(b.x)], 1u);
            asm volatile("s_waitcnt vmcnt(0)" ::: "memory");
        } else {
            XB_SPIN(xb_ld(&bar[XB_XGEN(b.x)]) == gen, bar);
            __builtin_amdgcn_fence(__ATOMIC_ACQUIRE, "agent");
            asm volatile("s_waitcnt vmcnt(0)" ::: "memory");
        }
    }
    __syncthreads();
}


__global__ __launch_bounds__(512, 2) void mega_fwd(Params p) {
    extern __shared__ __attribute__((aligned(16))) unsigned char shm_raw[];
    LAS unsigned char* lds = (LAS unsigned char*)shm_raw;
    cg::grid_group grid = cg::this_grid();
    unsigned char* ws = p.ws; float* rss = (float*)(ws + W_RSS);
    pg8::StaticOrder S;
    volatile LAS unsigned* xst = (volatile LAS unsigned*)(lds + 131072 + 4096);
    if (threadIdx.x < 4) xst[threadIdx.x] = 0u;
    __syncthreads();
    const XcdBarrier xb = xcd_barrier_post((unsigned*)(ws + W_BAR), xst);
    if (p.ph_lo < 0) grid.sync();
#define PH_RUN(n, ...) if ((PHMASK & (1 << n)) && p.ph_lo <= n && n < p.ph_hi) { if (n > p.ph_lo) xcd_barrier(xb); \
        for (int rep = 0; rep < (PROBE_PH == n ? 1 + PROBE_N : 1); ++rep) { if (rep) xcd_barrier(xb); const bool dry = rep > 0; __VA_ARGS__ } }
    PH_RUN(0, phase0(p, lds); (void)dry;)
    PH_RUN(1, pg8::Gemm g{(const bf16_t*)(ws + W_XH), (const bf16_t*)(ws + W_BTIN), MTOK, INW, 1024, 1024}; S.init(g.M, g.N, gridDim.x, blockIdx.x);
        EpiInProj E; E.dry = dry; E.P = (bf16_t*)(ws + W_PBUF); pg8::gemm_phase<EpiInProj, pg8::StaticOrder, GP_ALIGN, GP_SP2>(lds, g, S, E);)
    PH_RUN(2, phase2(p, lds, dry, dry ? PROBE_P2MASK : 7);)
    PH_RUN(3, { pg8::Gemm g{(const bf16_t*)(ws + W_GBUF), (const bf16_t*)(ws + W_BTGLU), MTOK, 512, 512, 512}; pg8::StaticOrder S3; S3.init(g.M, g.N, gridDim.x, blockIdx.x);
        EpiGlu E; E.dry = dry; E.G = (const bf16_t*)(ws + W_GBUF); E.MIX = (bf16_t*)(ws + W_MIX); E.bglu = p.in[15]; E.rss = rss;
        p3_transposes(p, lds, 136);
        pg8::gemm_phase<EpiGlu, pg8::StaticOrder, GP_ALIGN, GP_SP2>(lds, g, S3, E);
        asm volatile("s_waitcnt vmcnt(0)" ::: "memory");
        __syncthreads();
        if (threadIdx.x == 0) { Unit u; if (S3.next(0, u)) { __builtin_amdgcn_s_sleep(64); __builtin_amdgcn_fence(__ATOMIC_RELEASE, "agent"); asm volatile("s_waitcnt vmcnt(0)" ::: "memory");
            for (int i = 0; S3.next(i, u); ++i) __hip_atomic_fetch_add((unsigned*)(ws + W_BAR) + 4096 + 16 * (1 + u.pm), 1u, __ATOMIC_RELAXED, __HIP_MEMORY_SCOPE_AGENT); } } }
        { pg8::Gemm g{(const bf16_t*)(ws + W_MIX), (const bf16_t*)(ws + W_BTOUT), NTP, 1024, 1024, 1024}; S.init(g.M, g.N, gridDim.x, blockIdx.x);
        EpiOutProj E; E.dry = dry; E.xp = p.in[0]; E.xs = p.in[1]; E.X2B = (bf16_t*)(ws + W_X2B); E.rss2 = rss + 2 * MTOK;
        LAS float* fl = (LAS float*)(lds + 131072); E.fl = fl; E.pm0 = -1; E.pn0 = -1;
        if (threadIdx.x == 0) { bool any = false;
            for (int i = 0; i < 2; ++i) { Unit u0; if (!S.next(i, u0)) break; any = true; const unsigned* c = (const unsigned*)(ws + W_BAR) + 4096 + 16 * (1 + u0.pm);
                for (unsigned sp = 0; sp < (1u << 16); ++sp) { if (__hip_atomic_load(c, __ATOMIC_RELAXED, __HIP_MEMORY_SCOPE_AGENT) >= 2u) break; __builtin_amdgcn_s_sleep(2); } }
            if (any) { __builtin_amdgcn_fence(__ATOMIC_ACQUIRE, "agent"); asm volatile("s_waitcnt vmcnt(0)" ::: "memory"); } }
        __syncthreads();
        for (int i = 0; i < 2; ++i) { Unit u; if (S.next(i, u)) { if (i == 0) { E.pm0 = u.pm; E.pn0 = u.pn; }
            if (threadIdx.x < 256) { const int row = u.pm * 256 + threadIdx.x; const float a = rss[row] * (1.f / 512.f) + EPSV; const float b = rss[MTOK + row] * (1.f / 512.f) + EPSV;
                fl[i * 256 + threadIdx.x] = sqrtf(b / a); fl[512 + i * 256 + threadIdx.x] = rsqrtf(b); } } }
        __syncthreads();
        pg8::gemm_phase<EpiOutProj, pg8::StaticOrder, GP_ALIGN, GP_SP2>(lds, g, S, E); })
    PH_RUN(5, { pg8::Gemm g{(const bf16_t*)(ws + W_MIX), (const bf16_t*)(ws + W_BTOUT), MTOK, 1024, 1024, 1024};
        pg8::SampleOutOrder S4; S4.c = blockIdx.x; S4.base = (int)gridDim.x - 16; S4.cnt = (unsigned*)(ws + W_BAR) + 4096;
        EpiOutProj E; E.dry = dry; E.xp = p.in[0]; E.xs = p.in[1]; E.X2B = (bf16_t*)(ws + W_X2B); E.rss2 = rss + 2 * MTOK;
        LAS float* fl = (LAS float*)(lds + 131072); E.fl = fl; E.pm0 = -1; E.pn0 = -1;
        { Unit u; if (S4.next(0, u)) { E.pm0 = u.pm; E.pn0 = u.pn;
            if (threadIdx.x < 256) { const int row = u.pm * 256 + threadIdx.x; const float a = rss[row] * (1.f / 512.f) + EPSV; const float b = rss[MTOK + row] * (1.f / 512.f) + EPSV;
                fl[threadIdx.x] = sqrtf(b / a); fl[512 + threadIdx.x] = rsqrtf(b); } } }
        __syncthreads();
        pg8::gemm_phase<EpiOutProj, pg8::SampleOutOrder, GP_ALIGN, GP_SP2>(lds, g, S4, E);
        asm volatile("s_waitcnt vmcnt(0)" ::: "memory");
        __syncthreads();
        if (threadIdx.x == 0) { Unit u; if (S4.next(0, u)) { __builtin_amdgcn_s_sleep(64); __builtin_amdgcn_fence(__ATOMIC_RELEASE, "agent"); asm volatile("s_waitcnt vmcnt(0)" ::: "memory");
            __hip_atomic_fetch_add(S4.cnt, 1u, __ATOMIC_RELAXED, __HIP_MEMORY_SCOPE_AGENT); } } }
        { pg8::Gemm g{(const bf16_t*)(ws + W_X2B), (const bf16_t*)(ws + W_BTGU), MTOK, 2 * DFF, 1024, 1024}; pg8::CountedGU S5; S5.init(g.M, g.N, gridDim.x, blockIdx.x); S5.cnt = (const unsigned*)(ws + W_BAR) + 4096;
        EpiGateUp E; E.dry = dry; E.ACT = (bf16_t*)(ws + W_ACT); E.rss2 = rss + 2 * MTOK;
        pg8::gemm_phase<EpiGateUp, pg8::CountedGU, GP_ALIGN, GP_SP2>(lds, g, S5, E); })
    PH_RUN(6, { pg8::Gemm g{(const bf16_t*)(ws + W_ACT), (const bf16_t*)(ws + W_BTDN), NTP, 1024, DFF, DFF}; S.init(g.M, g.N, gridDim.x, blockIdx.x);
        EpiDown E; E.dry = dry; E.X2B = (const bf16_t*)(ws + W_X2B); E.X3B = (bf16_t*)(ws + W_X3B);
        pg8::gemm_phase<EpiDown, pg8::StaticOrder, GP_ALIGN, GP_SP2>(lds, g, S, E); }
        { pg8::Gemm g{(const bf16_t*)(ws + W_ACT), (const bf16_t*)(ws + W_BTDN), MTOK, 1024, 256, DFF}; pg8::SplitKOrder S2; S2.init(gridDim.x, blockIdx.x);
        EpiDownPart E; E.dry = dry; E.PART = (bf16_t*)(ws + W_PART);
        pg8::gemm_phase<EpiDownPart, pg8::SplitKOrder, GP_ALIGN, GP_SP2>(lds, g, S2, E); })
    PH_RUN(7, phase7(p, dry);)
}

extern "C" void kernel_launch(void* const* d_in, const int* in_sizes, int n_in, void* d_out, int out_size, void* d_ws, size_t ws_size, hipStream_t stream) {
    static int grid = 0;
    if (grid == 0) {
        if (n_in != 28 || ws_size < W_END) { fprintf(stderr, "kernel_launch: unexpected n_in %d / ws %zu (need %zu)\n", n_in, ws_size, (size_t)W_END); grid = -1; return; }
        int dev = 0, cus = 0, per_cu = 0;
        if (hipGetDevice(&dev) != hipSuccess || hipDeviceGetAttribute(&cus, hipDeviceAttributeMultiprocessorCount, dev) != hipSuccess) { grid = -1; return; }
        if (hipFuncSetAttribute((const void*)mega_fwd, hipFuncAttributeMaxDynamicSharedMemorySize, LDS_BYTES) != hipSuccess) { fprintf(stderr, "kernel_launch: hipFuncSetAttribute failed\n"); grid = -1; return; }
        if (hipOccupancyMaxActiveBlocksPerMultiprocessor(&per_cu, (const void*)mega_fwd, 512, LDS_BYTES) != hipSuccess || per_cu < 1) { fprintf(stderr, "kernel_launch: occupancy query says %d\n", per_cu); per_cu = 1; }
        (void)hipGetLastError();
        grid = cus * 1;
    }
    if (grid < 0) return;
    if (hipMemsetAsync((unsigned char*)d_ws + W_BAR, 0, 32768, stream) != hipSuccess) { fprintf(stderr, "kernel_launch: memset failed\n"); return; }
    Params p{};
    for (int i = 0; i < 28; ++i) p.in[i] = (const float*)d_in[i];
    p.out = (float*)d_out; p.ws = (unsigned char*)d_ws;
#if MK_MULTI_LAUNCH
    for (int ph = 0; ph < 8; ++ph) { p.ph_lo = ph; p.ph_hi = ph + 1; hipLaunchKernelGGL(mega_fwd, dim3(grid), dim3(512), LDS_BYTES, stream, p); }
#else
    p.ph_lo = 0; p.ph_hi = 8;
    void* args[] = {&p};
    hipError_t e = hipLaunchCooperativeKernel((const void*)mega_fwd, dim3(grid), dim3(512), args, LDS_BYTES, stream);
    if (e != hipSuccess) fprintf(stderr, "kernel_launch: cooperative launch failed: %s (grid %d)\n", hipGetErrorString(e), grid);
#endif
}
```

```cpp
#include <hip/hip_runtime.h>
#include <hip/hip_cooperative_groups.h>
#include <cstdio>
#include <cstdint>
namespace cg = cooperative_groups;
#ifndef PHMASK
#define PHMASK 255
#endif
#ifndef PROBE_PH
#define PROBE_PH -1
#endif
#ifndef PROBE_P2MASK
#define PROBE_P2MASK 7
#endif
#ifndef PROBE_VAR
#define PROBE_VAR 0
#endif
#ifndef PROBE_N
#define PROBE_N 2
#endif
#ifndef GP_ALIGN
#define GP_ALIGN true
#endif
#ifndef GP_SP2
#define GP_SP2 true
#endif
#ifndef MK_MULTI_LAUNCH
#define MK_MULTI_LAUNCH 0
#endif
namespace pg8 {
#define PG8_LAS __attribute__((address_space(3)))
typedef unsigned short bf16_t;
typedef short bf16x8 __attribute__((ext_vector_type(8)));
typedef float f32x4 __attribute__((ext_vector_type(4)));
typedef unsigned u32x4 __attribute__((ext_vector_type(4)));
constexpr int BM = 256, BK = 64, HALF = 128, HTB = HALF * BK * 2  , STAGE_BYTES = 8 * HTB, NXCD = 8, WGM = 8;

__host__ __device__ __forceinline__ int lds_byte(int r, int c) { const int st = (r >> 4) * 2 + (c >> 5), rr = r & 15, cc = c & 31, ob = rr * 64 + cc * 2; return st * 1024 + (ob ^ (((ob >> 9) & 1) << 5)); }
__host__ __device__ __forceinline__ void stage_rc(int b, int& R, int& C) { const int st = b / 1024, sb = b % 1024, swz = sb ^ (((sb >> 9) & 1) << 5); R = (st >> 1) * 16 + swz / 64; C = (st & 1) * 32 + (swz % 64) / 2; }
__host__ __device__ __forceinline__ int perm32(int rho) { const int n = rho >> 4, i = rho & 15; return 8 * (i >> 2) + 4 * n + (i & 3); }

struct Unit { int pm, pn, ko; };
struct Gemm { const bf16_t* A; const bf16_t* Bt; int M, N, K, ld; };

struct StaticOrder {
    int nM, nN, nwg, G, c;
    __host__ __device__ void init(int M, int N, int G_, int c_) { nM = M / BM; nN = N / BM; nwg = nM * nN; G = G_; c = c_; }
    __host__ __device__ bool next(int i, Unit& u) const {
        const long L = (long)i * G + c; if (L >= nwg) return false;
        int wgid = (int)L; { const int q = nwg / NXCD, r = nwg % NXCD, xcd = wgid % NXCD, off = wgid / NXCD; wgid = (xcd < r ? xcd * (q + 1) : r * (q + 1) + (xcd - r) * q) + off; }
        const int nig = WGM * nN, gid = wgid / nig, fm = gid * WGM, gsz = (nM - fm) < WGM ? (nM - fm) : WGM;
        u.pm = fm + ((wgid % nig) % gsz); u.pn = (wgid % nig) / gsz; u.ko = 0; return true;
    }
    __device__ __forceinline__ void a_ready(const Unit&) const {}
    __device__ __forceinline__ void done(const Unit&) const {}
};
struct SplitKOrder {
    int G, c;
    __host__ __device__ void init(int G_, int c_) { G = G_; c = c_; }
    __host__ __device__ bool next(int i, Unit& u) const { const long L = (long)i * G + c; if (L >= 176) return false; const int ks = (int)L % 11, rem = (int)L / 11; u.pm = 64 + (rem >> 2); u.pn = rem & 3; u.ko = ks * 256; return true; }
    __device__ __forceinline__ void a_ready(const Unit&) const {}
    __device__ __forceinline__ void done(const Unit&) const {}
};
struct GluOrder : StaticOrder {
    unsigned* cnt;
    __device__ __forceinline__ void done(const Unit& u) const {
        asm volatile("s_waitcnt vmcnt(0)" ::: "memory");
        __builtin_amdgcn_fence(__ATOMIC_RELEASE, "agent");
        asm volatile("s_waitcnt vmcnt(0)" ::: "memory");
        if ((threadIdx.x & 63) == 0) __hip_atomic_fetch_add(cnt + 16 * (1 + u.pm), 1u, __ATOMIC_RELAXED, __HIP_MEMORY_SCOPE_AGENT);
    }
};
struct SampleOutOrder {
    int c, base; unsigned* cnt;
    __host__ __device__ bool next(int i, Unit& u) const { if (i != 0 || c < base) return false; const int k = c - base; u.pm = 64 + (k >> 2); u.pn = k & 3; u.ko = 0; return true; }
    __device__ __forceinline__ void a_ready(const Unit&) const {}
    __device__ __forceinline__ void done(const Unit&) const {}
};
struct CountedGU : StaticOrder {
    const unsigned* cnt;
    __device__ __forceinline__ void a_ready(const Unit& u) const {
        if (u.pm >= 64) {
            if (threadIdx.x < 64) {
                for (unsigned sp = 0; sp < (1u << 16); ++sp) { if ((unsigned)__builtin_amdgcn_readfirstlane((int)__hip_atomic_load(cnt, __ATOMIC_RELAXED, __HIP_MEMORY_SCOPE_AGENT)) >= 16u) break; __builtin_amdgcn_s_sleep(2); }
                __builtin_amdgcn_fence(__ATOMIC_ACQUIRE, "agent");
                asm volatile("s_waitcnt vmcnt(0)" ::: "memory");
            }
            asm volatile("" ::: "memory"); __builtin_amdgcn_s_barrier(); asm volatile("" ::: "memory");
        }
    }
};
template <class Epi, class Sched, bool ALIGN_EPI = false, bool SP2 = false>
__device__ __forceinline__ void gemm_phase(PG8_LAS unsigned char* lds, const Gemm g, const Sched& S, const Epi& E) {
    const int tid = threadIdx.x, wid = __builtin_amdgcn_readfirstlane(tid >> 6), lane = tid & 63, wr = wid >> 2, wc = wid & 3, fr = lane & 15, fq = lane >> 4;
    const int K = g.K, nt = K / BK, LD = g.ld;
    unsigned voffA[2], voffB[2];
#pragma unroll
    for (int i = 0; i < 2; ++i) { int R, C; stage_rc(tid * 16 + i * 8192, R, C); const int Rb = Epi::PERM ? ((R & ~31) + perm32(R & 31)) : R;
        voffA[i] = (unsigned)(R * LD + C) * 2u; voffB[i] = (unsigned)(Rb * LD + C) * 2u; }
    const size_t kstep = (size_t)(BK * 2);
    const size_t hstep = (size_t)HALF * LD * 2;
    const size_t tstep = 2 * hstep;
    const unsigned ldsw = (unsigned)wid * 1024u;
    const int aoff = lds_byte(wr * 64 + fr, fq * 8), boff = lds_byte(wc * 32 + fr, fq * 8);
#define PG8_SA(b, h) (((b) * 2 + (h)) * HTB)
#define PG8_SB(b, h) ((4 + (b) * 2 + (h)) * HTB)
#define PG8_STAGE(bufoff, gbase, voff) do { _Pragma("unroll") for (int _i = 0; _i < 2; ++_i) \
        __builtin_amdgcn_global_load_lds((const unsigned*)((const char*)(gbase) + (voff)[_i]), (PG8_LAS unsigned*)(lds + (bufoff) + ldsw + _i * 8192), 16, 0, 0); } while (0)
#define PG8_LDA(dst, b, h) do { _Pragma("unroll") for (int m = 0; m < 4; ++m) _Pragma("unroll") for (int k = 0; k < 2; ++k) dst[m][k] = *(const PG8_LAS bf16x8*)(lds + PG8_SA(b, h) + aoff + m * 2048 + k * 1024); } while (0)
#define PG8_LDB(dst, b, h) do { _Pragma("unroll") for (int n = 0; n < 2; ++n) _Pragma("unroll") for (int k = 0; k < 2; ++k) dst[n][k] = *(const PG8_LAS bf16x8*)(lds + PG8_SB(b, h) + boff + n * 2048 + k * 1024); } while (0)
#define PG8_MMA(ai, bj, At, Bt) do { __builtin_amdgcn_s_setprio(1); _Pragma("unroll") for (int m = 0; m < 4; ++m) _Pragma("unroll") for (int n = 0; n < 2; ++n) _Pragma("unroll") for (int k = 0; k < 2; ++k) \
        acc[ai][bj][m][n] = __builtin_amdgcn_mfma_f32_16x16x32_bf16(Bt[n][k], At[m][k], acc[ai][bj][m][n], 0, 0, 0); __builtin_amdgcn_s_setprio(0); } while (0)
#define PG8_WAIT_V(n) asm volatile("s_waitcnt vmcnt(" #n ")" ::: "memory")
#define PG8_WAIT_L(n) asm volatile("s_waitcnt lgkmcnt(" #n ")" ::: "memory")
#define PG8_BAR __builtin_amdgcn_s_barrier()
#define PG8_SCHED __builtin_amdgcn_sched_barrier(0)
    Unit cur, nxt; int ui = 0;
    if (!S.next(0, cur)) return;
    f32x4 acc[2][2][4][2];
#pragma unroll
    for (int a = 0; a < 2; ++a)
#pragma unroll
        for (int b = 0; b < 2; ++b)
#pragma unroll
            for (int m = 0; m < 4; ++m)
#pragma unroll
                for (int n = 0; n < 2; ++n) acc[a][b][m][n] = (f32x4){0.f, 0.f, 0.f, 0.f};
    bf16x8 At[4][2], B0[2][2], B1[2][2];
    const char* cA = (const char*)g.A + (size_t)cur.pm * tstep + (size_t)cur.ko * 2; const char* cB = (const char*)g.Bt + (size_t)cur.pn * tstep + (size_t)cur.ko * 2;
    S.a_ready(cur);
    if constexpr (SP2) {
        PG8_STAGE(PG8_SB(0, 0), cB, voffB); PG8_STAGE(PG8_SB(0, 1), cB + hstep, voffB); PG8_STAGE(PG8_SA(0, 0), cA, voffA); PG8_STAGE(PG8_SA(0, 1), cA + hstep, voffA);
        if (wr == 1) PG8_BAR;
        PG8_WAIT_V(2); PG8_BAR;
        PG8_STAGE(PG8_SB(1, 0), cB + kstep, voffB); PG8_STAGE(PG8_SA(1, 0), cA + kstep, voffA); PG8_STAGE(PG8_SB(1, 1), cB + hstep + kstep, voffB);
        PG8_WAIT_V(6); PG8_BAR;
    } else {
        PG8_STAGE(PG8_SB(0, 0), cB, voffB); PG8_STAGE(PG8_SA(0, 0), cA, voffA); PG8_STAGE(PG8_SB(0, 1), cB + hstep, voffB); PG8_STAGE(PG8_SA(0, 1), cA + hstep, voffA);
        if (wr == 1) PG8_BAR;
        PG8_WAIT_V(4); PG8_BAR;
        PG8_STAGE(PG8_SB(1, 0), cB + kstep, voffB); PG8_STAGE(PG8_SA(1, 0), cA + kstep, voffA); PG8_STAGE(PG8_SB(1, 1), cB + hstep + kstep, voffB);
        PG8_WAIT_V(6); PG8_BAR;
    }
    for (;;) {
        const bool has_next = S.next(ui + 1, nxt);
        const char* nA = has_next ? (const char*)g.A + (size_t)nxt.pm * tstep + (size_t)nxt.ko * 2 : cA; const char* nB = has_next ? (const char*)g.Bt + (size_t)nxt.pn * tstep + (size_t)nxt.ko * 2 : cB;
        for (int t = 0; t < nt; t += 2) {
            const bool last = (t == nt - 2);
            const char* a1 = cA + (size_t)(t + 1) * kstep;
            const char* a2 = last ? nA : cA + (size_t)(t + 2) * kstep; const char* b2 = last ? nB : cB + (size_t)(t + 2) * kstep;
            const char* a3 = a2 + kstep; const char* b3 = b2 + kstep;
            if (last && has_next) S.a_ready(nxt);
            if constexpr (Epi::HAS_MID) { if (t == Epi::MID_T) E.mid(acc, cur, wr, wc, fr, fq); }
            if constexpr (SP2) {
            PG8_LDB(B0, 0, 0); PG8_LDB(B1, 0, 1); PG8_SCHED; PG8_LDA(At, 0, 0); PG8_STAGE(PG8_SA(1, 1), a1 + hstep, voffA);
            PG8_WAIT_V(8); PG8_WAIT_L(0); PG8_BAR; PG8_MMA(0, 0, At, B0); PG8_MMA(0, 1, At, B1); PG8_BAR; PG8_SCHED;
            PG8_LDA(At, 0, 1); PG8_STAGE(PG8_SB(0, 0), b2, voffB); PG8_STAGE(PG8_SB(0, 1), b2 + hstep, voffB); PG8_STAGE(PG8_SA(0, 0), a2, voffA);
            PG8_WAIT_V(8); PG8_WAIT_L(0); PG8_BAR; PG8_MMA(1, 0, At, B0); PG8_MMA(1, 1, At, B1); PG8_BAR; PG8_SCHED;
            PG8_LDB(B0, 1, 0); PG8_LDB(B1, 1, 1); PG8_SCHED; PG8_LDA(At, 1, 0); PG8_STAGE(PG8_SA(0, 1), a2 + hstep, voffA);
            PG8_WAIT_V(8); PG8_WAIT_L(0); PG8_BAR; PG8_MMA(0, 0, At, B0); PG8_MMA(0, 1, At, B1); PG8_BAR; PG8_SCHED;
            PG8_LDA(At, 1, 1); PG8_STAGE(PG8_SB(1, 0), b3, voffB); PG8_STAGE(PG8_SB(1, 1), b3 + hstep, voffB); PG8_STAGE(PG8_SA(1, 0), a3, voffA);
            PG8_WAIT_V(8); PG8_WAIT_L(0); PG8_BAR; PG8_MMA(1, 0, At, B0); PG8_MMA(1, 1, At, B1); PG8_BAR; PG8_SCHED;
            } else {
            PG8_LDB(B0, 0, 0); PG8_SCHED; PG8_LDA(At, 0, 0); PG8_STAGE(PG8_SA(1, 1), a1 + hstep, voffA);
            PG8_WAIT_L(8); PG8_BAR; PG8_WAIT_L(0); PG8_MMA(0, 0, At, B0); PG8_BAR; PG8_SCHED;
            PG8_LDB(B1, 0, 1); PG8_STAGE(PG8_SB(0, 0), b2, voffB);
            PG8_BAR; PG8_WAIT_L(0); PG8_MMA(0, 1, At, B1); PG8_BAR;
            PG8_LDA(At, 0, 1); PG8_STAGE(PG8_SA(0, 0), a2, voffA);
            PG8_BAR; PG8_WAIT_L(0); PG8_MMA(1, 0, At, B0); PG8_BAR; PG8_SCHED;
            PG8_STAGE(PG8_SB(0, 1), b2 + hstep, voffB);
            PG8_WAIT_V(6); PG8_BAR; PG8_MMA(1, 1, At, B1); PG8_BAR;
            PG8_LDB(B0, 1, 0); PG8_SCHED; PG8_LDA(At, 1, 0); PG8_STAGE(PG8_SA(0, 1), a2 + hstep, voffA);
            PG8_WAIT_L(8); PG8_BAR; PG8_WAIT_L(0); PG8_MMA(0, 0, At, B0); PG8_BAR; PG8_SCHED;
            PG8_LDB(B1, 1, 1); PG8_STAGE(PG8_SB(1, 0), b3, voffB);
            PG8_BAR; PG8_WAIT_L(0); PG8_MMA(0, 1, At, B1); PG8_BAR;
            PG8_LDA(At, 1, 1); PG8_STAGE(PG8_SA(1, 0), a3, voffA);
            PG8_BAR; PG8_WAIT_L(0); PG8_MMA(1, 0, At, B0); PG8_BAR; PG8_SCHED;
            PG8_STAGE(PG8_SB(1, 1), b3 + hstep, voffB);
            PG8_WAIT_V(6); PG8_BAR; PG8_MMA(1, 1, At, B1); PG8_BAR;
            }
        }
        if constexpr (ALIGN_EPI) { if (wr == 0) PG8_BAR; }
        if constexpr (!Epi::AFTER_DRAIN) { E(acc, cur, wr, wc, fr, fq); S.done(cur); }
        if (!has_next) break;
#pragma unroll
        for (int a = 0; a < 2; ++a)
#pragma unroll
            for (int b = 0; b < 2; ++b)
#pragma unroll
                for (int m = 0; m < 4; ++m)
#pragma unroll
                    for (int n = 0; n < 2; ++n) acc[a][b][m][n] = (f32x4){0.f, 0.f, 0.f, 0.f};
        cur = nxt; cA = nA; cB = nB; ++ui;
        if constexpr (ALIGN_EPI) { if (wr == 1) PG8_BAR; }
    }
    PG8_WAIT_V(0);
    if constexpr (!ALIGN_EPI) { if (wr == 0) PG8_BAR; }
    PG8_BAR;
    if constexpr (Epi::AFTER_DRAIN) { E.fused(acc, cur, wr, wc, fr, fq, lds, wid, lane); S.done(cur); }
#undef PG8_SA
#undef PG8_SB
#undef PG8_STAGE
#undef PG8_LDA
#undef PG8_LDB
#undef PG8_MMA
#undef PG8_WAIT_V
#undef PG8_WAIT_L
#undef PG8_BAR
#undef PG8_SCHED
}
}

using pg8::bf16_t; using pg8::bf16x8; using pg8::f32x4; using pg8::Unit;
#define LAS __attribute__((address_space(3)))
typedef unsigned u32x2 __attribute__((ext_vector_type(2)));
typedef unsigned u32x4 __attribute__((ext_vector_type(4)));
typedef float f32x16 __attribute__((ext_vector_type(16)));

constexpr int DM = 1024, NTP = 16384, MTOK = 17408, INW = 1536, DFF = 2816;
constexpr float EPSV = 1e-6f;
constexpr size_t O_Y = 0, O_PRE = 17825792, O_PIM = 17842176, O_PV = 17858560, O_SRE = 18382848, O_SIM = 18644992, O_SV = 18907136;
constexpr size_t W_ACT = 0, W_XH = 0, W_GBUF = 0, W_MIX = 35651584, W_PBUF = 71303168, W_X2B = 98041856;
constexpr size_t W_BTIN = 133693440, W_BTGLU = W_BTIN + 3145728, W_BTOUT = W_BTGLU + 524288, W_BTGU = W_BTOUT + 2097152, W_BTDN = W_BTGU + 11534336;
constexpr size_t W_ATAB = W_BTDN + 5767168, W_BBT = W_ATAB + 16384, W_CMT = W_BBT + 131072, W_WTP = W_CMT + 131072, W_WTS = W_WTP + 262144, W_RSS = W_WTS + 262144;
constexpr size_t W_BAR = W_RSS + 4 * 17408 * 4;
constexpr size_t W_X3B = W_BAR + 32768;
constexpr size_t W_PART = W_X3B + 33554432;
constexpr size_t W_END = W_PART + 11 * 4194304;
constexpr int LDS_BYTES = 131072 + 4096 + 256;

struct Params { const float* in[28]; float* out; unsigned char* ws; int ph_lo, ph_hi; };

__device__ __forceinline__ unsigned pk2(float lo, float hi) { unsigned r; asm volatile("v_cvt_pk_bf16_f32 %0, %1, %2" : "=v"(r) : "v"(lo), "v"(hi)); return r; }
__device__ __forceinline__ float bflo(unsigned w) { return __uint_as_float(w << 16); }
__device__ __forceinline__ float bfhi(unsigned w) { return __uint_as_float(w & 0xffff0000u); }
__device__ __forceinline__ float sigmoidf_(float z) { return __builtin_amdgcn_rcpf(1.0f + __builtin_amdgcn_exp2f(-1.4426950408889634f * z)); }
__device__ __forceinline__ float gelu_t(float x) { const float z = 1.5957691216057308f * (x + 0.044715f * x * x * x); return x * sigmoidf_(z); }
__device__ __forceinline__ float wave_sum(float v) {
#define WS_DPP(ctrl, rmask) v += __int_as_float(__builtin_amdgcn_update_dpp(0, __float_as_int(v), ctrl, rmask, 0xf, true))
    WS_DPP(0x111, 0xf); WS_DPP(0x112, 0xf); WS_DPP(0x114, 0xf); WS_DPP(0x118, 0xf); WS_DPP(0x142, 0xa); WS_DPP(0x143, 0xc);
#undef WS_DPP
    return __int_as_float(__builtin_amdgcn_readlane(__float_as_int(v), 63));
}
#define LDS_WAIT() asm volatile("s_waitcnt lgkmcnt(0)" ::: "memory")
__device__ __forceinline__ const float* xrow_ptr(const Params& p, int tok) { return tok < NTP ? p.in[0] + (size_t)tok * DM : p.in[1] + (size_t)(tok - NTP) * DM; }

struct EpiBase { bool dry = false; static constexpr bool PERM = false, AFTER_DRAIN = false, HAS_MID = false; static constexpr int MID_T = -1;
    __device__ __forceinline__ void mid(f32x4 (&)[2][2][4][2], const Unit&, int, int, int, int) const {} };

__device__ __forceinline__ void row_ss_add(float* rss, int row, float ss, int fq) {
    ss += __shfl_xor(ss, 16); ss += __shfl_xor(ss, 32);
    if (fq == 0) unsafeAtomicAdd(rss + row, ss);
}

struct EpiInProj : EpiBase {
    static constexpr bool PERM = true;
    bf16_t* P;
    __device__ __forceinline__ void operator()(const f32x4 (&acc)[2][2][4][2], const Unit& u, int wr, int wc, int fr, int fq) const {
        const int row0 = u.pm * 256 + wr * 64 + fr, col0 = u.pn * 256 + wc * 32 + 8 * fq; const bool act = u.pn >= 2;
#pragma unroll
        for (int ai = 0; ai < 2; ++ai)
#pragma unroll
            for (int m = 0; m < 4; ++m) { bf16_t* rowp = P + (size_t)(row0 + ai * 128 + m * 16) * INW + col0;
#pragma unroll
                for (int bj = 0; bj < 2; ++bj) { f32x4 v0 = acc[ai][bj][m][0], v1 = acc[ai][bj][m][1];
                    if (act) { v0[0] = gelu_t(v0[0]); v0[1] = gelu_t(v0[1]); v0[2] = gelu_t(v0[2]); v0[3] = gelu_t(v0[3]); v1[0] = gelu_t(v1[0]); v1[1] = gelu_t(v1[1]); v1[2] = gelu_t(v1[2]); v1[3] = gelu_t(v1[3]); }
                    u32x4 w; w.x = pk2(v0[0], v0[1]); w.y = pk2(v0[2], v0[3]); w.z = pk2(v1[0], v1[1]); w.w = pk2(v1[2], v1[3]); *(u32x4*)(rowp + bj * 128) = w; } }
    }
};
struct EpiGlu : EpiBase {
    static constexpr bool PERM = true;
    const bf16_t* G; bf16_t* MIX; const float* bglu; float* rss;
    __device__ __forceinline__ void operator()(const f32x4 (&acc)[2][2][4][2], const Unit& u, int wr, int wc, int fr, int fq) const {
        const int row0 = u.pm * 256 + wr * 64 + fr, col0 = u.pn * 256 + wc * 32 + 8 * fq;
        f32x4 bv[2][2];
#pragma unroll
        for (int bj = 0; bj < 2; ++bj)
#pragma unroll
            for (int n = 0; n < 2; ++n) bv[bj][n] = *(const f32x4*)(bglu + col0 + bj * 128 + n * 4);
#pragma unroll
        for (int ai = 0; ai < 2; ++ai) { u32x4 gw[4][2];
#pragma unroll
            for (int m = 0; m < 4; ++m)
#pragma unroll
                for (int bj = 0; bj < 2; ++bj) gw[m][bj] = *(const u32x4*)(G + (size_t)(row0 + ai * 128 + m * 16) * 512 + col0 + bj * 128);
#pragma unroll
            for (int m = 0; m < 4; ++m) { const int row = row0 + ai * 128 + m * 16; float ss = 0.f;
#pragma unroll
                for (int bj = 0; bj < 2; ++bj) { const f32x4 z0 = acc[ai][bj][m][0] + bv[bj][0], z1 = acc[ai][bj][m][1] + bv[bj][1]; const u32x4 g4 = gw[m][bj];
                    const float o0 = bflo(g4.x) * sigmoidf_(z0[0]), o1 = bfhi(g4.x) * sigmoidf_(z0[1]), o2 = bflo(g4.y) * sigmoidf_(z0[2]), o3 = bfhi(g4.y) * sigmoidf_(z0[3]);
                    const float o4 = bflo(g4.z) * sigmoidf_(z1[0]), o5 = bfhi(g4.z) * sigmoidf_(z1[1]), o6 = bflo(g4.w) * sigmoidf_(z1[2]), o7 = bfhi(g4.w) * sigmoidf_(z1[3]);
                    ss += (o0 * o0 + o1 * o1 + o2 * o2 + o3 * o3) + (o4 * o4 + o5 * o5 + o6 * o6 + o7 * o7);
                    u32x4 w; w.x = pk2(o0, o1); w.y = pk2(o2, o3); w.z = pk2(o4, o5); w.w = pk2(o6, o7); *(u32x4*)(MIX + (size_t)row * DM + col0 + bj * 128) = w; }
                if (!dry) row_ss_add(rss, row, ss, fq); } }
    }
};
struct EpiOutProj : EpiBase {
    static constexpr bool HAS_MID = true, PERM = true; static constexpr int MID_T = 8;
    const float* xp; const float* xs; bf16_t* X2B; float* rss2; const LAS float* fl; int pm0, pn0;
    __device__ __forceinline__ void mid(f32x4 (&acc)[2][2][4][2], const Unit& u, int wr, int wc, int fr, int fq) const {
        const LAS float* f0 = fl + ((u.pm == pm0 && u.pn == pn0) ? 0 : 256) + wr * 64 + fr;
#pragma unroll
        for (int ai = 0; ai < 2; ++ai)
#pragma unroll
            for (int m = 0; m < 4; ++m) { const float f = f0[ai * 128 + m * 16];
#pragma unroll
                for (int bj = 0; bj < 2; ++bj)
#pragma unroll
                    for (int n = 0; n < 2; ++n) acc[ai][bj][m][n] = acc[ai][bj][m][n] * f; }
    }
    __device__ __forceinline__ void operator()(const f32x4 (&acc)[2][2][4][2], const Unit& u, int wr, int wc, int fr, int fq) const {
        const int row0 = u.pm * 256 + wr * 64 + fr, col0 = u.pn * 256 + wc * 32 + 8 * fq;
        const LAS float* r0 = fl + 512 + ((u.pm == pm0 && u.pn == pn0) ? 0 : 256) + wr * 64 + fr;
        const float* xbase = row0 < NTP ? xp + (size_t)row0 * DM : xs + (size_t)(row0 - NTP) * DM;
#pragma unroll
        for (int ai = 0; ai < 2; ++ai) { f32x4 xv[4][2][2];
#pragma unroll
            for (int m = 0; m < 4; ++m)
#pragma unroll
                for (int bj = 0; bj < 2; ++bj)
#pragma unroll
                    for (int n = 0; n < 2; ++n) xv[m][bj][n] = *(const f32x4*)(xbase + (size_t)(ai * 128 + m * 16) * DM + col0 + bj * 128 + n * 4);
#pragma unroll
            for (int m = 0; m < 4; ++m) { const int row = row0 + ai * 128 + m * 16; float ss = 0.f; const float rc = r0[ai * 128 + m * 16];
#pragma unroll
                for (int bj = 0; bj < 2; ++bj) { const f32x4 v0 = xv[m][bj][0] + acc[ai][bj][m][0] * rc, v1 = xv[m][bj][1] + acc[ai][bj][m][1] * rc;
                    ss += (v0[0] * v0[0] + v0[1] * v0[1] + v0[2] * v0[2] + v0[3] * v0[3]) + (v1[0] * v1[0] + v1[1] * v1[1] + v1[2] * v1[2] + v1[3] * v1[3]);
                    u32x4 w; w.x = pk2(v0[0], v0[1]); w.y = pk2(v0[2], v0[3]); w.z = pk2(v1[0], v1[1]); w.w = pk2(v1[2], v1[3]); *(u32x4*)(X2B + (size_t)row * DM + col0 + bj * 128) = w; }
                if (!dry) row_ss_add(rss2, row, ss, fq); } }
    }
};
struct EpiGateUp : EpiBase {
    static constexpr bool PERM = true;
    bf16_t* ACT; const float* rss2;
    __device__ __forceinline__ void operator()(const f32x4 (&acc)[2][2][4][2], const Unit& u, int wr, int wc, int fr, int fq) const {
        const int row0 = u.pm * 256 + wr * 64 + fr, f0 = u.pn * 128 + wc * 32 + 8 * fq;
        float r2v[2][4];
#pragma unroll
        for (int ai = 0; ai < 2; ++ai)
#pragma unroll
            for (int m = 0; m < 4; ++m) r2v[ai][m] = rss2[row0 + ai * 128 + m * 16];
#pragma unroll
        for (int ai = 0; ai < 2; ++ai)
#pragma unroll
            for (int m = 0; m < 4; ++m) { const int row = row0 + ai * 128 + m * 16; const float r2 = rsqrtf(r2v[ai][m] * (1.f / 1024.f) + EPSV); float o[8];
#pragma unroll
                for (int n = 0; n < 2; ++n) { const f32x4 g = acc[ai][0][m][n] * r2, up = acc[ai][1][m][n] * r2;
#pragma unroll
                    for (int j = 0; j < 4; ++j) o[4 * n + j] = g[j] * sigmoidf_(g[j]) * up[j]; }
                u32x4 w; w.x = pk2(o[0], o[1]); w.y = pk2(o[2], o[3]); w.z = pk2(o[4], o[5]); w.w = pk2(o[6], o[7]); *(u32x4*)(ACT + (size_t)row * DFF + f0) = w; }
    }
};
struct EpiDown : EpiBase {
    static constexpr bool PERM = true;
    const bf16_t* X2B; bf16_t* X3B;
    __device__ __forceinline__ void operator()(const f32x4 (&acc)[2][2][4][2], const Unit& u, int wr, int wc, int fr, int fq) const {
        const int row0 = u.pm * 256 + wr * 64 + fr, col0 = u.pn * 256 + wc * 32 + 8 * fq;
#pragma unroll
        for (int ai = 0; ai < 2; ++ai) { u32x4 xv[4][2];
#pragma unroll
            for (int m = 0; m < 4; ++m)
#pragma unroll
                for (int bj = 0; bj < 2; ++bj) xv[m][bj] = *(const u32x4*)(X2B + (size_t)(row0 + ai * 128 + m * 16) * DM + col0 + bj * 128);
#pragma unroll
            for (int m = 0; m < 4; ++m) { const int row = row0 + ai * 128 + m * 16;
#pragma unroll
                for (int bj = 0; bj < 2; ++bj) { const f32x4 a0 = acc[ai][bj][m][0], a1 = acc[ai][bj][m][1]; const u32x4 x = xv[m][bj];
                    u32x4 w; w.x = pk2(bflo(x.x) + a0[0], bfhi(x.x) + a0[1]); w.y = pk2(bflo(x.y) + a0[2], bfhi(x.y) + a0[3]); w.z = pk2(bflo(x.z) + a1[0], bfhi(x.z) + a1[1]); w.w = pk2(bflo(x.w) + a1[2], bfhi(x.w) + a1[3]);
                    *(u32x4*)(X3B + (size_t)row * DM + col0 + bj * 128) = w; } } }
    }
};
struct EpiDownPart : EpiBase {
    static constexpr bool PERM = true;
    bf16_t* PART;
    __device__ __forceinline__ void operator()(const f32x4 (&acc)[2][2][4][2], const Unit& u, int wr, int wc, int fr, int fq) const {
        const int row0 = (u.pm - 64) * 256 + wr * 64 + fr, col0 = u.pn * 256 + wc * 32 + 8 * fq; bf16_t* base = PART + (size_t)(u.ko >> 8) * 1048576;
#pragma unroll
        for (int ai = 0; ai < 2; ++ai)
#pragma unroll
            for (int m = 0; m < 4; ++m)
#pragma unroll
                for (int bj = 0; bj < 2; ++bj) { const f32x4 a0 = acc[ai][bj][m][0], a1 = acc[ai][bj][m][1];
                    u32x4 w; w.x = pk2(a0[0], a0[1]); w.y = pk2(a0[2], a0[3]); w.z = pk2(a1[0], a1[1]); w.w = pk2(a1[2], a1[3]);
                    *(u32x4*)(base + (size_t)(row0 + ai * 128 + m * 16) * DM + col0 + bj * 128) = w; }
    }
};

__device__ __forceinline__ void p0_transpose_item(const float* W, int K, int N, bf16_t* WT, int mode, int bjoff, const float* ks1, const float* ks2, int ksplit, LAS float* scr, int item, int lane) {
    const int nblk = N / 32, kb = item / nblk, nb = item % nblk, k0 = 64 * kb, n0 = 32 * nb;
    const int r8 = lane >> 3, c4 = lane & 7;
#pragma unroll
    for (int i = 0; i < 8; ++i) { const int kk = 8 * i + r8, k = k0 + kk; float sc = 1.f; if (ks1) sc = k < ksplit ? ks1[k] : ks2[k - ksplit];
        const f32x4 v = *(const f32x4*)(W + (size_t)k * N + n0 + 4 * c4);
        LAS float* d = scr + kk * 33 + 4 * c4; d[0] = v[0] * sc; d[1] = v[1] * sc; d[2] = v[2] * sc; d[3] = v[3] * sc; }
    LDS_WAIT();
    const int c = lane & 7;
#pragma unroll
    for (int j = 0; j < 4; ++j) { const int n = (lane >> 3) + 8 * j; const LAS float* s = scr + (8 * c) * 33 + n; const int nn = n0 + n;
        const int row = mode ? (((nn >> 7) << 8) + bjoff + (nn & 127)) : nn;
        u32x4 o; o.x = pk2(s[0 * 33], s[1 * 33]); o.y = pk2(s[2 * 33], s[3 * 33]); o.z = pk2(s[4 * 33], s[5 * 33]); o.w = pk2(s[6 * 33], s[7 * 33]);
        *(u32x4*)(WT + (size_t)row * K + k0 + 8 * c) = o; }
    LDS_WAIT();
}

__device__ __forceinline__ void phase0(const Params& p, LAS unsigned char* lds) {
    const int tid = threadIdx.x, lane = tid & 63, wave = tid >> 6;
    const int gw = blockIdx.x * 8 + wave, NGW = gridDim.x * 8;
    unsigned char* ws = p.ws;
    {   bf16_t* XH = (bf16_t*)(ws + W_XH); const f32x4* g4 = (const f32x4*)p.in[4] + 2 * lane; f32x4 gg[2][2];
#pragma unroll
        for (int j = 0; j < 2; ++j) { gg[j][0] = g4[128 * j]; gg[j][1] = g4[128 * j + 1]; }
        for (int tok = gw; tok < MTOK; tok += 2 * NGW) { const int tok2 = tok + NGW < MTOK ? tok + NGW : tok;
            const f32x4* xr = (const f32x4*)xrow_ptr(p, tok) + 2 * lane; const f32x4* xr2 = (const f32x4*)xrow_ptr(p, tok2) + 2 * lane; f32x4 v[2][2], v2[2][2]; float s = 0.f, s2 = 0.f;
#pragma unroll
            for (int j = 0; j < 2; ++j) { v[j][0] = xr[128 * j]; v[j][1] = xr[128 * j + 1]; v2[j][0] = xr2[128 * j]; v2[j][1] = xr2[128 * j + 1]; }
#pragma unroll
            for (int j = 0; j < 2; ++j)
#pragma unroll
                for (int e = 0; e < 2; ++e) { const f32x4 a = v[j][e], c = v2[j][e]; s += (a[0] * a[0] + a[1] * a[1]) + (a[2] * a[2] + a[3] * a[3]); s2 += (c[0] * c[0] + c[1] * c[1]) + (c[2] * c[2] + c[3] * c[3]); }
            const float r = rsqrtf(wave_sum(s) * (1.f / 1024.f) + EPSV), r2 = rsqrtf(wave_sum(s2) * (1.f / 1024.f) + EPSV);
            u32x4* o16 = (u32x4*)(XH + (size_t)tok * DM) + lane; u32x4* o162 = (u32x4*)(XH + (size_t)tok2 * DM) + lane;
#pragma unroll
            for (int j = 0; j < 2; ++j) { const f32x4 g0 = gg[j][0], g1 = gg[j][1]; const f32x4 a0 = v[j][0] * r * g0, a1 = v[j][1] * r * g1, c0 = v2[j][0] * r2 * g0, c1 = v2[j][1] * r2 * g1;
                u32x4 w; w.x = pk2(a0[0], a0[1]); w.y = pk2(a0[2], a0[3]); w.z = pk2(a1[0], a1[1]); w.w = pk2(a1[2], a1[3]); o16[64 * j] = w;
                u32x4 w2; w2.x = pk2(c0[0], c0[1]); w2.y = pk2(c0[2], c0[3]); w2.z = pk2(c1[0], c1[1]); w2.w = pk2(c1[2], c1[3]); o162[64 * j] = w2; } }
    }
    {   LAS float* scr = (LAS float*)(lds + wave * 8448);
        constexpr int I_IN = 16 * 48, I_GLU = 8 * 16, I_OUT = 16 * 32, NIT = I_IN + I_GLU + I_OUT;
        for (int it = gw; it < NIT; it += NGW) { int r = it;
            if (r < I_IN) { p0_transpose_item(p.in[5], 1024, 1536, (bf16_t*)(ws + W_BTIN), 0, 0, nullptr, nullptr, 0, scr, r, lane); continue; } r -= I_IN;
            if (r < I_GLU) { p0_transpose_item(p.in[14], 512, 512, (bf16_t*)(ws + W_BTGLU), 0, 0, nullptr, nullptr, 0, scr, r, lane); continue; } r -= I_GLU;
            p0_transpose_item(p.in[22], 1024, 1024, (bf16_t*)(ws + W_BTOUT), 0, 0, p.in[20], p.in[21], 512, scr, r, lane); }
    }
    const int gt = blockIdx.x * 512 + tid, NGT = gridDim.x * 512;
    for (int id8 = gt; id8 < 16384; id8 += NGT) { const int idx = id8 >> 3, i = 2 * (id8 & 7), g = idx >> 6;
        const float dt = expf(p.in[8][g]), lr = p.in[6][idx], li = p.in[7][idx];
        const float mag = expf(lr * dt), ar = mag * cosf(li * dt), ai = mag * sinf(li * dt), den = lr * lr + li * li;
        const float qr = ((ar - 1.0f) * lr + ai * li) / den, qi = (ai * lr - (ar - 1.0f) * li) / den;
        if (i == 0) { float* AT = (float*)(ws + W_ATAB); AT[idx * 2] = ar; AT[idx * 2 + 1] = ai; }
        bf16_t* BB = (bf16_t*)(ws + W_BBT); const int n = idx & 63;
        const float br0 = p.in[9][idx * 16 + i], bi0 = p.in[10][idx * 16 + i], br1 = p.in[9][idx * 16 + i + 1], bi1 = p.in[10][idx * 16 + i + 1];
        *(unsigned*)(BB + ((size_t)(g * 2 + 0) * 64 + n) * 16 + i) = pk2(qr * br0 - qi * bi0, qr * br1 - qi * bi1);
        *(unsigned*)(BB + ((size_t)(g * 2 + 1) * 64 + n) * 16 + i) = pk2(qr * bi0 + qi * br0, qr * bi1 + qi * br1); }
    for (int idx = gt; idx < 32768; idx += NGT) { const int g = idx >> 10, o = (idx >> 6) & 15, kp = (idx & 63) * 2;
        const int c5 = kp >> 2, e = kp & 3; const size_t base = ((size_t)(g * 16 + o)) * 64;
        float v0, v1; if (e == 0) { v0 = p.in[11][base + c5]; v1 = p.in[11][base + c5 + 32]; } else { v0 = -p.in[12][base + c5]; v1 = -p.in[12][base + c5 + 32]; }
        *(unsigned*)((bf16_t*)(ws + W_CMT) + ((size_t)(g * 16 + o)) * 128 + kp) = pk2(v0, v1); }
    for (int idx = gt; idx < 131072; idx += NGT) { const int which = idx >> 16, h = (idx >> 13) & 7, t = (idx >> 6) & 127, s = (idx & 63) * 2; const float* wsr = p.in[18] + (size_t)h * 16384;
        float v0, v1;
        if (which == 0) { v0 = s <= t ? wsr[t * 128 + s] : 0.f; v1 = (s + 1) <= t ? wsr[t * 128 + s + 1] : 0.f; }
        else { const bool same = (t >> 3) == (s >> 3); const int tt = t & 7, s0 = s & 7; v0 = (same && s0 <= tt) ? wsr[tt * 128 + s0] : 0.f; v1 = (same && (s0 + 1) <= tt) ? wsr[tt * 128 + s0 + 1] : 0.f; }
        *(unsigned*)((bf16_t*)(ws + (which ? W_WTS : W_WTP)) + (size_t)h * 16384 + t * 128 + s) = pk2(v0, v1); }
    for (int idx = gt; idx < 4 * MTOK; idx += NGT) __hip_atomic_store((unsigned*)(ws + W_RSS) + idx, 0u, __ATOMIC_RELAXED, __HIP_MEMORY_SCOPE_AGENT);
}

__device__ __forceinline__ void p3_transposes(const Params& p, LAS unsigned char* lds, int first_idle) {
    const int tid = threadIdx.x, lane = tid & 63, wave = tid >> 6;
    if ((int)blockIdx.x < first_idle) return;
    const int gw = ((int)blockIdx.x - first_idle) * 8 + wave, NGW = ((int)gridDim.x - first_idle) * 8;
    unsigned char* ws = p.ws; LAS float* scr = (LAS float*)(lds + wave * 8448);
    constexpr int I_G = 16 * 88, I_DN = 44 * 32, NIT = 2 * I_G + I_DN;
    for (int it = gw; it < NIT; it += NGW) { int r = it;
        if (r < I_G) { p0_transpose_item(p.in[24], 1024, 2816, (bf16_t*)(ws + W_BTGU), 1, 0, p.in[23], p.in[23], 1024, scr, r, lane); continue; } r -= I_G;
        if (r < I_G) { p0_transpose_item(p.in[25], 1024, 2816, (bf16_t*)(ws + W_BTGU), 1, 128, p.in[23], p.in[23], 1024, scr, r, lane); continue; } r -= I_G;
        p0_transpose_item(p.in[26], 2816, 1024, (bf16_t*)(ws + W_BTDN), 0, 0, nullptr, nullptr, 0, scr, r, lane); }
}

constexpr int HT_STRIDE = 272, HT_WAVE = 32 * HT_STRIDE, SSEG_OFF = 8 * HT_WAVE;
struct S5Ctx { bf16x8 Bf[4]; bf16x8 Cf[4]; float ar0, ai0, ar1, ai1; float dsk[4]; };

__device__ __forceinline__ bf16x8 s5_load_a(const bf16_t* P, int g, int tokA, int tokB, int lane) {
    const int rho = lane & 31, half = (rho >> 2) & 1, r = 4 * (rho >> 3) + (rho & 3);
    const int tok = (half ? tokB : tokA) + r;
    return *(const bf16x8*)(P + (size_t)tok * INW + g * 16 + 8 * (lane >> 5));
}
__device__ __forceinline__ void s5_bu(const bf16x8 a, const S5Ctx& c, f32x16 (&acc)[4]) {
#pragma unroll
    for (int j = 0; j < 4; ++j) { f32x16 z;
#pragma unroll
        for (int i = 0; i < 16; ++i) z[i] = 0.f;
        acc[j] = __builtin_amdgcn_mfma_f32_32x32x16_bf16(a, c.Bf[j], z, 0, 0, 0); }
}
#define S5_STEP(r) do { const float nr0 = c.ar0 * hr0 - c.ai0 * hi0 + acc[0][r], ni0 = c.ar0 * hi0 + c.ai0 * hr0 + acc[2][r]; \
        const float nr1 = c.ar1 * hr1 - c.ai1 * hi1 + acc[1][r], ni1 = c.ar1 * hi1 + c.ai1 * hr1 + acc[3][r]; hr0 = nr0; hi0 = ni0; hr1 = nr1; hi1 = ni1; } while (0)

__device__ __forceinline__ u32x2 s5_load_x(const bf16_t* P, int g, int tok0, int lane) { return *(const u32x2*)(P + (size_t)(tok0 + (lane & 15)) * INW + g * 16 + 4 * (lane >> 4)); }
__device__ __forceinline__ void s5_y(bf16_t* GB, const S5Ctx& c, int g, int tokA, int tokB, int lane, LAS unsigned char* ht, const u32x2 xwA, const u32x2 xwB, bool nostore = false) {
    const int cc = lane & 15, q = lane >> 4;
#pragma unroll
    for (int t16 = 0; t16 < 2; ++t16) { f32x4 y = {0.f, 0.f, 0.f, 0.f};
#pragma unroll
        for (int ks = 0; ks < 4; ++ks) { const bf16x8 b = *(const LAS bf16x8*)(ht + (16 * t16 + cc) * HT_STRIDE + 64 * ks + 16 * q);
            y = __builtin_amdgcn_mfma_f32_16x16x32_bf16(c.Cf[ks], b, y, 0, 0, 0); }
        const int tok = (t16 ? tokB : tokA) + cc; const u32x2 xw = t16 ? xwB : xwA;
        const float o0 = gelu_t(y[0] + c.dsk[0] * bflo(xw.x)), o1 = gelu_t(y[1] + c.dsk[1] * bfhi(xw.x)), o2 = gelu_t(y[2] + c.dsk[2] * bflo(xw.y)), o3 = gelu_t(y[3] + c.dsk[3] * bfhi(xw.y));
        u32x2 w; w.x = pk2(o0, o1); w.y = pk2(o2, o3); if (!nostore) *(u32x2*)(GB + (size_t)tok * 512 + g * 16 + 4 * q) = w; }
}
__device__ __forceinline__ void s5_load_ctx(const Params& p, S5Ctx& c, int g, int lane) {
    const unsigned char* ws = p.ws; const int c5 = lane & 31, hh = lane >> 5;
    const float* AT = (const float*)(ws + W_ATAB) + (size_t)g * 128; c.ar0 = AT[c5 * 2]; c.ai0 = AT[c5 * 2 + 1]; c.ar1 = AT[(c5 + 32) * 2]; c.ai1 = AT[(c5 + 32) * 2 + 1];
    const bf16_t* BB = (const bf16_t*)(ws + W_BBT);
#pragma unroll
    for (int j = 0; j < 4; ++j) c.Bf[j] = *(const bf16x8*)(BB + ((size_t)(g * 2 + (j >> 1)) * 64 + 32 * (j & 1) + c5) * 16 + 8 * hh);
    const bf16_t* CM = (const bf16_t*)(ws + W_CMT) + ((size_t)(g * 16 + (lane & 15))) * 128;
#pragma unroll
    for (int ks = 0; ks < 4; ++ks) c.Cf[ks] = *(const bf16x8*)(CM + 32 * ks + 8 * (lane >> 4));
#pragma unroll
    for (int j = 0; j < 4; ++j) c.dsk[j] = p.in[13][g * 16 + 4 * (lane >> 4) + j];
}
#define S5_WRITE(r) do { u32x2 w; w.x = pk2(hr0, hr1); w.y = pk2(hi0, hi1); *(LAS u32x2*)(ht + (16 * hh + (r)) * HT_STRIDE + 8 * c5) = w; } while (0)

__device__ __forceinline__ void s5_prompt_item(const Params& p, int item, LAS unsigned char* lds, bool dryA = false, bool dryB = false) {
    const int tid = threadIdx.x, lane = tid & 63, wave = tid >> 6, c5 = lane & 31, hh = lane >> 5;
    const int slot = item >> 3, g = 4 * (item & 7) + (slot & 3), b = slot >> 2, seqbase = b * 2048;
    const bf16_t* P = (const bf16_t*)(p.ws + W_PBUF); bf16_t* GB = (bf16_t*)(p.ws + W_GBUF);
    S5Ctx c; s5_load_ctx(p, c, g, lane);
    LAS unsigned char* ht = lds + wave * HT_WAVE; LAS float* sseg = (LAS float*)(lds + SSEG_OFF);
    float hr0 = 0.f, hi0 = 0.f, hr1 = 0.f, hi1 = 0.f; f32x16 acc[4];
    const int tbase = seqbase + 256 * wave;
    bf16x8 acur = s5_load_a(P, g, tbase, tbase + 128, lane);
    for (int tile = 0; tile < 8; ++tile) { const int tn = tile < 7 ? tile + 1 : 7; const bf16x8 anext = s5_load_a(P, g, tbase + 16 * tn, tbase + 16 * tn + 128, lane);
        s5_bu(acur, c, acc); acur = anext;
#pragma unroll
        for (int r = 0; r < 16; ++r) S5_STEP(r); }
    const int seg = 2 * wave + hh;
    sseg[(seg * 64 + c5) * 2] = hr0; sseg[(seg * 64 + c5) * 2 + 1] = hi0; sseg[(seg * 64 + c5 + 32) * 2] = hr1; sseg[(seg * 64 + c5 + 32) * 2 + 1] = hi1;
    float pr0 = c.ar0, pi0 = c.ai0, pr1 = c.ar1, pi1 = c.ai1;
#pragma unroll
    for (int i = 0; i < 7; ++i) { const float t0 = pr0 * pr0 - pi0 * pi0, u0 = 2.f * pr0 * pi0, t1 = pr1 * pr1 - pi1 * pi1, u1 = 2.f * pr1 * pi1; pr0 = t0; pi0 = u0; pr1 = t1; pi1 = u1; }
    __syncthreads();
    hr0 = hi0 = hr1 = hi1 = 0.f;
    for (int j = 0; j < seg; ++j) { const float s0r = sseg[(j * 64 + c5) * 2], s0i = sseg[(j * 64 + c5) * 2 + 1], s1r = sseg[(j * 64 + c5 + 32) * 2], s1i = sseg[(j * 64 + c5 + 32) * 2 + 1];
        const float nr0 = pr0 * hr0 - pi0 * hi0 + s0r, ni0 = pr0 * hi0 + pi0 * hr0 + s0i, nr1 = pr1 * hr1 - pi1 * hi1 + s1r, ni1 = pr1 * hi1 + pi1 * hr1 + s1i; hr0 = nr0; hi0 = ni0; hr1 = nr1; hi1 = ni1; }
    acur = s5_load_a(P, g, tbase, tbase + 128, lane);
    for (int tile = 0; tile < 8; ++tile) { const int tokA = tbase + 16 * tile, tokB = tokA + 128; const int tn = tile < 7 ? tile + 1 : 7;
        const bf16x8 anext = s5_load_a(P, g, tbase + 16 * tn, tbase + 16 * tn + 128, lane);
        const u32x2 xwA = s5_load_x(P, g, tokA, lane), xwB = s5_load_x(P, g, tokB, lane);
        s5_bu(acur, c, acc); acur = anext;
#pragma unroll
        for (int r = 0; r < 16; ++r) { S5_STEP(r); S5_WRITE(r); }
        LDS_WAIT();
        s5_y(GB, c, g, tokA, tokB, lane, ht, xwA, xwB, dryA);
        LDS_WAIT(); }
    if (seg == 15 && !dryB) { float* ore = p.out + O_PRE + (size_t)(b * 32 + g) * 64; float* oim = p.out + O_PIM + (size_t)(b * 32 + g) * 64;
        ore[c5] = hr0; ore[c5 + 32] = hr1; oim[c5] = hi0; oim[c5 + 32] = hi1; }
    __syncthreads();
}
__device__ __forceinline__ void s5_sample_item(const Params& p, int item, LAS unsigned char* lds) {
    const int tid = threadIdx.x, lane = tid & 63, wave = tid >> 6, c5 = lane & 31, hh = lane >> 5;
    const int g = 4 * (item & 7) + ((item >> 3) & 3), qq = item >> 5;
    const bf16_t* P = (const bf16_t*)(p.ws + W_PBUF); bf16_t* GB = (bf16_t*)(p.ws + W_GBUF);
    S5Ctx c; s5_load_ctx(p, c, g, lane);
    LAS unsigned char* ht = lds + wave * HT_WAVE;
    const int b0 = 32 * qq + 4 * wave, tokA = NTP + 8 * b0, tokB = tokA + 16, bA = b0 + 2 * hh;
    float hr0, hi0, hr1, hi1; f32x16 acc[4];
    const u32x2 xwA = s5_load_x(P, g, tokA, lane), xwB = s5_load_x(P, g, tokB, lane);
    s5_bu(s5_load_a(P, g, tokA, tokB, lane), c, acc);
#pragma unroll
    for (int half = 0; half < 2; ++half) { const size_t so = ((size_t)(bA + half) * 32 + g) * 64;
        hr0 = p.in[2][so + c5]; hr1 = p.in[2][so + c5 + 32]; hi0 = p.in[3][so + c5]; hi1 = p.in[3][so + c5 + 32];
#pragma unroll
        for (int r8 = 0; r8 < 8; ++r8) { S5_STEP(half * 8 + r8); S5_WRITE(half * 8 + r8); }
        p.out[O_SRE + so + c5] = hr0; p.out[O_SRE + so + c5 + 32] = hr1; p.out[O_SIM + so + c5] = hi0; p.out[O_SIM + so + c5 + 32] = hi1; }
    LDS_WAIT();
    s5_y(GB, c, g, tokA, tokB, lane, ht, xwA, xwB);
    LDS_WAIT();
    __syncthreads();
}

__device__ __forceinline__ void cm_item(const Params& p, int item, LAS unsigned char* lds, bool dry) {
    const int tid = threadIdx.x, lane = tid & 63, wave = tid >> 6;
    const bool sample = item >= 128; int tok0; float* vout = nullptr; const bf16_t* WT; int tmask;
    if (!sample) { const int b = item >> 4, cidx = item & 15; tok0 = b * 2048 + 128 * cidx; if (cidx == 15) vout = p.out + O_PV + (size_t)b * 128 * 512; WT = (const bf16_t*)(p.ws + W_WTP); tmask = 127; }
    else { const int j = item - 128; tok0 = NTP + 128 * j; vout = p.out + O_SV + (size_t)j * 128 * 512; WT = (const bf16_t*)(p.ws + W_WTS); tmask = 7; }
    const bf16_t* P = (const bf16_t*)(p.ws + W_PBUF); bf16_t* MIX = (bf16_t*)(p.ws + W_MIX); float* rss_cm = (float*)(p.ws + W_RSS) + MTOK;
    {   float lg[8], lb[8];
#pragma unroll
        for (int j = 0; j < 8; ++j) { lg[j] = p.in[16][8 * lane + j]; lb[j] = p.in[17][8 * lane + j]; }
        u32x4 rawv[16];
#pragma unroll
        for (int i = 0; i < 16; ++i) rawv[i] = *(const u32x4*)(P + (size_t)(tok0 + 16 * wave + i) * INW + 1024 + 8 * lane);
#pragma unroll
        for (int i = 0; i < 8; ++i) { const int s = 16 * wave + 2 * i; float v[2][8];
#pragma unroll
            for (int e = 0; e < 2; ++e) { const u32x4 raw = rawv[2 * i + e];
                v[e][0] = bflo(raw.x); v[e][1] = bfhi(raw.x); v[e][2] = bflo(raw.y); v[e][3] = bfhi(raw.y); v[e][4] = bflo(raw.z); v[e][5] = bfhi(raw.z); v[e][6] = bflo(raw.w); v[e][7] = bfhi(raw.w);
                float sm = 0.f;
#pragma unroll
                for (int j = 0; j < 8; ++j) sm += v[e][j];
                const float mu = wave_sum(sm) * (1.f / 512.f); float s2 = 0.f;
#pragma unroll
                for (int j = 0; j < 8; ++j) { v[e][j] -= mu; s2 += v[e][j] * v[e][j]; }
                const float rs = rsqrtf(wave_sum(s2) * (1.f / 512.f) + EPSV);
#pragma unroll
                for (int j = 0; j < 8; ++j) v[e][j] = v[e][j] * rs * lg[j] + lb[j];
                if (vout) { float* vo = vout + (size_t)(s + e) * 512 + 8 * lane; *(f32x4*)vo = (f32x4){v[e][0], v[e][1], v[e][2], v[e][3]}; *(f32x4*)(vo + 4) = (f32x4){v[e][4], v[e][5], v[e][6], v[e][7]}; } }
            const int chunk = (s >> 3) ^ (lane & 15);
#pragma unroll
            for (int j = 0; j < 8; ++j) *(LAS unsigned*)(lds + (8 * lane + j) * 256 + chunk * 16 + (s & 7) * 2) = pk2(v[0][j], v[1][j]); }
    }
    __syncthreads();
    {   const int h = wave, cc = lane & 15, q = lane >> 4;
        bf16x8 Af[4][4];
#pragma unroll
        for (int dt = 0; dt < 4; ++dt)
#pragma unroll
            for (int ks = 0; ks < 4; ++ks) { const int d = 64 * h + 32 * (dt >> 1) + 8 * (cc >> 2) + 4 * (dt & 1) + (cc & 3);
                Af[dt][ks] = *(const LAS bf16x8*)(lds + d * 256 + (((4 * ks + q) ^ ((d >> 3) & 15)) * 16)); }
        const bf16_t* Wh = WT + (size_t)h * 16384; const float* bs = p.in[19] + h * 128;
        bf16x8 bwN[4]; u32x4 uwN[2]; float biasN;
#define CM_LOAD(tt_) do { const int t_ = 16 * (tt_) + cc; \
            _Pragma("unroll") for (int ks = 0; ks < 4; ++ks) if (ks <= ((tt_) >> 1)) bwN[ks] = *(const bf16x8*)(Wh + t_ * 128 + 32 * ks + 8 * q); \
            _Pragma("unroll") for (int k2 = 0; k2 < 2; ++k2) uwN[k2] = *(const u32x4*)(P + (size_t)(tok0 + t_) * INW + 512 + 64 * h + 32 * k2 + 8 * q); \
            biasN = bs[t_ & tmask]; } while (0)
        CM_LOAD(0);
#pragma unroll
        for (int tt = 0; tt < 8; ++tt) { const int t = 16 * tt + cc; f32x4 acc[4]; bf16x8 bw[4]; u32x4 uw[2];
#pragma unroll
            for (int ks = 0; ks < 4; ++ks) bw[ks] = bwN[ks];
#pragma unroll
            for (int k2 = 0; k2 < 2; ++k2) uw[k2] = uwN[k2];
            const float bias = biasN;
            if (tt < 7) CM_LOAD(tt + 1);
#pragma unroll
            for (int dt = 0; dt < 4; ++dt) acc[dt] = (f32x4){0.f, 0.f, 0.f, 0.f};
#pragma unroll
            for (int ks = 0; ks < 4; ++ks) if (ks <= (tt >> 1)) {
#pragma unroll
                for (int dt = 0; dt < 4; ++dt) acc[dt] = __builtin_amdgcn_mfma_f32_16x16x32_bf16(Af[dt][ks], bw[ks], acc[dt], 0, 0, 0); }
            float ss = 0.f; const size_t tok = (size_t)(tok0 + t);
#pragma unroll
            for (int k2 = 0; k2 < 2; ++k2) { const int d = 64 * h + 32 * k2 + 8 * q; const f32x4 a0 = acc[2 * k2], a1 = acc[2 * k2 + 1]; const u32x4 u4 = uw[k2];
                const float o0 = bflo(u4.x) * (a0[0] + bias), o1 = bfhi(u4.x) * (a0[1] + bias), o2 = bflo(u4.y) * (a0[2] + bias), o3 = bfhi(u4.y) * (a0[3] + bias);
                const float o4 = bflo(u4.z) * (a1[0] + bias), o5 = bfhi(u4.z) * (a1[1] + bias), o6 = bflo(u4.w) * (a1[2] + bias), o7 = bfhi(u4.w) * (a1[3] + bias);
                ss += (o0 * o0 + o1 * o1 + o2 * o2 + o3 * o3) + (o4 * o4 + o5 * o5 + o6 * o6 + o7 * o7);
                u32x4 w; w.x = pk2(o0, o1); w.y = pk2(o2, o3); w.z = pk2(o4, o5); w.w = pk2(o6, o7); *(u32x4*)(MIX + tok * DM + 512 + d) = w; }
            ss += __shfl_xor(ss, 16); ss += __shfl_xor(ss, 32);
            if (q == 0 && !dry) unsafeAtomicAdd(rss_cm + tok0 + t, ss);
            asm volatile("" ::: "memory"); }
#undef CM_LOAD
    }
    __syncthreads();
}

__device__ __forceinline__ void phase2(const Params& p, LAS unsigned char* lds, bool dry = false, int mask = 7) {
    for (int it = blockIdx.x; it < 256 + 128 + 136; it += gridDim.x) {
        if (it < 256) { if (mask & 1) s5_prompt_item(p, it, lds, dry && (PROBE_VAR & 1), dry && (PROBE_VAR & 2)); }
        else if (it < 392) { if (mask & 2) cm_item(p, it - 256, lds, dry); }
        else { if (mask & 4) s5_sample_item(p, it - 392, lds); }
    }
}
__device__ __forceinline__ void phase7(const Params& p, bool dry = false) {
    const int tid = threadIdx.x, lane = tid & 63, wave = tid >> 6, gw = blockIdx.x * 8 + wave, NGW = gridDim.x * 8;
    const f32x4* nf = (const f32x4*)p.in[27] + 2 * lane; const bf16_t* X3B = (const bf16_t*)(p.ws + W_X3B); const bf16_t* X2B = (const bf16_t*)(p.ws + W_X2B); const bf16_t* PART = (const bf16_t*)(p.ws + W_PART);
    f32x4 g[2][2];
#pragma unroll
    for (int j = 0; j < 2; ++j) { g[j][0] = nf[128 * j]; g[j][1] = nf[128 * j + 1]; }
    for (int q = gw; q < NTP + 2 * (MTOK - NTP); q += NGW) { if (q >= NTP && ((q - NTP) & 1)) continue;
        const int tok = q < NTP ? q : NTP + ((q - NTP) >> 1); f32x4 v[2][2];
        const u32x4* src = (const u32x4*)((tok < NTP ? X3B : X2B) + (size_t)tok * DM) + lane;
#pragma unroll
        for (int j = 0; j < 2; ++j) { const u32x4 w = src[64 * j]; v[j][0] = (f32x4){bflo(w.x), bfhi(w.x), bflo(w.y), bfhi(w.y)}; v[j][1] = (f32x4){bflo(w.z), bfhi(w.z), bflo(w.w), bfhi(w.w)}; }
        if (tok >= NTP) { const u32x4* pp = (const u32x4*)(PART + (size_t)(tok - NTP) * DM) + lane;
#pragma unroll
            for (int ks = 0; ks < 11; ++ks) { u32x4 t[2];
#pragma unroll
                for (int j = 0; j < 2; ++j) t[j] = pp[(size_t)ks * 131072 + 64 * j];
#pragma unroll
                for (int j = 0; j < 2; ++j) { v[j][0] = v[j][0] + (f32x4){bflo(t[j].x), bfhi(t[j].x), bflo(t[j].y), bfhi(t[j].y)}; v[j][1] = v[j][1] + (f32x4){bflo(t[j].z), bfhi(t[j].z), bflo(t[j].w), bfhi(t[j].w)}; } } }
        float s2 = 0.f;
#pragma unroll
        for (int j = 0; j < 2; ++j)
#pragma unroll
            for (int e = 0; e < 2; ++e) { const f32x4 a = v[j][e]; s2 += (a[0] * a[0] + a[1] * a[1]) + (a[2] * a[2] + a[3] * a[3]); }
        const float r = rsqrtf(wave_sum(s2) * (1.f / 1024.f) + EPSV);
        f32x4* xr = (f32x4*)(p.out + (size_t)tok * DM) + 2 * lane;
        if (!dry) {
#pragma unroll
            for (int j = 0; j < 2; ++j) { xr[128 * j] = v[j][0] * r * g[j][0]; xr[128 * j + 1] = v[j][1] * r * g[j][1]; } } }
}

#define XB_TMO      128
#define XB_XCNT(j)  (256  + 64 * (j))
#define XB_XSUB(j)  (1280 + 64 * (j))
#define XB_XGEN(j)  (2304 + 64 * (j))
#define XB_TOP      3328
#define XB_TOPGEN   3392
#define XCD_BAR_WORDS 3456
#define XB_SPIN_CAP (1u << 18)

__device__ __forceinline__ unsigned xb_ld(unsigned* p)              { return __hip_atomic_load(p, __ATOMIC_RELAXED, __HIP_MEMORY_SCOPE_AGENT); }
__device__ __forceinline__ unsigned xb_add(unsigned* p, unsigned v) { return __hip_atomic_fetch_add(p, v, __ATOMIC_RELAXED, __HIP_MEMORY_SCOPE_AGENT); }
__device__ __forceinline__ unsigned xb_xcc_id() { return (unsigned)__builtin_amdgcn_s_getreg((3 << 11) | 20) & 0xFu; }
#define XB_SPIN(cond, bar) do { unsigned _sp = 0; while (cond) { __builtin_amdgcn_s_sleep(1); \
    if ((++_sp & 255u) == 0u) { if (xb_ld(&(bar)[XB_TMO])) break; if (_sp > XB_SPIN_CAP) { atomicAdd(&(bar)[XB_TMO], 1u); break; } } } } while (0)

struct XcdBarrier {
    unsigned* bar; unsigned x;
    volatile LAS unsigned* st;
};

__device__ __forceinline__ XcdBarrier xcd_barrier_post(unsigned* bar, volatile LAS unsigned* st) {
    XcdBarrier b; b.bar = bar; b.x = xb_xcc_id(); b.st = st;
    if (threadIdx.x == 0) (void)xb_add(&bar[XB_XCNT(b.x)], 1u);
    return b;
}
__device__ __forceinline__ void xcd_barrier_complete(unsigned* bar, unsigned x, unsigned& nloc, unsigned& nx) {
    const unsigned G = gridDim.x * gridDim.y * gridDim.z;
    unsigned sum, cnt, mine, sp = 0u;
    for (;;) {
        sum = 0u; cnt = 0u; mine = 0u;
#pragma unroll
        for (unsigned j = 0; j < 16; ++j) { const unsigned c = xb_ld(&bar[XB_XCNT(j)]); sum += c; cnt += (c > 0u) ? 1u : 0u; mine = (j == x) ? c : mine; }
        if (sum == G) break;
        __builtin_amdgcn_s_sleep(1);
        if ((++sp & 255u) == 0u) { if (xb_ld(&bar[XB_TMO])) break; if (sp > XB_SPIN_CAP) { atomicAdd(&bar[XB_TMO], 1u); break; } }
    }
    nloc = mine > 0u ? mine : 1u; nx = cnt > 0u ? cnt : 1u;
}

__device__ __forceinline__ void xcd_barrier(const XcdBarrier& b) {
    asm volatile("s_waitcnt vmcnt(0)" ::: "memory");
    __syncthreads();
    if (threadIdx.x == 0) {
        unsigned* bar = b.bar;
        __builtin_amdgcn_s_waitcnt(0);
        unsigned nloc = b.st[0], nx = b.st[1];
        if (nloc == 0u) { xcd_barrier_complete(bar, b.x, nloc, nx); b.st[0] = nloc; b.st[1] = nx; }
        __builtin_amdgcn_s_sleep(64);
        __builtin_amdgcn_fence(__ATOMIC_RELEASE, "agent"); asm volatile("s_waitcnt vmcnt(0)" ::: "memory");
        const unsigned old = xb_add(&bar[XB_XSUB(b.x)], 1u);
        const unsigned gen = old / nloc;
        if (old + 1u == (gen + 1u) * nloc) {
            __builtin_amdgcn_fence(__ATOMIC_RELEASE, "agent");
            asm volatile("s_waitcnt vmcnt(0)" ::: "memory");
            const unsigned og = xb_add(&bar[XB_TOP], 1u);
            const unsigned tg = og / nx;
            if (og + 1u == (tg + 1u) * nx) xb_add(&bar[XB_TOPGEN], 1u);
            else XB_SPIN(xb_ld(&bar[XB_TOPGEN]) == tg, bar);
            __builtin_amdgcn_fence(__ATOMIC_ACQUIRE, "agent");
            xb_add(&bar[XB_XGEN(b.x)], 1u);
            asm volatile("s_waitcnt vmcnt(0)" ::: "memory");
        } else {
            XB_SPIN(xb_ld(&bar[XB_XGEN(b.x)]) == gen, bar);
            __builtin_amdgcn_fence(__ATOMIC_ACQUIRE, "agent");
            asm volatile("s_waitcnt vmcnt(0)" ::: "memory");
        }
    }
    __syncthreads();
}


__global__ __launch_bounds__(512, 2) void mega_fwd(Params p) {
    extern __shared__ __attribute__((aligned(16))) unsigned char shm_raw[];
    LAS unsigned char* lds = (LAS unsigned char*)shm_raw;
    cg::grid_group grid = cg::this_grid();
    unsigned char* ws = p.ws; float* rss = (float*)(ws + W_RSS);
    pg8::StaticOrder S;
    volatile LAS unsigned* xst = (volatile LAS unsigned*)(lds + 131072 + 4096);
    if (threadIdx.x < 4) xst[threadIdx.x] = 0u;
    __syncthreads();
    const XcdBarrier xb = xcd_barrier_post((unsigned*)(ws + W_BAR), xst);
    if (p.ph_lo < 0) grid.sync();
#define PH_RUN(n, ...) if ((PHMASK & (1 << n)) && p.ph_lo <= n && n < p.ph_hi) { if (n > p.ph_lo) xcd_barrier(xb); \
        for (int rep = 0; rep < (PROBE_PH == n ? 1 + PROBE_N : 1); ++rep) { if (rep) xcd_barrier(xb); const bool dry = rep > 0; __VA_ARGS__ } }
    PH_RUN(0, phase0(p, lds); (void)dry;)
    PH_RUN(1, pg8::Gemm g{(const bf16_t*)(ws + W_XH), (const bf16_t*)(ws + W_BTIN), MTOK, INW, 1024, 1024}; S.init(g.M, g.N, gridDim.x, blockIdx.x);
        EpiInProj E; E.dry = dry; E.P = (bf16_t*)(ws + W_PBUF); pg8::gemm_phase<EpiInProj, pg8::StaticOrder, GP_ALIGN, GP_SP2>(lds, g, S, E);)
    PH_RUN(2, phase2(p, lds, dry, dry ? PROBE_P2MASK : 7);)
    PH_RUN(3, { pg8::Gemm g{(const bf16_t*)(ws + W_GBUF), (const bf16_t*)(ws + W_BTGLU), MTOK, 512, 512, 512}; pg8::StaticOrder S3; S3.init(g.M, g.N, gridDim.x, blockIdx.x);
        EpiGlu E; E.dry = dry; E.G = (const bf16_t*)(ws + W_GBUF); E.MIX = (bf16_t*)(ws + W_MIX); E.bglu = p.in[15]; E.rss = rss;
        p3_transposes(p, lds, 136);
        pg8::gemm_phase<EpiGlu, pg8::StaticOrder, GP_ALIGN, GP_SP2>(lds, g, S3, E);
        asm volatile("s_waitcnt vmcnt(0)" ::: "memory");
        __syncthreads();
        if (threadIdx.x == 0) { Unit u; if (S3.next(0, u)) { __builtin_amdgcn_s_sleep(64); __builtin_amdgcn_fence(__ATOMIC_RELEASE, "agent"); asm volatile("s_waitcnt vmcnt(0)" ::: "memory");
            for (int i = 0; S3.next(i, u); ++i) __hip_atomic_fetch_add((unsigned*)(ws + W_BAR) + 4096 + 16 * (1 + u.pm), 1u, __ATOMIC_RELAXED, __HIP_MEMORY_SCOPE_AGENT); } } }
        { pg8::Gemm g{(const bf16_t*)(ws + W_MIX), (const bf16_t*)(ws + W_BTOUT), NTP, 1024, 1024, 1024}; S.init(g.M, g.N, gridDim.x, blockIdx.x);
        EpiOutProj E; E.dry = dry; E.xp = p.in[0]; E.xs = p.in[1]; E.X2B = (bf16_t*)(ws + W_X2B); E.rss2 = rss + 2 * MTOK;
        LAS float* fl = (LAS float*)(lds + 131072); E.fl = fl; E.pm0 = -1; E.pn0 = -1;
        if (threadIdx.x == 0) { bool any = false;
            for (int i = 0; i < 2; ++i) { Unit u0; if (!S.next(i, u0)) break; any = true; const unsigned* c = (const unsigned*)(ws + W_BAR) + 4096 + 16 * (1 + u0.pm);
                for (unsigned sp = 0; sp < (1u << 16); ++sp) { if (__hip_atomic_load(c, __ATOMIC_RELAXED, __HIP_MEMORY_SCOPE_AGENT) >= 2u) break; __builtin_amdgcn_s_sleep(2); } }
            if (any) { __builtin_amdgcn_fence(__ATOMIC_ACQUIRE, "agent"); asm volatile("s_waitcnt vmcnt(0)" ::: "memory"); } }
        __syncthreads();
        for (int i = 0; i < 2; ++i) { Unit u; if (S.next(i, u)) { if (i == 0) { E.pm0 = u.pm; E.pn0 = u.pn; }
            if (threadIdx.x < 256) { const int row = u.pm * 256 + threadIdx.x; const float a = rss[row] * (1.f / 512.f) + EPSV; const float b = rss[MTOK + row] * (1.f / 512.f) + EPSV;
                fl[i * 256 + threadIdx.x] = sqrtf(b / a); fl[512 + i * 256 + threadIdx.x] = rsqrtf(b); } } }
        __syncthreads();
        pg8::gemm_phase<EpiOutProj, pg8::StaticOrder, GP_ALIGN, GP_SP2>(lds, g, S, E); })
    PH_RUN(5, { pg8::Gemm g{(const bf16_t*)(ws + W_MIX), (const bf16_t*)(ws + W_BTOUT), MTOK, 1024, 1024, 1024};
        pg8::SampleOutOrder S4; S4.c = blockIdx.x; S4.base = (int)gridDim.x - 16; S4.cnt = (unsigned*)(ws + W_BAR) + 4096;
        EpiOutProj E; E.dry = dry; E.xp = p.in[0]; E.xs = p.in[1]; E.X2B = (bf16_t*)(ws + W_X2B); E.rss2 = rss + 2 * MTOK;
        LAS float* fl = (LAS float*)(lds + 131072); E.fl = fl; E.pm0 = -1; E.pn0 = -1;
        { Unit u; if (S4.next(0, u)) { E.pm0 = u.pm; E.pn0 = u.pn;
            if (threadIdx.x < 256) { const int row = u.pm * 256 + threadIdx.x; const float a = rss[row] * (1.f / 512.f) + EPSV; const float b = rss[MTOK + row] * (1.f / 512.f) + EPSV;
                fl[threadIdx.x] = sqrtf(b / a); fl[512 + threadIdx.x] = rsqrtf(b); } } }
        __syncthreads();
        pg8::gemm_phase<EpiOutProj, pg8::SampleOutOrder, GP_ALIGN, GP_SP2>(lds, g, S4, E);
        asm volatile("s_waitcnt vmcnt(0)" ::: "memory");
        __syncthreads();
        if (threadIdx.x == 0) { Unit u; if (S4.next(0, u)) { __builtin_amdgcn_s_sleep(64); __builtin_amdgcn_fence(__ATOMIC_RELEASE, "agent"); asm volatile("s_waitcnt vmcnt(0)" ::: "memory");
            __hip_atomic_fetch_add(S4.cnt, 1u, __ATOMIC_RELAXED, __HIP_MEMORY_SCOPE_AGENT); } } }
        { pg8::Gemm g{(const bf16_t*)(ws + W_X2B), (const bf16_t*)(ws + W_BTGU), MTOK, 2 * DFF, 1024, 1024}; pg8::CountedGU S5; S5.init(g.M, g.N, gridDim.x, blockIdx.x); S5.cnt = (const unsigned*)(ws + W_BAR) + 4096;
        EpiGateUp E; E.dry = dry; E.ACT = (bf16_t*)(ws + W_ACT); E.rss2 = rss + 2 * MTOK;
        pg8::gemm_phase<EpiGateUp, pg8::CountedGU, GP_ALIGN, GP_SP2>(lds, g, S5, E); })
    PH_RUN(6, { pg8::Gemm g{(const bf16_t*)(ws + W_ACT), (const bf16_t*)(ws + W_BTDN), NTP, 1024, DFF, DFF}; S.init(g.M, g.N, gridDim.x, blockIdx.x);
        EpiDown E; E.dry = dry; E.X2B = (const bf16_t*)(ws + W_X2B); E.X3B = (bf16_t*)(ws + W_X3B);
        pg8::gemm_phase<EpiDown, pg8::StaticOrder, GP_ALIGN, GP_SP2>(lds, g, S, E); }
        { pg8::Gemm g{(const bf16_t*)(ws + W_ACT), (const bf16_t*)(ws + W_BTDN), MTOK, 1024, 256, DFF}; pg8::SplitKOrder S2; S2.init(gridDim.x, blockIdx.x);
        EpiDownPart E; E.dry = dry; E.PART = (bf16_t*)(ws + W_PART);
        pg8::gemm_phase<EpiDownPart, pg8::SplitKOrder, GP_ALIGN, GP_SP2>(lds, g, S2, E); })
    PH_RUN(7, phase7(p, dry);)
}

extern "C" void kernel_launch(void* const* d_in, const int* in_sizes, int n_in, void* d_out, int out_size, void* d_ws, size_t ws_size, hipStream_t stream) {
    static int grid = 0;
    if (grid == 0) {
        if (n_in != 28 || ws_size < W_END) { fprintf(stderr, "kernel_launch: unexpected n_in %d / ws %zu (need %zu)\n", n_in, ws_size, (size_t)W_END); grid = -1; return; }
        int dev = 0, cus = 0, per_cu = 0;
        if (hipGetDevice(&dev) != hipSuccess || hipDeviceGetAttribute(&cus, hipDeviceAttributeMultiprocessorCount, dev) != hipSuccess) { grid = -1; return; }
        if (hipFuncSetAttribute((const void*)mega_fwd, hipFuncAttributeMaxDynamicSharedMemorySize, LDS_BYTES) != hipSuccess) { fprintf(stderr, "kernel_launch: hipFuncSetAttribute failed\n"); grid = -1; return; }
        if (hipOccupancyMaxActiveBlocksPerMultiprocessor(&per_cu, (const void*)mega_fwd, 512, LDS_BYTES) != hipSuccess || per_cu < 1) { fprintf(stderr, "kernel_launch: occupancy query says %d\n", per_cu); per_cu = 1; }
        (void)hipGetLastError();
        grid = cus * 1;
    }
    if (grid < 0) return;
    if (hipMemsetAsync((unsigned char*)d_ws + W_BAR, 0, 32768, stream) != hipSuccess) { fprintf(stderr, "kernel_launch: memset failed\n"); return; }
    Params p{};
    for (int i = 0; i < 28; ++i) p.in[i] = (const float*)d_in[i];
    p.out = (float*)d_out; p.ws = (unsigned char*)d_ws;
#if MK_MULTI_LAUNCH
    for (int ph = 0; ph < 8; ++ph) { p.ph_lo = ph; p.ph_hi = ph + 1; hipLaunchKernelGGL(mega_fwd, dim3(grid), dim3(512), LDS_BYTES, stream, p); }
#else
    p.ph_lo = 0; p.ph_hi = 8;
    void* args[] = {&p};
    hipError_t e = hipLaunchCooperativeKernel((const void*)mega_fwd, dim3(grid), dim3(512), args, LDS_BYTES, stream);
    if (e != hipSuccess) fprintf(stderr, "kernel_launch: cooperative launch failed: %s (grid %d)\n", hipGetErrorString(e), grid);
#endif
}
```

```cpp
#include <hip/hip_runtime.h>
#include <hip/hip_cooperative_groups.h>
#include <cstdio>
#include <cstdint>
namespace cg = cooperative_groups;
#ifndef PHMASK
#define PHMASK 255
#endif
#ifndef PROBE_PH
#define PROBE_PH -1
#endif
#ifndef PROBE_P2MASK
#define PROBE_P2MASK 7
#endif
#ifndef PROBE_VAR
#define PROBE_VAR 0
#endif
#ifndef PROBE_N
#define PROBE_N 2
#endif
#ifndef GP_ALIGN
#define GP_ALIGN true
#endif
#ifndef GP_SP2
#define GP_SP2 true
#endif
#ifndef MK_MULTI_LAUNCH
#define MK_MULTI_LAUNCH 0
#endif
namespace pg8 {
#define PG8_LAS __attribute__((address_space(3)))
typedef unsigned short bf16_t;
typedef short bf16x8 __attribute__((ext_vector_type(8)));
typedef float f32x4 __attribute__((ext_vector_type(4)));
typedef unsigned u32x4 __attribute__((ext_vector_type(4)));
constexpr int BM = 256, BK = 64, HALF = 128, HTB = HALF * BK * 2  , STAGE_BYTES = 8 * HTB, NXCD = 8, WGM = 8;

__host__ __device__ __forceinline__ int lds_byte(int r, int c) { const int st = (r >> 4) * 2 + (c >> 5), rr = r & 15, cc = c & 31, ob = rr * 64 + cc * 2; return st * 1024 + (ob ^ (((ob >> 9) & 1) << 5)); }
__host__ __device__ __forceinline__ void stage_rc(int b, int& R, int& C) { const int st = b / 1024, sb = b % 1024, swz = sb ^ (((sb >> 9) & 1) << 5); R = (st >> 1) * 16 + swz / 64; C = (st & 1) * 32 + (swz % 64) / 2; }
__host__ __device__ __forceinline__ int perm32(int rho) { const int n = rho >> 4, i = rho & 15; return 8 * (i >> 2) + 4 * n + (i & 3); }

struct Unit { int pm, pn, ko; };
struct Gemm { const bf16_t* A; const bf16_t* Bt; int M, N, K, ld; };

struct StaticOrder {
    int nM, nN, nwg, G, c;
    __host__ __device__ void init(int M, int N, int G_, int c_) { nM = M / BM; nN = N / BM; nwg = nM * nN; G = G_; c = c_; }
    __host__ __device__ bool next(int i, Unit& u) const {
        const long L = (long)i * G + c; if (L >= nwg) return false;
        int wgid = (int)L; { const int q = nwg / NXCD, r = nwg % NXCD, xcd = wgid % NXCD, off = wgid / NXCD; wgid = (xcd < r ? xcd * (q + 1) : r * (q + 1) + (xcd - r) * q) + off; }
        const int nig = WGM * nN, gid = wgid / nig, fm = gid * WGM, gsz = (nM - fm) < WGM ? (nM - fm) : WGM;
        u.pm = fm + ((wgid % nig) % gsz); u.pn = (wgid % nig) / gsz; u.ko = 0; return true;
    }
    __device__ __forceinline__ void a_ready(const Unit&) const {}
    __device__ __forceinline__ void done(const Unit&) const {}
};
struct SplitKOrder {
    int G, c;
    __host__ __device__ void init(int G_, int c_) { G = G_; c = c_; }
    __host__ __device__ bool next(int i, Unit& u) const { const long L = (long)i * G + c; if (L >= 176) return false; const int ks = (int)L % 11, rem = (int)L / 11; u.pm = 64 + (rem >> 2); u.pn = rem & 3; u.ko = ks * 256; return true; }
    __device__ __forceinline__ void a_ready(const Unit&) const {}
    __device__ __forceinline__ void done(const Unit&) const {}
};
struct GluOrder : StaticOrder {
    unsigned* cnt;
    __device__ __forceinline__ void done(const Unit& u) const {
        asm volatile("s_waitcnt vmcnt(0)" ::: "memory");
        __builtin_amdgcn_fence(__ATOMIC_RELEASE, "agent");
        asm volatile("s_waitcnt vmcnt(0)" ::: "memory");
        if ((threadIdx.x & 63) == 0) __hip_atomic_fetch_add(cnt + 16 * (1 + u.pm), 1u, __ATOMIC_RELAXED, __HIP_MEMORY_SCOPE_AGENT);
    }
};
struct SampleOutOrder {
    int c, base; unsigned* cnt;
    __host__ __device__ bool next(int i, Unit& u) const { if (i != 0 || c < base) return false; const int k = c - base; u.pm = 64 + (k >> 2); u.pn = k & 3; u.ko = 0; return true; }
    __device__ __forceinline__ void a_ready(const Unit&) const {}
    __device__ __forceinline__ void done(const Unit&) const {}
};
struct CountedGU : StaticOrder {
    const unsigned* cnt;
    __device__ __forceinline__ void a_ready(const Unit& u) const {
        if (u.pm >= 64) {
            if (threadIdx.x < 64) {
                for (unsigned sp = 0; sp < (1u << 16); ++sp) { if ((unsigned)__builtin_amdgcn_readfirstlane((int)__hip_atomic_load(cnt, __ATOMIC_RELAXED, __HIP_MEMORY_SCOPE_AGENT)) >= 16u) break; __builtin_amdgcn_s_sleep(2); }
                __builtin_amdgcn_fence(__ATOMIC_ACQUIRE, "agent");
                asm volatile("s_waitcnt vmcnt(0)" ::: "memory");
            }
            asm volatile("" ::: "memory"); __builtin_amdgcn_s_barrier(); asm volatile("" ::: "memory");
        }
    }
};
template <class Epi, class Sched, bool ALIGN_EPI = false, bool SP2 = false>
__device__ __forceinline__ void gemm_phase(PG8_LAS unsigned char* lds, const Gemm g, const Sched& S, const Epi& E) {
    const int tid = threadIdx.x, wid = __builtin_amdgcn_readfirstlane(tid >> 6), lane = tid & 63, wr = wid >> 2, wc = wid & 3, fr = lane & 15, fq = lane >> 4;
    const int K = g.K, nt = K / BK, LD = g.ld;
    unsigned voffA[2], voffB[2];
#pragma unroll
    for (int i = 0; i < 2; ++i) { int R, C; stage_rc(tid * 16 + i * 8192, R, C); const int Rb = Epi::PERM ? ((R & ~31) + perm32(R & 31)) : R;
        voffA[i] = (unsigned)(R * LD + C) * 2u; voffB[i] = (unsigned)(Rb * LD + C) * 2u; }
    const size_t kstep = (size_t)(BK * 2);
    const size_t hstep = (size_t)HALF * LD * 2;
    const size_t tstep = 2 * hstep;
    const unsigned ldsw = (unsigned)wid * 1024u;
    const int aoff = lds_byte(wr * 64 + fr, fq * 8), boff = lds_byte(wc * 32 + fr, fq * 8);
#define PG8_SA(b, h) (((b) * 2 + (h)) * HTB)
#define PG8_SB(b, h) ((4 + (b) * 2 + (h)) * HTB)
#define PG8_STAGE(bufoff, gbase, voff) do { _Pragma("unroll") for (int _i = 0; _i < 2; ++_i) \
        __builtin_amdgcn_global_load_lds((const unsigned*)((const char*)(gbase) + (voff)[_i]), (PG8_LAS unsigned*)(lds + (bufoff) + ldsw + _i * 8192), 16, 0, 0); } while (0)
#define PG8_LDA(dst, b, h) do { _Pragma("unroll") for (int m = 0; m < 4; ++m) _Pragma("unroll") for (int k = 0; k < 2; ++k) dst[m][k] = *(const PG8_LAS bf16x8*)(lds + PG8_SA(b, h) + aoff + m * 2048 + k * 1024); } while (0)
#define PG8_LDB(dst, b, h) do { _Pragma("unroll") for (int n = 0; n < 2; ++n) _Pragma("unroll") for (int k = 0; k < 2; ++k) dst[n][k] = *(const PG8_LAS bf16x8*)(lds + PG8_SB(b, h) + boff + n * 2048 + k * 1024); } while (0)
#define PG8_MMA(ai, bj, At, Bt) do { __builtin_amdgcn_s_setprio(1); _Pragma("unroll") for (int m = 0; m < 4; ++m) _Pragma("unroll") for (int n = 0; n < 2; ++n) _Pragma("unroll") for (int k = 0; k < 2; ++k) \
        acc[ai][bj][m][n] = __builtin_amdgcn_mfma_f32_16x16x32_bf16(Bt[n][k], At[m][k], acc[ai][bj][m][n], 0, 0, 0); __builtin_amdgcn_s_setprio(0); } while (0)
#define PG8_WAIT_V(n) asm volatile("s_waitcnt vmcnt(" #n ")" ::: "memory")
#define PG8_WAIT_L(n) asm volatile("s_waitcnt lgkmcnt(" #n ")" ::: "memory")
#define PG8_BAR __builtin_amdgcn_s_barrier()
#define PG8_SCHED __builtin_amdgcn_sched_barrier(0)
    Unit cur, nxt; int ui = 0;
    if (!S.next(0, cur)) return;
    f32x4 acc[2][2][4][2];
#pragma unroll
    for (int a = 0; a < 2; ++a)
#pragma unroll
        for (int b = 0; b < 2; ++b)
#pragma unroll
            for (int m = 0; m < 4; ++m)
#pragma unroll
                for (int n = 0; n < 2; ++n) acc[a][b][m][n] = (f32x4){0.f, 0.f, 0.f, 0.f};
    bf16x8 At[4][2], B0[2][2], B1[2][2];
    const char* cA = (const char*)g.A + (size_t)cur.pm * tstep + (size_t)cur.ko * 2; const char* cB = (const char*)g.Bt + (size_t)cur.pn * tstep + (size_t)cur.ko * 2;
    S.a_ready(cur);
    if constexpr (SP2) {
        PG8_STAGE(PG8_SB(0, 0), cB, voffB); PG8_STAGE(PG8_SB(0, 1), cB + hstep, voffB); PG8_STAGE(PG8_SA(0, 0), cA, voffA); PG8_STAGE(PG8_SA(0, 1), cA + hstep, voffA);
        if (wr == 1) PG8_BAR;
        PG8_WAIT_V(2); PG8_BAR;
        PG8_STAGE(PG8_SB(1, 0), cB + kstep, voffB); PG8_STAGE(PG8_SA(1, 0), cA + kstep, voffA); PG8_STAGE(PG8_SB(1, 1), cB + hstep + kstep, voffB);
        PG8_WAIT_V(6); PG8_BAR;
    } else {
        PG8_STAGE(PG8_SB(0, 0), cB, voffB); PG8_STAGE(PG8_SA(0, 0), cA, voffA); PG8_STAGE(PG8_SB(0, 1), cB + hstep, voffB); PG8_STAGE(PG8_SA(0, 1), cA + hstep, voffA);
        if (wr == 1) PG8_BAR;
        PG8_WAIT_V(4); PG8_BAR;
        PG8_STAGE(PG8_SB(1, 0), cB + kstep, voffB); PG8_STAGE(PG8_SA(1, 0), cA + kstep, voffA); PG8_STAGE(PG8_SB(1, 1), cB + hstep + kstep, voffB);
        PG8_WAIT_V(6); PG8_BAR;
    }
    for (;;) {
        const bool has_next = S.next(ui + 1, nxt);
        const char* nA = has_next ? (const char*)g.A + (size_t)nxt.pm * tstep + (size_t)nxt.ko * 2 : cA; const char* nB = has_next ? (const char*)g.Bt + (size_t)nxt.pn * tstep + (size_t)nxt.ko * 2 : cB;
        for (int t = 0; t < nt; t += 2) {
            const bool last = (t == nt - 2);
            const char* a1 = cA + (size_t)(t + 1) * kstep;
            const char* a2 = last ? nA : cA + (size_t)(t + 2) * kstep; const char* b2 = last ? nB : cB + (size_t)(t + 2) * kstep;
            const char* a3 = a2 + kstep; const char* b3 = b2 + kstep;
            if (last && has_next) S.a_ready(nxt);
            if constexpr (Epi::HAS_MID) { if (t == Epi::MID_T) E.mid(acc, cur, wr, wc, fr, fq); }
            if constexpr (SP2) {
            PG8_LDB(B0, 0, 0); PG8_LDB(B1, 0, 1); PG8_SCHED; PG8_LDA(At, 0, 0); PG8_STAGE(PG8_SA(1, 1), a1 + hstep, voffA);
            PG8_WAIT_V(8); PG8_WAIT_L(0); PG8_BAR; PG8_MMA(0, 0, At, B0); PG8_MMA(0, 1, At, B1); PG8_BAR; PG8_SCHED;
            PG8_LDA(At, 0, 1); PG8_STAGE(PG8_SB(0, 0), b2, voffB); PG8_STAGE(PG8_SB(0, 1), b2 + hstep, voffB); PG8_STAGE(PG8_SA(0, 0), a2, voffA);
            PG8_WAIT_V(8); PG8_WAIT_L(0); PG8_BAR; PG8_MMA(1, 0, At, B0); PG8_MMA(1, 1, At, B1); PG8_BAR; PG8_SCHED;
            PG8_LDB(B0, 1, 0); PG8_LDB(B1, 1, 1); PG8_SCHED; PG8_LDA(At, 1, 0); PG8_STAGE(PG8_SA(0, 1), a2 + hstep, voffA);
            PG8_WAIT_V(8); PG8_WAIT_L(0); PG8_BAR; PG8_MMA(0, 0, At, B0); PG8_MMA(0, 1, At, B1); PG8_BAR; PG8_SCHED;
            PG8_LDA(At, 1, 1); PG8_STAGE(PG8_SB(1, 0), b3, voffB); PG8_STAGE(PG8_SB(1, 1), b3 + hstep, voffB); PG8_STAGE(PG8_SA(1, 0), a3, voffA);
            PG8_WAIT_V(8); PG8_WAIT_L(0); PG8_BAR; PG8_MMA(1, 0, At, B0); PG8_MMA(1, 1, At, B1); PG8_BAR; PG8_SCHED;
            } else {
            PG8_LDB(B0, 0, 0); PG8_SCHED; PG8_LDA(At, 0, 0); PG8_STAGE(PG8_SA(1, 1), a1 + hstep, voffA);
            PG8_WAIT_L(8); PG8_BAR; PG8_WAIT_L(0); PG8_MMA(0, 0, At, B0); PG8_BAR; PG8_SCHED;
            PG8_LDB(B1, 0, 1); PG8_STAGE(PG8_SB(0, 0), b2, voffB);
            PG8_BAR; PG8_WAIT_L(0); PG8_MMA(0, 1, At, B1); PG8_BAR;
            PG8_LDA(At, 0, 1); PG8_STAGE(PG8_SA(0, 0), a2, voffA);
            PG8_BAR; PG8_WAIT_L(0); PG8_MMA(1, 0, At, B0); PG8_BAR; PG8_SCHED;
            PG8_STAGE(PG8_SB(0, 1), b2 + hstep, voffB);
            PG8_WAIT_V(6); PG8_BAR; PG8_MMA(1, 1, At, B1); PG8_BAR;
            PG8_LDB(B0, 1, 0); PG8_SCHED; PG8_LDA(At, 1, 0); PG8_STAGE(PG8_SA(0, 1), a2 + hstep, voffA);
            PG8_WAIT_L(8); PG8_BAR; PG8_WAIT_L(0); PG8_MMA(0, 0, At, B0); PG8_BAR; PG8_SCHED;
            PG8_LDB(B1, 1, 1); PG8_STAGE(PG8_SB(1, 0), b3, voffB);
            PG8_BAR; PG8_WAIT_L(0); PG8_MMA(0, 1, At, B1); PG8_BAR;
            PG8_LDA(At, 1, 1); PG8_STAGE(PG8_SA(1, 0), a3, voffA);
            PG8_BAR; PG8_WAIT_L(0); PG8_MMA(1, 0, At, B0); PG8_BAR; PG8_SCHED;
            PG8_STAGE(PG8_SB(1, 1), b3 + hstep, voffB);
            PG8_WAIT_V(6); PG8_BAR; PG8_MMA(1, 1, At, B1); PG8_BAR;
            }
        }
        if constexpr (ALIGN_EPI) { if (wr == 0) PG8_BAR; }
        if constexpr (!Epi::AFTER_DRAIN) { E(acc, cur, wr, wc, fr, fq); S.done(cur); }
        if (!has_next) break;
#pragma unroll
        for (int a = 0; a < 2; ++a)
#pragma unroll
            for (int b = 0; b < 2; ++b)
#pragma unroll
                for (int m = 0; m < 4; ++m)
#pragma unroll
                    for (int n = 0; n < 2; ++n) acc[a][b][m][n] = (f32x4){0.f, 0.f, 0.f, 0.f};
        cur = nxt; cA = nA; cB = nB; ++ui;
        if constexpr (ALIGN_EPI) { if (wr == 1) PG8_BAR; }
    }
    PG8_WAIT_V(0);
    if constexpr (!ALIGN_EPI) { if (wr == 0) PG8_BAR; }
    PG8_BAR;
    if constexpr (Epi::AFTER_DRAIN) { E.fused(acc, cur, wr, wc, fr, fq, lds, wid, lane); S.done(cur); }
#undef PG8_SA
#undef PG8_SB
#undef PG8_STAGE
#undef PG8_LDA
#undef PG8_LDB
#undef PG8_MMA
#undef PG8_WAIT_V
#undef PG8_WAIT_L
#undef PG8_BAR
#undef PG8_SCHED
}
}

using pg8::bf16_t; using pg8::bf16x8; using pg8::f32x4; using pg8::Unit;
#define LAS __attribute__((address_space(3)))
typedef unsigned u32x2 __attribute__((ext_vector_type(2)));
typedef unsigned u32x4 __attribute__((ext_vector_type(4)));
typedef float f32x16 __attribute__((ext_vector_type(16)));

constexpr int DM = 1024, NTP = 16384, MTOK = 17408, INW = 1536, DFF = 2816;
constexpr float EPSV = 1e-6f;
constexpr size_t O_Y = 0, O_PRE = 17825792, O_PIM = 17842176, O_PV = 17858560, O_SRE = 18382848, O_SIM = 18644992, O_SV = 18907136;
constexpr size_t W_ACT = 0, W_XH = 0, W_GBUF = 0, W_MIX = 35651584, W_PBUF = 71303168, W_X2B = 98041856;
constexpr size_t W_BTIN = 133693440, W_BTGLU = W_BTIN + 3145728, W_BTOUT = W_BTGLU + 524288, W_BTGU = W_BTOUT + 2097152, W_BTDN = W_BTGU + 11534336;
constexpr size_t W_ATAB = W_BTDN + 5767168, W_BBT = W_ATAB + 16384, W_CMT = W_BBT + 131072, W_WTP = W_CMT + 131072, W_WTS = W_WTP + 262144, W_RSS = W_WTS + 262144;
constexpr size_t W_BAR = W_RSS + 4 * 17408 * 4;
constexpr size_t W_X3B = W_BAR + 32768;
constexpr size_t W_PART = W_X3B + 33554432;
constexpr size_t W_END = W_PART + 11 * 4194304;
constexpr int LDS_BYTES = 131072 + 4096 + 256;

struct Params { const float* in[28]; float* out; unsigned char* ws; int ph_lo, ph_hi; };

__device__ __forceinline__ unsigned pk2(float lo, float hi) { unsigned r; asm volatile("v_cvt_pk_bf16_f32 %0, %1, %2" : "=v"(r) : "v"(lo), "v"(hi)); return r; }
__device__ __forceinline__ float bflo(unsigned w) { return __uint_as_float(w << 16); }
__device__ __forceinline__ float bfhi(unsigned w) { return __uint_as_float(w & 0xffff0000u); }
__device__ __forceinline__ float sigmoidf_(float z) { return __builtin_amdgcn_rcpf(1.0f + __builtin_amdgcn_exp2f(-1.4426950408889634f * z)); }
__device__ __forceinline__ float gelu_t(float x) { const float z = 1.5957691216057308f * (x + 0.044715f * x * x * x); return x * sigmoidf_(z); }
__device__ __forceinline__ float wave_sum(float v) {
#define WS_DPP(ctrl, rmask) v += __int_as_float(__builtin_amdgcn_update_dpp(0, __float_as_int(v), ctrl, rmask, 0xf, true))
    WS_DPP(0x111, 0xf); WS_DPP(0x112, 0xf); WS_DPP(0x114, 0xf); WS_DPP(0x118, 0xf); WS_DPP(0x142, 0xa); WS_DPP(0x143, 0xc);
#undef WS_DPP
    return __int_as_float(__builtin_amdgcn_readlane(__float_as_int(v), 63));
}
#define LDS_WAIT() asm volatile("s_waitcnt lgkmcnt(0)" ::: "memory")
__device__ __forceinline__ const float* xrow_ptr(const Params& p, int tok) { return tok < NTP ? p.in[0] + (size_t)tok * DM : p.in[1] + (size_t)(tok - NTP) * DM; }

struct EpiBase { bool dry = false; static constexpr bool PERM = false, AFTER_DRAIN = false, HAS_MID = false; static constexpr int MID_T = -1;
    __device__ __forceinline__ void mid(f32x4 (&)[2][2][4][2], const Unit&, int, int, int, int) const {} };

__device__ __forceinline__ void row_ss_add(float* rss, int row, float ss, int fq) {
    ss += __shfl_xor(ss, 16); ss += __shfl_xor(ss, 32);
    if (fq == 0) unsafeAtomicAdd(rss + row, ss);
}

struct EpiInProj : EpiBase {
    static constexpr bool PERM = true;
    bf16_t* P;
    __device__ __forceinline__ void operator()(const f32x4 (&acc)[2][2][4][2], const Unit& u, int wr, int wc, int fr, int fq) const {
        const int row0 = u.pm * 256 + wr * 64 + fr, col0 = u.pn * 256 + wc * 32 + 8 * fq; const bool act = u.pn >= 2;
#pragma unroll
        for (int ai = 0; ai < 2; ++ai)
#pragma unroll
            for (int m = 0; m < 4; ++m) { bf16_t* rowp = P + (size_t)(row0 + ai * 128 + m * 16) * INW + col0;
#pragma unroll
                for (int bj = 0; bj < 2; ++bj) { f32x4 v0 = acc[ai][bj][m][0], v1 = acc[ai][bj][m][1];
                    if (act) { v0[0] = gelu_t(v0[0]); v0[1] = gelu_t(v0[1]); v0[2] = gelu_t(v0[2]); v0[3] = gelu_t(v0[3]); v1[0] = gelu_t(v1[0]); v1[1] = gelu_t(v1[1]); v1[2] = gelu_t(v1[2]); v1[3] = gelu_t(v1[3]); }
                    u32x4 w; w.x = pk2(v0[0], v0[1]); w.y = pk2(v0[2], v0[3]); w.z = pk2(v1[0], v1[1]); w.w = pk2(v1[2], v1[3]); *(u32x4*)(rowp + bj * 128) = w; } }
    }
};
struct EpiGlu : EpiBase {
    static constexpr bool PERM = true;
    const bf16_t* G; bf16_t* MIX; const float* bglu; float* rss;
    __device__ __forceinline__ void operator()(const f32x4 (&acc)[2][2][4][2], const Unit& u, int wr, int wc, int fr, int fq) const {
        const int row0 = u.pm * 256 + wr * 64 + fr, col0 = u.pn * 256 + wc * 32 + 8 * fq;
        f32x4 bv[2][2];
#pragma unroll
        for (int bj = 0; bj < 2; ++bj)
#pragma unroll
            for (int n = 0; n < 2; ++n) bv[bj][n] = *(const f32x4*)(bglu + col0 + bj * 128 + n * 4);
#pragma unroll
        for (int ai = 0; ai < 2; ++ai) { u32x4 gw[4][2];
#pragma unroll
            for (int m = 0; m < 4; ++m)
#pragma unroll
                for (int bj = 0; bj < 2; ++bj) gw[m][bj] = *(const u32x4*)(G + (size_t)(row0 + ai * 128 + m * 16) * 512 + col0 + bj * 128);
#pragma unroll
            for (int m = 0; m < 4; ++m) { const int row = row0 + ai * 128 + m * 16; float ss = 0.f;
#pragma unroll
                for (int bj = 0; bj < 2; ++bj) { const f32x4 z0 = acc[ai][bj][m][0] + bv[bj][0], z1 = acc[ai][bj][m][1] + bv[bj][1]; const u32x4 g4 = gw[m][bj];
                    const float o0 = bflo(g4.x) * sigmoidf_(z0[0]), o1 = bfhi(g4.x) * sigmoidf_(z0[1]), o2 = bflo(g4.y) * sigmoidf_(z0[2]), o3 = bfhi(g4.y) * sigmoidf_(z0[3]);
                    const float o4 = bflo(g4.z) * sigmoidf_(z1[0]), o5 = bfhi(g4.z) * sigmoidf_(z1[1]), o6 = bflo(g4.w) * sigmoidf_(z1[2]), o7 = bfhi(g4.w) * sigmoidf_(z1[3]);
                    ss += (o0 * o0 + o1 * o1 + o2 * o2 + o3 * o3) + (o4 * o4 + o5 * o5 + o6 * o6 + o7 * o7);
                    u32x4 w; w.x = pk2(o0, o1); w.y = pk2(o2, o3); w.z = pk2(o4, o5); w.w = pk2(o6, o7); *(u32x4*)(MIX + (size_t)row * DM + col0 + bj * 128) = w; }
                if (!dry) row_ss_add(rss, row, ss, fq); } }
    }
};
struct EpiOutProj : EpiBase {
    static constexpr bool HAS_MID = true, PERM = true; static constexpr int MID_T = 8;
    const float* xp; const float* xs; bf16_t* X2B; float* rss2; const LAS float* fl; int pm0, pn0;
    __device__ __forceinline__ void mid(f32x4 (&acc)[2][2][4][2], const Unit& u, int wr, int wc, int fr, int fq) const {
        const LAS float* f0 = fl + ((u.pm == pm0 && u.pn == pn0) ? 0 : 256) + wr * 64 + fr;
#pragma unroll
        for (int ai = 0; ai < 2; ++ai)
#pragma unroll
            for (int m = 0; m < 4; ++m) { const float f = f0[ai * 128 + m * 16];
#pragma unroll
                for (int bj = 0; bj < 2; ++bj)
#pragma unroll
                    for (int n = 0; n < 2; ++n) acc[ai][bj][m][n] = acc[ai][bj][m][n] * f; }
    }
    __device__ __forceinline__ void operator()(const f32x4 (&acc)[2][2][4][2], const Unit& u, int wr, int wc, int fr, int fq) const {
        const int row0 = u.pm * 256 + wr * 64 + fr, col0 = u.pn * 256 + wc * 32 + 8 * fq;
        const LAS float* r0 = fl + 512 + ((u.pm == pm0 && u.pn == pn0) ? 0 : 256) + wr * 64 + fr;
        const float* xbase = row0 < NTP ? xp + (size_t)row0 * DM : xs + (size_t)(row0 - NTP) * DM;
#pragma unroll
        for (int ai = 0; ai < 2; ++ai) { f32x4 xv[4][2][2];
#pragma unroll
            for (int m = 0; m < 4; ++m)
#pragma unroll
                for (int bj = 0; bj < 2; ++bj)
#pragma unroll
                    for (int n = 0; n < 2; ++n) xv[m][bj][n] = *(const f32x4*)(xbase + (size_t)(ai * 128 + m * 16) * DM + col0 + bj * 128 + n * 4);
#pragma unroll
            for (int m = 0; m < 4; ++m) { const int row = row0 + ai * 128 + m * 16; float ss = 0.f; const float rc = r0[ai * 128 + m * 16];
#pragma unroll
                for (int bj = 0; bj < 2; ++bj) { const f32x4 v0 = xv[m][bj][0] + acc[ai][bj][m][0] * rc, v1 = xv[m][bj][1] + acc[ai][bj][m][1] * rc;
                    ss += (v0[0] * v0[0] + v0[1] * v0[1] + v0[2] * v0[2] + v0[3] * v0[3]) + (v1[0] * v1[0] + v1[1] * v1[1] + v1[2] * v1[2] + v1[3] * v1[3]);
                    u32x4 w; w.x = pk2(v0[0], v0[1]); w.y = pk2(v0[2], v0[3]); w.z = pk2(v1[0], v1[1]); w.w = pk2(v1[2], v1[3]); *(u32x4*)(X2B + (size_t)row * DM + col0 + bj * 128) = w; }
                if (!dry) row_ss_add(rss2, row, ss, fq); } }
    }
};
struct EpiGateUp : EpiBase {
    static constexpr bool PERM = true;
    bf16_t* ACT; const float* rss2;
    __device__ __forceinline__ void operator()(const f32x4 (&acc)[2][2][4][2], const Unit& u, int wr, int wc, int fr, int fq) const {
        const int row0 = u.pm * 256 + wr * 64 + fr, f0 = u.pn * 128 + wc * 32 + 8 * fq;
        float r2v[2][4];
#pragma unroll
        for (int ai = 0; ai < 2; ++ai)
#pragma unroll
            for (int m = 0; m < 4; ++m) r2v[ai][m] = rss2[row0 + ai * 128 + m * 16];
#pragma unroll
        for (int ai = 0; ai < 2; ++ai)
#pragma unroll
            for (int m = 0; m < 4; ++m) { const int row = row0 + ai * 128 + m * 16; const float r2 = rsqrtf(r2v[ai][m] * (1.f / 1024.f) + EPSV); float o[8];
#pragma unroll
                for (int n = 0; n < 2; ++n) { const f32x4 g = acc[ai][0][m][n] * r2, up = acc[ai][1][m][n] * r2;
#pragma unroll
                    for (int j = 0; j < 4; ++j) o[4 * n + j] = g[j] * sigmoidf_(g[j]) * up[j]; }
                u32x4 w; w.x = pk2(o[0], o[1]); w.y = pk2(o[2], o[3]); w.z = pk2(o[4], o[5]); w.w = pk2(o[6], o[7]); *(u32x4*)(ACT + (size_t)row * DFF + f0) = w; }
    }
};
struct EpiDown : EpiBase {
    static constexpr bool PERM = true;
    const bf16_t* X2B; bf16_t* X3B;
    __device__ __forceinline__ void operator()(const f32x4 (&acc)[2][2][4][2], const Unit& u, int wr, int wc, int fr, int fq) const {
        const int row0 = u.pm * 256 + wr * 64 + fr, col0 = u.pn * 256 + wc * 32 + 8 * fq;
#pragma unroll
        for (int ai = 0; ai < 2; ++ai) { u32x4 xv[4][2];
#pragma unroll
            for (int m = 0; m < 4; ++m)
#pragma unroll
                for (int bj = 0; bj < 2; ++bj) xv[m][bj] = *(const u32x4*)(X2B + (size_t)(row0 + ai * 128 + m * 16) * DM + col0 + bj * 128);
#pragma unroll
            for (int m = 0; m < 4; ++m) { const int row = row0 + ai * 128 + m * 16;
#pragma unroll
                for (int bj = 0; bj < 2; ++bj) { const f32x4 a0 = acc[ai][bj][m][0], a1 = acc[ai][bj][m][1]; const u32x4 x = xv[m][bj];
                    u32x4 w; w.x = pk2(bflo(x.x) + a0[0], bfhi(x.x) + a0[1]); w.y = pk2(bflo(x.y) + a0[2], bfhi(x.y) + a0[3]); w.z = pk2(bflo(x.z) + a1[0], bfhi(x.z) + a1[1]); w.w = pk2(bflo(x.w) + a1[2], bfhi(x.w) + a1[3]);
                    *(u32x4*)(X3B + (size_t)row * DM + col0 + bj * 128) = w; } } }
    }
};
struct EpiDownPart : EpiBase {
    static constexpr bool PERM = true;
    bf16_t* PART;
    __device__ __forceinline__ void operator()(const f32x4 (&acc)[2][2][4][2], const Unit& u, int wr, int wc, int fr, int fq) const {
        const int row0 = (u.pm - 64) * 256 + wr * 64 + fr, col0 = u.pn * 256 + wc * 32 + 8 * fq; bf16_t* base = PART + (size_t)(u.ko >> 8) * 1048576;
#pragma unroll
        for (int ai = 0; ai < 2; ++ai)
#pragma unroll
            for (int m = 0; m < 4; ++m)
#pragma unroll
                for (int bj = 0; bj < 2; ++bj) { const f32x4 a0 = acc[ai][bj][m][0], a1 = acc[ai][bj][m][1];
                    u32x4 w; w.x = pk2(a0[0], a0[1]); w.y = pk2(a0[2], a0[3]); w.z = pk2(a1[0], a1[1]); w.w = pk2(a1[2], a1[3]);
                    *(u32x4*)(base + (size_t)(row0 + ai * 128 + m * 16) * DM + col0 + bj * 128) = w; }
    }
};

__device__ __forceinline__ void p0_transpose_item(const float* W, int K, int N, bf16_t* WT, int mode, int bjoff, const float* ks1, const float* ks2, int ksplit, LAS float* scr, int item, int lane) {
    const int nblk = N / 32, kb = item / nblk, nb = item % nblk, k0 = 64 * kb, n0 = 32 * nb;
    const int r8 = lane >> 3, c4 = lane & 7;
#pragma unroll
    for (int i = 0; i < 8; ++i) { const int kk = 8 * i + r8, k = k0 + kk; float sc = 1.f; if (ks1) sc = k < ksplit ? ks1[k] : ks2[k - ksplit];
        const f32x4 v = *(const f32x4*)(W + (size_t)k * N + n0 + 4 * c4);
        LAS float* d = scr + kk * 33 + 4 * c4; d[0] = v[0] * sc; d[1] = v[1] * sc; d[2] = v[2] * sc; d[3] = v[3] * sc; }
    LDS_WAIT();
    const int c = lane & 7;
#pragma unroll
    for (int j = 0; j < 4; ++j) { const int n = (lane >> 3) + 8 * j; const LAS float* s = scr + (8 * c) * 33 + n; const int nn = n0 + n;
        const int row = mode ? (((nn >> 7) << 8) + bjoff + (nn & 127)) : nn;
        u32x4 o; o.x = pk2(s[0 * 33], s[1 * 33]); o.y = pk2(s[2 * 33], s[3 * 33]); o.z = pk2(s[4 * 33], s[5 * 33]); o.w = pk2(s[6 * 33], s[7 * 33]);
        *(u32x4*)(WT + (size_t)row * K + k0 + 8 * c) = o; }
    LDS_WAIT();
}

__device__ __forceinline__ void phase0(const Params& p, LAS unsigned char* lds) {
    const int tid = threadIdx.x, lane = tid & 63, wave = tid >> 6;
    const int gw = blockIdx.x * 8 + wave, NGW = gridDim.x * 8;
    unsigned char* ws = p.ws;
    {   bf16_t* XH = (bf16_t*)(ws + W_XH); const f32x4* g4 = (const f32x4*)p.in[4] + 2 * lane; f32x4 gg[2][2];
#pragma unroll
        for (int j = 0; j < 2; ++j) { gg[j][0] = g4[128 * j]; gg[j][1] = g4[128 * j + 1]; }
        for (int tok = gw; tok < MTOK; tok += 2 * NGW) { const int tok2 = tok + NGW < MTOK ? tok + NGW : tok;
            const f32x4* xr = (const f32x4*)xrow_ptr(p, tok) + 2 * lane; const f32x4* xr2 = (const f32x4*)xrow_ptr(p, tok2) + 2 * lane; f32x4 v[2][2], v2[2][2]; float s = 0.f, s2 = 0.f;
#pragma unroll
            for (int j = 0; j < 2; ++j) { v[j][0] = xr[128 * j]; v[j][1] = xr[128 * j + 1]; v2[j][0] = xr2[128 * j]; v2[j][1] = xr2[128 * j + 1]; }
#pragma unroll
            for (int j = 0; j < 2; ++j)
#pragma unroll
                for (int e = 0; e < 2; ++e) { const f32x4 a = v[j][e], c = v2[j][e]; s += (a[0] * a[0] + a[1] * a[1]) + (a[2] * a[2] + a[3] * a[3]); s2 += (c[0] * c[0] + c[1] * c[1]) + (c[2] * c[2] + c[3] * c[3]); }
            const float r = rsqrtf(wave_sum(s) * (1.f / 1024.f) + EPSV), r2 = rsqrtf(wave_sum(s2) * (1.f / 1024.f) + EPSV);
            u32x4* o16 = (u32x4*)(XH + (size_t)tok * DM) + lane; u32x4* o162 = (u32x4*)(XH + (size_t)tok2 * DM) + lane;
#pragma unroll
            for (int j = 0; j < 2; ++j) { const f32x4 g0 = gg[j][0], g1 = gg[j][1]; const f32x4 a0 = v[j][0] * r * g0, a1 = v[j][1] * r * g1, c0 = v2[j][0] * r2 * g0, c1 = v2[j][1] * r2 * g1;
                u32x4 w; w.x = pk2(a0[0], a0[1]); w.y = pk2(a0[2], a0[3]); w.z = pk2(a1[0], a1[1]); w.w = pk2(a1[2], a1[3]); o16[64 * j] = w;
                u32x4 w2; w2.x = pk2(c0[0], c0[1]); w2.y = pk2(c0[2], c0[3]); w2.z = pk2(c1[0], c1[1]); w2.w = pk2(c1[2], c1[3]); o162[64 * j] = w2; } }
    }
    {   LAS float* scr = (LAS float*)(lds + wave * 8448);
        constexpr int I_IN = 16 * 48, I_GLU = 8 * 16, I_OUT = 16 * 32, NIT = I_IN + I_GLU + I_OUT;
        for (int it = gw; it < NIT; it += NGW) { int r = it;
            if (r < I_IN) { p0_transpose_item(p.in[5], 1024, 1536, (bf16_t*)(ws + W_BTIN), 0, 0, nullptr, nullptr, 0, scr, r, lane); continue; } r -= I_IN;
            if (r < I_GLU) { p0_transpose_item(p.in[14], 512, 512, (bf16_t*)(ws + W_BTGLU), 0, 0, nullptr, nullptr, 0, scr, r, lane); continue; } r -= I_GLU;
            p0_transpose_item(p.in[22], 1024, 1024, (bf16_t*)(ws + W_BTOUT), 0, 0, p.in[20], p.in[21], 512, scr, r, lane); }
    }
    const int gt = blockIdx.x * 512 + tid, NGT = gridDim.x * 512;
    const int gtr = ((int)gridDim.x - 1 - (int)blockIdx.x) * 512 + tid;
    for (int id8 = gtr; id8 < 16384; id8 += NGT) { const int idx = id8 >> 3, i = 2 * (id8 & 7), g = idx >> 6;
        const float dt = expf(p.in[8][g]), lr = p.in[6][idx], li = p.in[7][idx];
        const float mag = expf(lr * dt), ar = mag * cosf(li * dt), ai = mag * sinf(li * dt), den = lr * lr + li * li;
        const float qr = ((ar - 1.0f) * lr + ai * li) / den, qi = (ai * lr - (ar - 1.0f) * li) / den;
        if (i == 0) { float* AT = (float*)(ws + W_ATAB); AT[idx * 2] = ar; AT[idx * 2 + 1] = ai; }
        bf16_t* BB = (bf16_t*)(ws + W_BBT); const int n = idx & 63;
        const float br0 = p.in[9][idx * 16 + i], bi0 = p.in[10][idx * 16 + i], br1 = p.in[9][idx * 16 + i + 1], bi1 = p.in[10][idx * 16 + i + 1];
        *(unsigned*)(BB + ((size_t)(g * 2 + 0) * 64 + n) * 16 + i) = pk2(qr * br0 - qi * bi0, qr * br1 - qi * bi1);
        *(unsigned*)(BB + ((size_t)(g * 2 + 1) * 64 + n) * 16 + i) = pk2(qr * bi0 + qi * br0, qr * bi1 + qi * br1); }
    for (int idx = gtr; idx < 32768; idx += NGT) { const int g = idx >> 10, o = (idx >> 6) & 15, kp = (idx & 63) * 2;
        const int c5 = kp >> 2, e = kp & 3; const size_t base = ((size_t)(g * 16 + o)) * 64;
        float v0, v1; if (e == 0) { v0 = p.in[11][base + c5]; v1 = p.in[11][base + c5 + 32]; } else { v0 = -p.in[12][base + c5]; v1 = -p.in[12][base + c5 + 32]; }
        *(unsigned*)((bf16_t*)(ws + W_CMT) + ((size_t)(g * 16 + o)) * 128 + kp) = pk2(v0, v1); }
    for (int idx = gt; idx < 131072; idx += NGT) { const int which = idx >> 16, h = (idx >> 13) & 7, t = (idx >> 6) & 127, s = (idx & 63) * 2; const float* wsr = p.in[18] + (size_t)h * 16384;
        float v0, v1;
        if (which == 0) { v0 = s <= t ? wsr[t * 128 + s] : 0.f; v1 = (s + 1) <= t ? wsr[t * 128 + s + 1] : 0.f; }
        else { const bool same = (t >> 3) == (s >> 3); const int tt = t & 7, s0 = s & 7; v0 = (same && s0 <= tt) ? wsr[tt * 128 + s0] : 0.f; v1 = (same && (s0 + 1) <= tt) ? wsr[tt * 128 + s0 + 1] : 0.f; }
        *(unsigned*)((bf16_t*)(ws + (which ? W_WTS : W_WTP)) + (size_t)h * 16384 + t * 128 + s) = pk2(v0, v1); }
    for (int idx = gtr; idx < 4 * MTOK; idx += NGT) __hip_atomic_store((unsigned*)(ws + W_RSS) + idx, 0u, __ATOMIC_RELAXED, __HIP_MEMORY_SCOPE_AGENT);
}

__device__ __forceinline__ void p3_transposes(const Params& p, LAS unsigned char* lds, int first_idle) {
    const int tid = threadIdx.x, lane = tid & 63, wave = tid >> 6;
    if ((int)blockIdx.x < first_idle) return;
    const int gw = ((int)blockIdx.x - first_idle) * 8 + wave, NGW = ((int)gridDim.x - first_idle) * 8;
    unsigned char* ws = p.ws; LAS float* scr = (LAS float*)(lds + wave * 8448);
    constexpr int I_G = 16 * 88, I_DN = 44 * 32, NIT = 2 * I_G + I_DN;
    for (int it = gw; it < NIT; it += NGW) { int r = it;
        if (r < I_G) { p0_transpose_item(p.in[24], 1024, 2816, (bf16_t*)(ws + W_BTGU), 1, 0, p.in[23], p.in[23], 1024, scr, r, lane); continue; } r -= I_G;
        if (r < I_G) { p0_transpose_item(p.in[25], 1024, 2816, (bf16_t*)(ws + W_BTGU), 1, 128, p.in[23], p.in[23], 1024, scr, r, lane); continue; } r -= I_G;
        p0_transpose_item(p.in[26], 2816, 1024, (bf16_t*)(ws + W_BTDN), 0, 0, nullptr, nullptr, 0, scr, r, lane); }
}

constexpr int HT_STRIDE = 272, HT_WAVE = 32 * HT_STRIDE, SSEG_OFF = 8 * HT_WAVE;
struct S5Ctx { bf16x8 Bf[4]; bf16x8 Cf[4]; float ar0, ai0, ar1, ai1; float dsk[4]; };

__device__ __forceinline__ bf16x8 s5_load_a(const bf16_t* P, int g, int tokA, int tokB, int lane) {
    const int rho = lane & 31, half = (rho >> 2) & 1, r = 4 * (rho >> 3) + (rho & 3);
    const int tok = (half ? tokB : tokA) + r;
    return *(const bf16x8*)(P + (size_t)tok * INW + g * 16 + 8 * (lane >> 5));
}
__device__ __forceinline__ void s5_bu(const bf16x8 a, const S5Ctx& c, f32x16 (&acc)[4]) {
#pragma unroll
    for (int j = 0; j < 4; ++j) { f32x16 z;
#pragma unroll
        for (int i = 0; i < 16; ++i) z[i] = 0.f;
        acc[j] = __builtin_amdgcn_mfma_f32_32x32x16_bf16(a, c.Bf[j], z, 0, 0, 0); }
}
#define S5_STEP(r) do { const float nr0 = c.ar0 * hr0 - c.ai0 * hi0 + acc[0][r], ni0 = c.ar0 * hi0 + c.ai0 * hr0 + acc[2][r]; \
        const float nr1 = c.ar1 * hr1 - c.ai1 * hi1 + acc[1][r], ni1 = c.ar1 * hi1 + c.ai1 * hr1 + acc[3][r]; hr0 = nr0; hi0 = ni0; hr1 = nr1; hi1 = ni1; } while (0)

__device__ __forceinline__ u32x2 s5_load_x(const bf16_t* P, int g, int tok0, int lane) { return *(const u32x2*)(P + (size_t)(tok0 + (lane & 15)) * INW + g * 16 + 4 * (lane >> 4)); }
__device__ __forceinline__ void s5_y(bf16_t* GB, const S5Ctx& c, int g, int tokA, int tokB, int lane, LAS unsigned char* ht, const u32x2 xwA, const u32x2 xwB, bool nostore = false) {
    const int cc = lane & 15, q = lane >> 4;
#pragma unroll
    for (int t16 = 0; t16 < 2; ++t16) { f32x4 y = {0.f, 0.f, 0.f, 0.f};
#pragma unroll
        for (int ks = 0; ks < 4; ++ks) { const bf16x8 b = *(const LAS bf16x8*)(ht + (16 * t16 + cc) * HT_STRIDE + 64 * ks + 16 * q);
            y = __builtin_amdgcn_mfma_f32_16x16x32_bf16(c.Cf[ks], b, y, 0, 0, 0); }
        const int tok = (t16 ? tokB : tokA) + cc; const u32x2 xw = t16 ? xwB : xwA;
        const float o0 = gelu_t(y[0] + c.dsk[0] * bflo(xw.x)), o1 = gelu_t(y[1] + c.dsk[1] * bfhi(xw.x)), o2 = gelu_t(y[2] + c.dsk[2] * bflo(xw.y)), o3 = gelu_t(y[3] + c.dsk[3] * bfhi(xw.y));
        u32x2 w; w.x = pk2(o0, o1); w.y = pk2(o2, o3); if (!nostore) *(u32x2*)(GB + (size_t)tok * 512 + g * 16 + 4 * q) = w; }
}
__device__ __forceinline__ void s5_load_ctx(const Params& p, S5Ctx& c, int g, int lane) {
    const unsigned char* ws = p.ws; const int c5 = lane & 31, hh = lane >> 5;
    const float* AT = (const float*)(ws + W_ATAB) + (size_t)g * 128; c.ar0 = AT[c5 * 2]; c.ai0 = AT[c5 * 2 + 1]; c.ar1 = AT[(c5 + 32) * 2]; c.ai1 = AT[(c5 + 32) * 2 + 1];
    const bf16_t* BB = (const bf16_t*)(ws + W_BBT);
#pragma unroll
    for (int j = 0; j < 4; ++j) c.Bf[j] = *(const bf16x8*)(BB + ((size_t)(g * 2 + (j >> 1)) * 64 + 32 * (j & 1) + c5) * 16 + 8 * hh);
    const bf16_t* CM = (const bf16_t*)(ws + W_CMT) + ((size_t)(g * 16 + (lane & 15))) * 128;
#pragma unroll
    for (int ks = 0; ks < 4; ++ks) c.Cf[ks] = *(const bf16x8*)(CM + 32 * ks + 8 * (lane >> 4));
#pragma unroll
    for (int j = 0; j < 4; ++j) c.dsk[j] = p.in[13][g * 16 + 4 * (lane >> 4) + j];
}
#define S5_WRITE(r) do { u32x2 w; w.x = pk2(hr0, hr1); w.y = pk2(hi0, hi1); *(LAS u32x2*)(ht + (16 * hh + (r)) * HT_STRIDE + 8 * c5) = w; } while (0)

__device__ __forceinline__ void s5_prompt_item(const Params& p, int item, LAS unsigned char* lds, bool dryA = false, bool dryB = false) {
    const int tid = threadIdx.x, lane = tid & 63, wave = tid >> 6, c5 = lane & 31, hh = lane >> 5;
    const int slot = item >> 3, g = 4 * (item & 7) + (slot & 3), b = slot >> 2, seqbase = b * 2048;
    const bf16_t* P = (const bf16_t*)(p.ws + W_PBUF); bf16_t* GB = (bf16_t*)(p.ws + W_GBUF);
    S5Ctx c; s5_load_ctx(p, c, g, lane);
    LAS unsigned char* ht = lds + wave * HT_WAVE; LAS float* sseg = (LAS float*)(lds + SSEG_OFF);
    float hr0 = 0.f, hi0 = 0.f, hr1 = 0.f, hi1 = 0.f; f32x16 acc[4];
    const int tbase = seqbase + 256 * wave;
    bf16x8 acur = s5_load_a(P, g, tbase, tbase + 128, lane);
    for (int tile = 0; tile < 8; ++tile) { const int tn = tile < 7 ? tile + 1 : 7; const bf16x8 anext = s5_load_a(P, g, tbase + 16 * tn, tbase + 16 * tn + 128, lane);
        s5_bu(acur, c, acc); acur = anext;
#pragma unroll
        for (int r = 0; r < 16; ++r) S5_STEP(r); }
    const int seg = 2 * wave + hh;
    sseg[(seg * 64 + c5) * 2] = hr0; sseg[(seg * 64 + c5) * 2 + 1] = hi0; sseg[(seg * 64 + c5 + 32) * 2] = hr1; sseg[(seg * 64 + c5 + 32) * 2 + 1] = hi1;
    float pr0 = c.ar0, pi0 = c.ai0, pr1 = c.ar1, pi1 = c.ai1;
#pragma unroll
    for (int i = 0; i < 7; ++i) { const float t0 = pr0 * pr0 - pi0 * pi0, u0 = 2.f * pr0 * pi0, t1 = pr1 * pr1 - pi1 * pi1, u1 = 2.f * pr1 * pi1; pr0 = t0; pi0 = u0; pr1 = t1; pi1 = u1; }
    __syncthreads();
    hr0 = hi0 = hr1 = hi1 = 0.f;
    for (int j = 0; j < seg; ++j) { const float s0r = sseg[(j * 64 + c5) * 2], s0i = sseg[(j * 64 + c5) * 2 + 1], s1r = sseg[(j * 64 + c5 + 32) * 2], s1i = sseg[(j * 64 + c5 + 32) * 2 + 1];
        const float nr0 = pr0 * hr0 - pi0 * hi0 + s0r, ni0 = pr0 * hi0 + pi0 * hr0 + s0i, nr1 = pr1 * hr1 - pi1 * hi1 + s1r, ni1 = pr1 * hi1 + pi1 * hr1 + s1i; hr0 = nr0; hi0 = ni0; hr1 = nr1; hi1 = ni1; }
    acur = s5_load_a(P, g, tbase, tbase + 128, lane);
    for (int tile = 0; tile < 8; ++tile) { const int tokA = tbase + 16 * tile, tokB = tokA + 128; const int tn = tile < 7 ? tile + 1 : 7;
        const bf16x8 anext = s5_load_a(P, g, tbase + 16 * tn, tbase + 16 * tn + 128, lane);
        const u32x2 xwA = s5_load_x(P, g, tokA, lane), xwB = s5_load_x(P, g, tokB, lane);
        s5_bu(acur, c, acc); acur = anext;
#pragma unroll
        for (int r = 0; r < 16; ++r) { S5_STEP(r); S5_WRITE(r); }
        LDS_WAIT();
        s5_y(GB, c, g, tokA, tokB, lane, ht, xwA, xwB, dryA);
        LDS_WAIT(); }
    if (seg == 15 && !dryB) { float* ore = p.out + O_PRE + (size_t)(b * 32 + g) * 64; float* oim = p.out + O_PIM + (size_t)(b * 32 + g) * 64;
        ore[c5] = hr0; ore[c5 + 32] = hr1; oim[c5] = hi0; oim[c5 + 32] = hi1; }
    __syncthreads();
}
__device__ __forceinline__ void s5_sample_item(const Params& p, int item, LAS unsigned char* lds) {
    const int tid = threadIdx.x, lane = tid & 63, wave = tid >> 6, c5 = lane & 31, hh = lane >> 5;
    const int g = 4 * (item & 7) + ((item >> 3) & 3), qq = item >> 5;
    const bf16_t* P = (const bf16_t*)(p.ws + W_PBUF); bf16_t* GB = (bf16_t*)(p.ws + W_GBUF);
    S5Ctx c; s5_load_ctx(p, c, g, lane);
    LAS unsigned char* ht = lds + wave * HT_WAVE;
    const int b0 = 32 * qq + 4 * wave, tokA = NTP + 8 * b0, tokB = tokA + 16, bA = b0 + 2 * hh;
    float hr0, hi0, hr1, hi1; f32x16 acc[4];
    const u32x2 xwA = s5_load_x(P, g, tokA, lane), xwB = s5_load_x(P, g, tokB, lane);
    s5_bu(s5_load_a(P, g, tokA, tokB, lane), c, acc);
#pragma unroll
    for (int half = 0; half < 2; ++half) { const size_t so = ((size_t)(bA + half) * 32 + g) * 64;
        hr0 = p.in[2][so + c5]; hr1 = p.in[2][so + c5 + 32]; hi0 = p.in[3][so + c5]; hi1 = p.in[3][so + c5 + 32];
#pragma unroll
        for (int r8 = 0; r8 < 8; ++r8) { S5_STEP(half * 8 + r8); S5_WRITE(half * 8 + r8); }
        p.out[O_SRE + so + c5] = hr0; p.out[O_SRE + so + c5 + 32] = hr1; p.out[O_SIM + so + c5] = hi0; p.out[O_SIM + so + c5 + 32] = hi1; }
    LDS_WAIT();
    s5_y(GB, c, g, tokA, tokB, lane, ht, xwA, xwB);
    LDS_WAIT();
    __syncthreads();
}

__device__ __forceinline__ void cm_item(const Params& p, int item, LAS unsigned char* lds, bool dry) {
    const int tid = threadIdx.x, lane = tid & 63, wave = tid >> 6;
    const bool sample = item >= 128; int tok0; float* vout = nullptr; const bf16_t* WT; int tmask;
    if (!sample) { const int b = item >> 4, cidx = item & 15; tok0 = b * 2048 + 128 * cidx; if (cidx == 15) vout = p.out + O_PV + (size_t)b * 128 * 512; WT = (const bf16_t*)(p.ws + W_WTP); tmask = 127; }
    else { const int j = item - 128; tok0 = NTP + 128 * j; vout = p.out + O_SV + (size_t)j * 128 * 512; WT = (const bf16_t*)(p.ws + W_WTS); tmask = 7; }
    const bf16_t* P = (const bf16_t*)(p.ws + W_PBUF); bf16_t* MIX = (bf16_t*)(p.ws + W_MIX); float* rss_cm = (float*)(p.ws + W_RSS) + MTOK;
    {   float lg[8], lb[8];
#pragma unroll
        for (int j = 0; j < 8; ++j) { lg[j] = p.in[16][8 * lane + j]; lb[j] = p.in[17][8 * lane + j]; }
        u32x4 rawv[16];
#pragma unroll
        for (int i = 0; i < 16; ++i) rawv[i] = *(const u32x4*)(P + (size_t)(tok0 + 16 * wave + i) * INW + 1024 + 8 * lane);
#pragma unroll
        for (int i = 0; i < 8; ++i) { const int s = 16 * wave + 2 * i; float v[2][8];
#pragma unroll
            for (int e = 0; e < 2; ++e) { const u32x4 raw = rawv[2 * i + e];
                v[e][0] = bflo(raw.x); v[e][1] = bfhi(raw.x); v[e][2] = bflo(raw.y); v[e][3] = bfhi(raw.y); v[e][4] = bflo(raw.z); v[e][5] = bfhi(raw.z); v[e][6] = bflo(raw.w); v[e][7] = bfhi(raw.w);
                float sm = 0.f;
#pragma unroll
                for (int j = 0; j < 8; ++j) sm += v[e][j];
                const float mu = wave_sum(sm) * (1.f / 512.f); float s2 = 0.f;
#pragma unroll
                for (int j = 0; j < 8; ++j) { v[e][j] -= mu; s2 += v[e][j] * v[e][j]; }
                const float rs = rsqrtf(wave_sum(s2) * (1.f / 512.f) + EPSV);
#pragma unroll
                for (int j = 0; j < 8; ++j) v[e][j] = v[e][j] * rs * lg[j] + lb[j];
                if (vout) { float* vo = vout + (size_t)(s + e) * 512 + 8 * lane; *(f32x4*)vo = (f32x4){v[e][0], v[e][1], v[e][2], v[e][3]}; *(f32x4*)(vo + 4) = (f32x4){v[e][4], v[e][5], v[e][6], v[e][7]}; } }
            const int chunk = (s >> 3) ^ (lane & 15);
#pragma unroll
            for (int j = 0; j < 8; ++j) *(LAS unsigned*)(lds + (8 * lane + j) * 256 + chunk * 16 + (s & 7) * 2) = pk2(v[0][j], v[1][j]); }
    }
    __syncthreads();
    {   const int h = wave, cc = lane & 15, q = lane >> 4;
        bf16x8 Af[4][4];
#pragma unroll
        for (int dt = 0; dt < 4; ++dt)
#pragma unroll
            for (int ks = 0; ks < 4; ++ks) { const int d = 64 * h + 32 * (dt >> 1) + 8 * (cc >> 2) + 4 * (dt & 1) + (cc & 3);
                Af[dt][ks] = *(const LAS bf16x8*)(lds + d * 256 + (((4 * ks + q) ^ ((d >> 3) & 15)) * 16)); }
        const bf16_t* Wh = WT + (size_t)h * 16384; const float* bs = p.in[19] + h * 128;
        bf16x8 bwN[4]; u32x4 uwN[2]; float biasN;
#define CM_LOAD(tt_) do { const int t_ = 16 * (tt_) + cc; \
            _Pragma("unroll") for (int ks = 0; ks < 4; ++ks) if (ks <= ((tt_) >> 1)) bwN[ks] = *(const bf16x8*)(Wh + t_ * 128 + 32 * ks + 8 * q); \
            _Pragma("unroll") for (int k2 = 0; k2 < 2; ++k2) uwN[k2] = *(const u32x4*)(P + (size_t)(tok0 + t_) * INW + 512 + 64 * h + 32 * k2 + 8 * q); \
            biasN = bs[t_ & tmask]; } while (0)
        CM_LOAD(0);
#pragma unroll
        for (int tt = 0; tt < 8; ++tt) { const int t = 16 * tt + cc; f32x4 acc[4]; bf16x8 bw[4]; u32x4 uw[2];
#pragma unroll
            for (int ks = 0; ks < 4; ++ks) bw[ks] = bwN[ks];
#pragma unroll
            for (int k2 = 0; k2 < 2; ++k2) uw[k2] = uwN[k2];
            const float bias = biasN;
            if (tt < 7) CM_LOAD(tt + 1);
#pragma unroll
            for (int dt = 0; dt < 4; ++dt) acc[dt] = (f32x4){0.f, 0.f, 0.f, 0.f};
#pragma unroll
            for (int ks = 0; ks < 4; ++ks) if (ks <= (tt >> 1)) {
#pragma unroll
                for (int dt = 0; dt < 4; ++dt) acc[dt] = __builtin_amdgcn_mfma_f32_16x16x32_bf16(Af[dt][ks], bw[ks], acc[dt], 0, 0, 0); }
            float ss = 0.f; const size_t tok = (size_t)(tok0 + t);
#pragma unroll
            for (int k2 = 0; k2 < 2; ++k2) { const int d = 64 * h + 32 * k2 + 8 * q; const f32x4 a0 = acc[2 * k2], a1 = acc[2 * k2 + 1]; const u32x4 u4 = uw[k2];
                const float o0 = bflo(u4.x) * (a0[0] + bias), o1 = bfhi(u4.x) * (a0[1] + bias), o2 = bflo(u4.y) * (a0[2] + bias), o3 = bfhi(u4.y) * (a0[3] + bias);
                const float o4 = bflo(u4.z) * (a1[0] + bias), o5 = bfhi(u4.z) * (a1[1] + bias), o6 = bflo(u4.w) * (a1[2] + bias), o7 = bfhi(u4.w) * (a1[3] + bias);
                ss += (o0 * o0 + o1 * o1 + o2 * o2 + o3 * o3) + (o4 * o4 + o5 * o5 + o6 * o6 + o7 * o7);
                u32x4 w; w.x = pk2(o0, o1); w.y = pk2(o2, o3); w.z = pk2(o4, o5); w.w = pk2(o6, o7); *(u32x4*)(MIX + tok * DM + 512 + d) = w; }
            ss += __shfl_xor(ss, 16); ss += __shfl_xor(ss, 32);
            if (q == 0 && !dry) unsafeAtomicAdd(rss_cm + tok0 + t, ss);
            asm volatile("" ::: "memory"); }
#undef CM_LOAD
    }
    __syncthreads();
}

__device__ __forceinline__ void phase2(const Params& p, LAS unsigned char* lds, bool dry = false, int mask = 7) {
    for (int it = blockIdx.x; it < 256 + 128 + 136; it += gridDim.x) {
        if (it < 256) { if (mask & 1) s5_prompt_item(p, it, lds, dry && (PROBE_VAR & 1), dry && (PROBE_VAR & 2)); }
        else if (it < 392) { if (mask & 2) cm_item(p, it - 256, lds, dry); }
        else { if (mask & 4) s5_sample_item(p, it - 392, lds); }
    }
}
__device__ __forceinline__ void phase7(const Params& p, bool dry = false) {
    const int tid = threadIdx.x, lane = tid & 63, wave = tid >> 6, gw = blockIdx.x * 8 + wave, NGW = gridDim.x * 8;
    const f32x4* nf = (const f32x4*)p.in[27] + 2 * lane; const bf16_t* X3B = (const bf16_t*)(p.ws + W_X3B); const bf16_t* X2B = (const bf16_t*)(p.ws + W_X2B); const bf16_t* PART = (const bf16_t*)(p.ws + W_PART);
    f32x4 g[2][2];
#pragma unroll
    for (int j = 0; j < 2; ++j) { g[j][0] = nf[128 * j]; g[j][1] = nf[128 * j + 1]; }
    for (int q = gw; q < NTP + 2 * (MTOK - NTP); q += NGW) { if (q >= NTP && ((q - NTP) & 1)) continue;
        const int tok = q < NTP ? q : NTP + ((q - NTP) >> 1); f32x4 v[2][2];
        const u32x4* src = (const u32x4*)((tok < NTP ? X3B : X2B) + (size_t)tok * DM) + lane;
#pragma unroll
        for (int j = 0; j < 2; ++j) { const u32x4 w = src[64 * j]; v[j][0] = (f32x4){bflo(w.x), bfhi(w.x), bflo(w.y), bfhi(w.y)}; v[j][1] = (f32x4){bflo(w.z), bfhi(w.z), bflo(w.w), bfhi(w.w)}; }
        if (tok >= NTP) { const u32x4* pp = (const u32x4*)(PART + (size_t)(tok - NTP) * DM) + lane;
#pragma unroll
            for (int ks = 0; ks < 11; ++ks) { u32x4 t[2];
#pragma unroll
                for (int j = 0; j < 2; ++j) t[j] = pp[(size_t)ks * 131072 + 64 * j];
#pragma unroll
                for (int j = 0; j < 2; ++j) { v[j][0] = v[j][0] + (f32x4){bflo(t[j].x), bfhi(t[j].x), bflo(t[j].y), bfhi(t[j].y)}; v[j][1] = v[j][1] + (f32x4){bflo(t[j].z), bfhi(t[j].z), bflo(t[j].w), bfhi(t[j].w)}; } } }
        float s2 = 0.f;
#pragma unroll
        for (int j = 0; j < 2; ++j)
#pragma unroll
            for (int e = 0; e < 2; ++e) { const f32x4 a = v[j][e]; s2 += (a[0] * a[0] + a[1] * a[1]) + (a[2] * a[2] + a[3] * a[3]); }
        const float r = rsqrtf(wave_sum(s2) * (1.f / 1024.f) + EPSV);
        f32x4* xr = (f32x4*)(p.out + (size_t)tok * DM) + 2 * lane;
        if (!dry) {
#pragma unroll
            for (int j = 0; j < 2; ++j) { xr[128 * j] = v[j][0] * r * g[j][0]; xr[128 * j + 1] = v[j][1] * r * g[j][1]; } } }
}

#define XB_TMO      128
#define XB_XCNT(j)  (256  + 64 * (j))
#define XB_XSUB(j)  (1280 + 64 * (j))
#define XB_XGEN(j)  (2304 + 64 * (j))
#define XB_TOP      3328
#define XB_TOPGEN   3392
#define XCD_BAR_WORDS 3456
#define XB_SPIN_CAP (1u << 18)

__device__ __forceinline__ unsigned xb_ld(unsigned* p)              { return __hip_atomic_load(p, __ATOMIC_RELAXED, __HIP_MEMORY_SCOPE_AGENT); }
__device__ __forceinline__ unsigned xb_add(unsigned* p, unsigned v) { return __hip_atomic_fetch_add(p, v, __ATOMIC_RELAXED, __HIP_MEMORY_SCOPE_AGENT); }
__device__ __forceinline__ unsigned xb_xcc_id() { return (unsigned)__builtin_amdgcn_s_getreg((3 << 11) | 20) & 0xFu; }
#define XB_SPIN(cond, bar) do { unsigned _sp = 0; while (cond) { __builtin_amdgcn_s_sleep(1); \
    if ((++_sp & 255u) == 0u) { if (xb_ld(&(bar)[XB_TMO])) break; if (_sp > XB_SPIN_CAP) { atomicAdd(&(bar)[XB_TMO], 1u); break; } } } } while (0)

struct XcdBarrier {
    unsigned* bar; unsigned x;
    volatile LAS unsigned* st;
};

__device__ __forceinline__ XcdBarrier xcd_barrier_post(unsigned* bar, volatile LAS unsigned* st) {
    XcdBarrier b; b.bar = bar; b.x = xb_xcc_id(); b.st = st;
    if (threadIdx.x == 0) (void)xb_add(&bar[XB_XCNT(b.x)], 1u);
    return b;
}
__device__ __forceinline__ void xcd_barrier_complete(unsigned* bar, unsigned x, unsigned& nloc, unsigned& nx) {
    const unsigned G = gridDim.x * gridDim.y * gridDim.z;
    unsigned sum, cnt, mine, sp = 0u;
    for (;;) {
        sum = 0u; cnt = 0u; mine = 0u;
#pragma unroll
        for (unsigned j = 0; j < 16; ++j) { const unsigned c = xb_ld(&bar[XB_XCNT(j)]); sum += c; cnt += (c > 0u) ? 1u : 0u; mine = (j == x) ? c : mine; }
        if (sum == G) break;
        __builtin_amdgcn_s_sleep(1);
        if ((++sp & 255u) == 0u) { if (xb_ld(&bar[XB_TMO])) break; if (sp > XB_SPIN_CAP) { atomicAdd(&bar[XB_TMO], 1u); break; } }
    }
    nloc = mine > 0u ? mine : 1u; nx = cnt > 0u ? cnt : 1u;
}

__device__ __forceinline__ void xcd_barrier(const XcdBarrier& b) {
    asm volatile("s_waitcnt vmcnt(0)" ::: "memory");
    __syncthreads();
    if (threadIdx.x == 0) {
        unsigned* bar = b.bar;
        __builtin_amdgcn_s_waitcnt(0);
        unsigned nloc = b.st[0], nx = b.st[1];
        if (nloc == 0u) { xcd_barrier_complete(bar, b.x, nloc, nx); b.st[0] = nloc; b.st[1] = nx; }
        __builtin_amdgcn_s_sleep(64);
        __builtin_amdgcn_fence(__ATOMIC_RELEASE, "agent"); asm volatile("s_waitcnt vmcnt(0)" ::: "memory");
        const unsigned old = xb_add(&bar[XB_XSUB(b.x)], 1u);
        const unsigned gen = old / nloc;
        if (old + 1u == (gen + 1u) * nloc) {
            __builtin_amdgcn_fence(__ATOMIC_RELEASE, "agent");
            asm volatile("s_waitcnt vmcnt(0)" ::: "memory");
            const unsigned og = xb_add(&bar[XB_TOP], 1u);
            const unsigned tg = og / nx;
            if (og + 1u == (tg + 1u) * nx) xb_add(&bar[XB_TOPGEN], 1u);
            else XB_SPIN(xb_ld(&bar[XB_TOPGEN]) == tg, bar);
            __builtin_amdgcn_fence(__ATOMIC_ACQUIRE, "agent");
            xb_add(&bar[XB_XGEN(b.x)], 1u);
            asm volatile("s_waitcnt vmcnt(0)" ::: "memory");
        } else {
            XB_SPIN(xb_ld(&bar[XB_XGEN(b.x)]) == gen, bar);
            __builtin_amdgcn_fence(__ATOMIC_ACQUIRE, "agent");
            asm volatile("s_waitcnt vmcnt(0)" ::: "memory");
        }
    }
    __syncthreads();
}


__global__ __launch_bounds__(512, 2) void mega_fwd(Params p) {
    extern __shared__ __attribute__((aligned(16))) unsigned char shm_raw[];
    LAS unsigned char* lds = (LAS unsigned char*)shm_raw;
    cg::grid_group grid = cg::this_grid();
    unsigned char* ws = p.ws; float* rss = (float*)(ws + W_RSS);
    pg8::StaticOrder S;
    volatile LAS unsigned* xst = (volatile LAS unsigned*)(lds + 131072 + 4096);
    if (threadIdx.x < 4) xst[threadIdx.x] = 0u;
    __syncthreads();
    const XcdBarrier xb = xcd_barrier_post((unsigned*)(ws + W_BAR), xst);
    if (p.ph_lo < 0) grid.sync();
#define PH_RUN(n, ...) if ((PHMASK & (1 << n)) && p.ph_lo <= n && n < p.ph_hi) { if (n > p.ph_lo) xcd_barrier(xb); \
        for (int rep = 0; rep < (PROBE_PH == n ? 1 + PROBE_N : 1); ++rep) { if (rep) xcd_barrier(xb); const bool dry = rep > 0; __VA_ARGS__ } }
    PH_RUN(0, phase0(p, lds); (void)dry;)
    PH_RUN(1, pg8::Gemm g{(const bf16_t*)(ws + W_XH), (const bf16_t*)(ws + W_BTIN), MTOK, INW, 1024, 1024}; S.init(g.M, g.N, gridDim.x, blockIdx.x);
        EpiInProj E; E.dry = dry; E.P = (bf16_t*)(ws + W_PBUF); pg8::gemm_phase<EpiInProj, pg8::StaticOrder, GP_ALIGN, GP_SP2>(lds, g, S, E);)
    PH_RUN(2, phase2(p, lds, dry, dry ? PROBE_P2MASK : 7);)
    PH_RUN(3, { pg8::Gemm g{(const bf16_t*)(ws + W_GBUF), (const bf16_t*)(ws + W_BTGLU), MTOK, 512, 512, 512}; pg8::StaticOrder S3; S3.init(g.M, g.N, gridDim.x, blockIdx.x);
        EpiGlu E; E.dry = dry; E.G = (const bf16_t*)(ws + W_GBUF); E.MIX = (bf16_t*)(ws + W_MIX); E.bglu = p.in[15]; E.rss = rss;
        p3_transposes(p, lds, 136);
        pg8::gemm_phase<EpiGlu, pg8::StaticOrder, GP_ALIGN, GP_SP2>(lds, g, S3, E);
        asm volatile("s_waitcnt vmcnt(0)" ::: "memory");
        __syncthreads();
        if (threadIdx.x == 0) { Unit u; if (S3.next(0, u)) { __builtin_amdgcn_s_sleep(64); __builtin_amdgcn_fence(__ATOMIC_RELEASE, "agent"); asm volatile("s_waitcnt vmcnt(0)" ::: "memory");
            for (int i = 0; S3.next(i, u); ++i) __hip_atomic_fetch_add((unsigned*)(ws + W_BAR) + 4096 + 16 * (1 + u.pm), 1u, __ATOMIC_RELAXED, __HIP_MEMORY_SCOPE_AGENT); } } }
        { pg8::Gemm g{(const bf16_t*)(ws + W_MIX), (const bf16_t*)(ws + W_BTOUT), NTP, 1024, 1024, 1024}; S.init(g.M, g.N, gridDim.x, blockIdx.x);
        EpiOutProj E; E.dry = dry; E.xp = p.in[0]; E.xs = p.in[1]; E.X2B = (bf16_t*)(ws + W_X2B); E.rss2 = rss + 2 * MTOK;
        LAS float* fl = (LAS float*)(lds + 131072); E.fl = fl; E.pm0 = -1; E.pn0 = -1;
        if (threadIdx.x == 0) { bool any = false;
            for (int i = 0; i < 2; ++i) { Unit u0; if (!S.next(i, u0)) break; any = true; const unsigned* c = (const unsigned*)(ws + W_BAR) + 4096 + 16 * (1 + u0.pm);
                for (unsigned sp = 0; sp < (1u << 16); ++sp) { if (__hip_atomic_load(c, __ATOMIC_RELAXED, __HIP_MEMORY_SCOPE_AGENT) >= 2u) break; __builtin_amdgcn_s_sleep(2); } }
            if (any) { __builtin_amdgcn_fence(__ATOMIC_ACQUIRE, "agent"); asm volatile("s_waitcnt vmcnt(0)" ::: "memory"); } }
        __syncthreads();
        for (int i = 0; i < 2; ++i) { Unit u; if (S.next(i, u)) { if (i == 0) { E.pm0 = u.pm; E.pn0 = u.pn; }
            if (threadIdx.x < 256) { const int row = u.pm * 256 + threadIdx.x; const float a = rss[row] * (1.f / 512.f) + EPSV; const float b = rss[MTOK + row] * (1.f / 512.f) + EPSV;
                fl[i * 256 + threadIdx.x] = sqrtf(b / a); fl[512 + i * 256 + threadIdx.x] = rsqrtf(b); } } }
        __syncthreads();
        pg8::gemm_phase<EpiOutProj, pg8::StaticOrder, GP_ALIGN, GP_SP2>(lds, g, S, E); })
    PH_RUN(5, { pg8::Gemm g{(const bf16_t*)(ws + W_MIX), (const bf16_t*)(ws + W_BTOUT), MTOK, 1024, 1024, 1024};
        pg8::SampleOutOrder S4; S4.c = blockIdx.x; S4.base = (int)gridDim.x - 16; S4.cnt = (unsigned*)(ws + W_BAR) + 4096;
        EpiOutProj E; E.dry = dry; E.xp = p.in[0]; E.xs = p.in[1]; E.X2B = (bf16_t*)(ws + W_X2B); E.rss2 = rss + 2 * MTOK;
        LAS float* fl = (LAS float*)(lds + 131072); E.fl = fl; E.pm0 = -1; E.pn0 = -1;
        { Unit u; if (S4.next(0, u)) { E.pm0 = u.pm; E.pn0 = u.pn;
            if (threadIdx.x < 256) { const int row = u.pm * 256 + threadIdx.x; const float a = rss[row] * (1.f / 512.f) + EPSV; const float b = rss[MTOK + row] * (1.f / 512.f) + EPSV;
                fl[threadIdx.x] = sqrtf(b / a); fl[512 + threadIdx.x] = rsqrtf(b); } } }
        __syncthreads();
        pg8::gemm_phase<EpiOutProj, pg8::SampleOutOrder, GP_ALIGN, GP_SP2>(lds, g, S4, E);
        asm volatile("s_waitcnt vmcnt(0)" ::: "memory");
        __syncthreads();
        if (threadIdx.x == 0) { Unit u; if (S4.next(0, u)) { __builtin_amdgcn_s_sleep(64); __builtin_amdgcn_fence(__ATOMIC_RELEASE, "agent"); asm volatile("s_waitcnt vmcnt(0)" ::: "memory");
            __hip_atomic_fetch_add(S4.cnt, 1u, __ATOMIC_RELAXED, __HIP_MEMORY_SCOPE_AGENT); } } }
        { pg8::Gemm g{(const bf16_t*)(ws + W_X2B), (const bf16_t*)(ws + W_BTGU), MTOK, 2 * DFF, 1024, 1024}; pg8::CountedGU S5; S5.init(g.M, g.N, gridDim.x, blockIdx.x); S5.cnt = (const unsigned*)(ws + W_BAR) + 4096;
        EpiGateUp E; E.dry = dry; E.ACT = (bf16_t*)(ws + W_ACT); E.rss2 = rss + 2 * MTOK;
        pg8::gemm_phase<EpiGateUp, pg8::CountedGU, GP_ALIGN, GP_SP2>(lds, g, S5, E); })
    PH_RUN(6, { pg8::Gemm g{(const bf16_t*)(ws + W_ACT), (const bf16_t*)(ws + W_BTDN), NTP, 1024, DFF, DFF}; S.init(g.M, g.N, gridDim.x, blockIdx.x);
        EpiDown E; E.dry = dry; E.X2B = (const bf16_t*)(ws + W_X2B); E.X3B = (bf16_t*)(ws + W_X3B);
        pg8::gemm_phase<EpiDown, pg8::StaticOrder, GP_ALIGN, GP_SP2>(lds, g, S, E); }
        { pg8::Gemm g{(const bf16_t*)(ws + W_ACT), (const bf16_t*)(ws + W_BTDN), MTOK, 1024, 256, DFF}; pg8::SplitKOrder S2; S2.init(gridDim.x, blockIdx.x);
        EpiDownPart E; E.dry = dry; E.PART = (bf16_t*)(ws + W_PART);
        pg8::gemm_phase<EpiDownPart, pg8::SplitKOrder, GP_ALIGN, GP_SP2>(lds, g, S2, E); })
    PH_RUN(7, phase7(p, dry);)
}

extern "C" void kernel_launch(void* const* d_in, const int* in_sizes, int n_in, void* d_out, int out_size, void* d_ws, size_t ws_size, hipStream_t stream) {
    static int grid = 0;
    if (grid == 0) {
        if (n_in != 28 || ws_size < W_END) { fprintf(stderr, "kernel_launch: unexpected n_in %d / ws %zu (need %zu)\n", n_in, ws_size, (size_t)W_END); grid = -1; return; }
        int dev = 0, cus = 0, per_cu = 0;
        if (hipGetDevice(&dev) != hipSuccess || hipDeviceGetAttribute(&cus, hipDeviceAttributeMultiprocessorCount, dev) != hipSuccess) { grid = -1; return; }
        if (hipFuncSetAttribute((const void*)mega_fwd, hipFuncAttributeMaxDynamicSharedMemorySize, LDS_BYTES) != hipSuccess) { fprintf(stderr, "kernel_launch: hipFuncSetAttribute failed\n"); grid = -1; return; }
        if (hipOccupancyMaxActiveBlocksPerMultiprocessor(&per_cu, (const void*)mega_fwd, 512, LDS_BYTES) != hipSuccess || per_cu < 1) { fprintf(stderr, "kernel_launch: occupancy query says %d\n", per_cu); per_cu = 1; }
        (void)hipGetLastError();
        grid = cus * 1;
    }
    if (grid < 0) return;
    if (hipMemsetAsync((unsigned char*)d_ws + W_BAR, 0, 32768, stream) != hipSuccess) { fprintf(stderr, "kernel_launch: memset failed\n"); return; }
    Params p{};
    for (int i = 0; i < 28; ++i) p.in[i] = (const float*)d_in[i];
    p.out = (float*)d_out; p.ws = (unsigned char*)d_ws;
#if MK_MULTI_LAUNCH
    for (int ph = 0; ph < 8; ++ph) { p.ph_lo = ph; p.ph_hi = ph + 1; hipLaunchKernelGGL(mega_fwd, dim3(grid), dim3(512), LDS_BYTES, stream, p); }
#else
    p.ph_lo = 0; p.ph_hi = 8;
    void* args[] = {&p};
    hipError_t e = hipLaunchCooperativeKernel((const void*)mega_fwd, dim3(grid), dim3(512), args, LDS_BYTES, stream);
    if (e != hipSuccess) fprintf(stderr, "kernel_launch: cooperative launch failed: %s (grid %d)\n", hipGetErrorString(e), grid);
#endif
}
```
